# Optimizing an MI355X kernel written in HIP

```python
import math
import jax, jax.numpy as jnp
from jax import lax
import numpy as np

D_MODEL = 2048
BATCH = 4
SEQ = 4096
DEPTH = 2

CHUNK = 64
NORM_EPS = 1e-6
ROPE_THETA = 500000.0
N_BRANCH = 4
BRANCH_W = D_MODEL // 2

GLA_HEADS = 4
GLA_DK = BRANCH_W // 2 // GLA_HEADS
GLA_DV = BRANCH_W // GLA_HEADS
GLA_RANK = 16
GLA_TAU = 16.0

DSA_HEADS = 8
DSA_HD = BRANCH_W // DSA_HEADS
DSA_ROT = DSA_HD // 4
IDX_HEADS = 8
IDX_HD = 64
IDX_ROT = IDX_HD // 4
TOPK_MAX = 256
DSA_QBLOCK = 64

RWKV_HD = 64
RWKV_HEADS = BRANCH_W // RWKV_HD
RWKV_DECAY_RANK = 96
RWKV_A_RANK = 96
RWKV_DECAY_SCALE = 0.606531
RWKV_GN_EPS = 64e-5
RWKV_KK_EPS = 1e-12

SGU_CHUNK = 128
SGU_GROUPS = 8
SGU_GW = BRANCH_W // SGU_GROUPS
SGU_LN_EPS = 1e-5

A_COLS = (GLA_HEADS * GLA_DK, GLA_HEADS * GLA_DK, BRANCH_W, GLA_RANK, BRANCH_W)
B_COLS = (BRANCH_W, BRANCH_W, BRANCH_W, IDX_HEADS * IDX_HD, IDX_HD, IDX_HEADS, BRANCH_W)
C_COLS = (BRANCH_W, BRANCH_W, BRANCH_W, RWKV_DECAY_RANK, RWKV_A_RANK, BRANCH_W)
D_COLS = (2 * BRANCH_W, BRANCH_W)
GROUP_COLS = (sum(A_COLS), sum(B_COLS), sum(C_COLS), sum(D_COLS), N_BRANCH * D_MODEL)
N_IN_COLS = sum(GROUP_COLS)

kernel_name = "hybrid_gla_dsa_rwkv7_sgu_gated_merge"

F32 = jnp.float32


def _split(t, sizes):
    return jnp.split(t, np.cumsum(sizes)[:-1].tolist(), axis=-1)


def _rmsnorm(x, g):
    x32 = x.astype(F32)
    y = x32 * lax.rsqrt(jnp.mean(x32 * x32, axis=-1, keepdims=True) + NORM_EPS)
    return (y * g.astype(F32)).astype(x.dtype)


def _layernorm(x, g, b, eps):
    x32 = x.astype(F32)
    mu = jnp.mean(x32, axis=-1, keepdims=True)
    xc = x32 - mu
    var = jnp.mean(xc * xc, axis=-1, keepdims=True)
    return xc * lax.rsqrt(var + eps) * g.astype(F32) + b.astype(F32)


def _rope_tables(positions, rot_dim):
    inv = ROPE_THETA ** (-jnp.arange(0, rot_dim, 2, dtype=F32) / rot_dim)
    ang = positions.astype(F32)[..., None] * inv
    return jnp.cos(ang), jnp.sin(ang)


def _partial_rope(t, cos, sin):
    half = cos.shape[-1]
    t32 = t.astype(F32)
    x1, x2, rest = t32[..., :half], t32[..., half:2 * half], t32[..., 2 * half:]
    c, s = cos[:, :, None, :], sin[:, :, None, :]
    return jnp.concatenate([x1 * c - x2 * s, x2 * c + x1 * s, rest], axis=-1).astype(t.dtype)


def _token_shift(t):
    return jnp.pad(t[:, :-1], ((0, 0), (1, 0), (0, 0)))


def _gla_branch(q, k, v, g_lr, gate, w_g2, b_g, head_g):
    bsz, seq, _ = q.shape
    nc = seq // CHUNK
    log_a = jax.nn.log_sigmoid((g_lr @ w_g2 + b_g).astype(F32)) / GLA_TAU

    def chunks(t, hd):
        return t.astype(F32).reshape(bsz, nc, CHUNK, GLA_HEADS, hd).swapaxes(0, 1)

    qc = chunks(q, GLA_DK) * GLA_DK ** -0.5
    kc, lc = chunks(k, GLA_DK), chunks(log_a, GLA_DK)
    vc = chunks(v, GLA_DV)

    def step(state, inp):
        q_c, k_c, v_c, l_c = inp
        cum = jnp.cumsum(l_c, axis=1)
        total = cum[:, -1]
        k_dec = k_c * jnp.exp(total[:, None] - cum)
        state = state * jnp.exp(total)[..., None] + jnp.einsum('bchk,bchv->bhkv', k_dec, v_c)
        out = jnp.einsum('bchk,bhkv->bchv', q_c, state)
        return state, out

    state0 = jnp.zeros((bsz, GLA_HEADS, GLA_DK, GLA_DV), F32)
    _, o = lax.scan(step, state0, (qc, kc, vc, lc))
    o = o.swapaxes(0, 1).reshape(bsz, seq, GLA_HEADS, GLA_DV)
    o = _rmsnorm(o, head_g)
    return o.reshape(bsz, seq, BRANCH_W) * jax.nn.silu(gate.astype(F32))


def _dsa_branch(q, k, v, iq, ik, iw, gate, cos_a, sin_a, cos_i, sin_i):
    bsz, seq, _ = q.shape
    topk = min(TOPK_MAX, seq // 4)
    q = _partial_rope(q.reshape(bsz, seq, DSA_HEADS, DSA_HD), cos_a, sin_a)
    k = _partial_rope(k.reshape(bsz, seq, DSA_HEADS, DSA_HD), cos_a, sin_a)
    v = v.reshape(bsz, seq, DSA_HEADS, DSA_HD)
    iq = _partial_rope(iq.reshape(bsz, seq, IDX_HEADS, IDX_HD), cos_i, sin_i)
    ik = _partial_rope(ik[:, :, None, :], cos_i, sin_i)[:, :, 0]
    iw = iw.astype(F32) * (IDX_HEADS * IDX_HD) ** -0.5
    nqb = seq // DSA_QBLOCK
    key_chunk = jnp.arange(seq) // CHUNK

    def blocks(t):
        return t.reshape(bsz, nqb, DSA_QBLOCK, *t.shape[2:]).swapaxes(0, 1)

    def attend(args):
        qb, iqb, iwb, q0 = args
        rel = jax.nn.relu(jnp.einsum('bqhd,bsd->bqhs', iqb, ik).astype(F32))
        score = jnp.einsum('bqh,bqhs->bqs', iwb, rel)
        q_chunk = (q0 + jnp.arange(DSA_QBLOCK)) // CHUNK
        admissible = key_chunk[None, :] <= q_chunk[:, None]
        score = jnp.where(admissible[None], score, -jnp.inf)
        top_val, top_idx = lax.top_k(score, topk)
        valid = jnp.isfinite(top_val)
        k_sel = jax.vmap(lambda t, i: t[i])(k, top_idx)
        v_sel = jax.vmap(lambda t, i: t[i])(v, top_idx)
        logits = jnp.einsum('bqhd,bqkhd->bqhk', qb, k_sel).astype(F32) * DSA_HD ** -0.5
        logits = jnp.where(valid[:, :, None, :], logits, -jnp.inf)
        probs = jax.nn.softmax(logits, axis=-1)
        return jnp.einsum('bqhk,bqkhd->bqhd', probs, v_sel.astype(F32))

    starts = jnp.arange(nqb, dtype=jnp.int32) * DSA_QBLOCK
    o = lax.map(attend, (blocks(q), blocks(iq), blocks(iw), starts))
    o = o.swapaxes(0, 1).reshape(bsz, seq, BRANCH_W)
    return o * jax.nn.silu(gate.astype(F32))


def _rwkv7_branch(c, mu, w0, w_w2, a0, w_a2, k_k, k_a, r_k, lnx_g, lnx_b):
    bsz, seq, _ = c.shape
    c = c.astype(F32)
    c = c + (_token_shift(c) - c) * mu.astype(F32)
    r, k, v, w_lr, a_lr, gate = _split(c, C_COLS)
    w_log = -RWKV_DECAY_SCALE * jax.nn.sigmoid(w0 + jnp.tanh(w_lr) @ w_w2.astype(F32))
    a = jax.nn.sigmoid(a0 + a_lr @ w_a2.astype(F32))
    kk = k * k_k
    k = k * (1.0 + (a - 1.0) * k_a)

    def heads(t):
        return t.reshape(bsz, seq, RWKV_HEADS, RWKV_HD)

    r, k, v, w_log, a, kk = (heads(t) for t in (r, k, v, w_log, a, kk))
    kk = kk * lax.rsqrt(jnp.sum(kk * kk, axis=-1, keepdims=True) + RWKV_KK_EPS)

    def step(state, inp):
        r_t, w_t, k_t, v_t, kk_t, a_t = inp
        sa = jnp.einsum('bhvk,bhk->bhv', state, -kk_t)
        state = (state * w_t[:, :, None, :]
                 + sa[..., None] * (kk_t * a_t)[:, :, None, :]
                 + v_t[..., None] * k_t[:, :, None, :])
        return state, jnp.einsum('bhvk,bhk->bhv', state, r_t)

    xs = tuple(jnp.moveaxis(t, 1, 0) for t in (r, jnp.exp(w_log), k, v, kk, a))
    state0 = jnp.zeros((bsz, RWKV_HEADS, RWKV_HD, RWKV_HD), F32)
    _, y = lax.scan(step, state0, xs)
    y = jnp.moveaxis(y, 0, 1)
    y = _layernorm(y, lnx_g.reshape(RWKV_HEADS, RWKV_HD), lnx_b.reshape(RWKV_HEADS, RWKV_HD), RWKV_GN_EPS)
    y = y + jnp.sum(r * k * r_k.astype(F32), axis=-1, keepdims=True) * v
    return y.reshape(bsz, seq, BRANCH_W) * jax.nn.silu(gate)


def _sgu_branch(z, gate, ln_g, ln_b, w_s, b_s):
    bsz, seq, _ = z.shape
    z = jax.nn.gelu(z.astype(F32), approximate=False)
    u, v = jnp.split(z, 2, axis=-1)
    v = _layernorm(v, ln_g, ln_b, SGU_LN_EPS)
    nch = seq // SGU_CHUNK
    v = v.reshape(bsz, nch, SGU_CHUNK, SGU_GROUPS, SGU_GW)
    pos_chunk = jnp.arange(SGU_CHUNK) // CHUNK
    mask = pos_chunk[None, :] <= pos_chunk[:, None]
    ws = jnp.where(mask[None], w_s.astype(F32), 0.0)
    sv = jnp.einsum('gij,bcjgd->bcigd', ws, v) + b_s.astype(F32).T[None, None, :, :, None]
    return u * sv.reshape(bsz, seq, BRANCH_W) * jax.nn.silu(gate.astype(F32))


def setup_inputs(seed: int = 0) -> dict:
    key = jax.random.key(seed)
    ks = jax.random.split(key, 32)
    L, W = DEPTH, BRANCH_W

    def nrm(k, shape, scale):
        return jax.random.normal(k, shape, F32) * scale

    def gain(k, shape):
        return 1.0 + nrm(k, shape, 0.1)

    positions = (jax.random.randint(ks[1], (BATCH, 1), 0, 4096) * CHUNK
                 + jnp.arange(SEQ)[None, :]).astype(jnp.int32)
    return {
        "x": nrm(ks[0], (BATCH, SEQ, D_MODEL), 1.0),
        "positions": positions,
        "norm_pre": gain(ks[2], (L, D_MODEL)),
        "norm_post": gain(ks[3], (L, D_MODEL)),
        "w_in": nrm(ks[4], (L, D_MODEL, N_IN_COLS), D_MODEL ** -0.5),
        "gla_w_g2": nrm(ks[5], (L, GLA_RANK, GLA_HEADS * GLA_DK), GLA_RANK ** -0.5),
        "gla_b_g": 0.5 + nrm(ks[6], (L, GLA_HEADS * GLA_DK), 0.1),
        "gla_head_g": gain(ks[7], (L, GLA_DV)),
        "rwkv_mu": jax.random.uniform(ks[8], (L, sum(C_COLS)), F32),
        "rwkv_w0": nrm(ks[9], (L, W), 1.0),
        "rwkv_w_w2": nrm(ks[10], (L, RWKV_DECAY_RANK, W), 0.5 * RWKV_DECAY_RANK ** -0.5),
        "rwkv_a0": nrm(ks[11], (L, W), 0.5),
        "rwkv_w_a2": nrm(ks[12], (L, RWKV_A_RANK, W), 0.5 * RWKV_A_RANK ** -0.5),
        "rwkv_k_k": 0.85 + nrm(ks[13], (L, W), 0.05),
        "rwkv_k_a": gain(ks[14], (L, W)),
        "rwkv_r_k": nrm(ks[15], (L, RWKV_HEADS, RWKV_HD), 0.1),
        "rwkv_lnx_g": gain(ks[16], (L, W)),
        "rwkv_lnx_b": nrm(ks[17], (L, W), 0.02),
        "sgu_ln_g": gain(ks[18], (L, W)),
        "sgu_ln_b": nrm(ks[19], (L, W), 0.02),
        "sgu_w_s": nrm(ks[20], (L, SGU_GROUPS, SGU_CHUNK, SGU_CHUNK), SGU_CHUNK ** -0.5),
        "sgu_b_s": gain(ks[21], (L, SGU_GROUPS, SGU_CHUNK)),
        "w_proj": nrm(ks[22], (L, N_BRANCH, W, D_MODEL), W ** -0.5),
        "w_out": nrm(ks[23], (L, D_MODEL, D_MODEL), D_MODEL ** -0.5),
    }


def reference(x, positions, norm_pre, norm_post, w_in, gla_w_g2, gla_b_g, gla_head_g,
              rwkv_mu, rwkv_w0, rwkv_w_w2, rwkv_a0, rwkv_w_a2, rwkv_k_k, rwkv_k_a, rwkv_r_k,
              rwkv_lnx_g, rwkv_lnx_b, sgu_ln_g, sgu_ln_b, sgu_w_s, sgu_b_s, w_proj, w_out):
    bsz, seq, _ = x.shape
    cos_a, sin_a = _rope_tables(positions, DSA_ROT)
    cos_i, sin_i = _rope_tables(positions, IDX_ROT)
    for l in range(DEPTH):
        h = _rmsnorm(x, norm_pre[l])
        p = h @ w_in[l]
        pa, pb, pc, pd, pm = _split(p, GROUP_COLS)
        ya = _gla_branch(*_split(pa, A_COLS), gla_w_g2[l], gla_b_g[l], gla_head_g[l])
        yb = _dsa_branch(*_split(pb, B_COLS), cos_a, sin_a, cos_i, sin_i)
        yc = _rwkv7_branch(pc, rwkv_mu[l], rwkv_w0[l], rwkv_w_w2[l], rwkv_a0[l], rwkv_w_a2[l],
                           rwkv_k_k[l], rwkv_k_a[l], rwkv_r_k[l], rwkv_lnx_g[l], rwkv_lnx_b[l])
        yd = _sgu_branch(*_split(pd, D_COLS), sgu_ln_g[l], sgu_ln_b[l], sgu_w_s[l], sgu_b_s[l])
        ys = jnp.stack([ya, yb, yc, yd], axis=2).astype(x.dtype)
        proj = jnp.einsum('bsgw,gwd->bsgd', ys, w_proj[l])
        gates = jax.nn.sigmoid(pm.reshape(bsz, seq, N_BRANCH, D_MODEL).astype(F32))
        merged = jnp.einsum('bsgd,bsgd->bsd', gates, proj.astype(F32)).astype(x.dtype)
        x = x + _rmsnorm(merged @ w_out[l], norm_post[l])
    return x
```

```cpp
#include <hip/hip_runtime.h>
#include <cstdio>
#include <cstdint>

namespace pg8 {
#define PG8_LAS __attribute__((address_space(3)))
typedef unsigned short bf16_t;
typedef short bf16x8 __attribute__((ext_vector_type(8)));
typedef float f32x4 __attribute__((ext_vector_type(4)));
typedef unsigned u32x4 __attribute__((ext_vector_type(4)));
constexpr int BM = 256, BK = 64, HALF = 128, HTB = HALF * BK * 2  , STAGE_BYTES = 8 * HTB, NXCD = 8, WGM = 8;

__host__ __device__ __forceinline__ int lds_byte(int r, int c) { const int st = (r >> 4) * 2 + (c >> 5), rr = r & 15, cc = c & 31, ob = rr * 64 + cc * 2; return st * 1024 + (ob ^ (((ob >> 9) & 1) << 5)); }
__host__ __device__ __forceinline__ void stage_rc(int b, int& R, int& C) { const int st = b / 1024, sb = b % 1024, swz = sb ^ (((sb >> 9) & 1) << 5); R = (st >> 1) * 16 + swz / 64; C = (st & 1) * 32 + (swz % 64) / 2; }
__host__ __device__ __forceinline__ int perm32(int rho) { const int n = rho >> 4, i = rho & 15; return 8 * (i >> 2) + 4 * n + (i & 3); }

struct Unit { int pm, pn; };
struct Gemm { const bf16_t* A; const bf16_t* Bt; int M, N, K; int npg; size_t a_gstride; };

struct StaticOrder {
    int nM, nN, nwg, G, c;
    __host__ __device__ void init(int M, int N, int G_, int c_) { nM = M / BM; nN = N / BM; nwg = nM * nN; G = G_; c = c_; }
    __host__ __device__ bool next(int i, Unit& u) const {
        const long L = (long)i * G + c; if (L >= nwg) return false;
        int wgid = (int)L; { const int q = nwg / NXCD, r = nwg % NXCD, xcd = wgid % NXCD, off = wgid / NXCD; wgid = (xcd < r ? xcd * (q + 1) : r * (q + 1) + (xcd - r) * q) + off; }
        const int nig = WGM * nN, gid = wgid / nig, fm = gid * WGM, gsz = (nM - fm) < WGM ? (nM - fm) : WGM;
        u.pm = fm + ((wgid % nig) % gsz); u.pn = (wgid % nig) / gsz; return true;
    }
    __device__ __forceinline__ void a_ready(const Unit&) const {}
    __device__ __forceinline__ void done(const Unit&) const {}
};
template <class Epi, class Sched, bool STAMP = false>
__device__ __forceinline__ void gemm_phase(PG8_LAS unsigned char* lds, const Gemm g, const Sched& S, const Epi& E, unsigned long long* stamps) {
    const int tid = threadIdx.x, wid = __builtin_amdgcn_readfirstlane(tid >> 6), lane = tid & 63, wr = wid >> 2, wc = wid & 3, fr = lane & 15, fq = lane >> 4;
    const int K = g.K, nt = K / BK;
    int ts_lo = 0, ts_hi = 0, nts = 0; const unsigned long long rt_entry = STAMP ? (unsigned long long)wall_clock64() : 0ull;
#define PG8_STAMP() do { if (STAMP && wid == 0 && nts < 64) { const unsigned long long _c = (unsigned long long)clock64(); \
        ts_lo = (lane == nts) ? (int)(unsigned)_c : ts_lo; ts_hi = (lane == nts) ? (int)(unsigned)(_c >> 32) : ts_hi; ++nts; } } while (0)
    PG8_STAMP();
    unsigned voffA[2], voffB[2];
#pragma unroll
    for (int i = 0; i < 2; ++i) { int R, C; stage_rc(tid * 16 + i * 8192, R, C); const int Rb = Epi::PERM ? ((R & ~31) + perm32(R & 31)) : R;
        voffA[i] = (unsigned)(R * K + C) * 2u; voffB[i] = (unsigned)(Rb * K + C) * 2u; }
    const size_t kstep = (size_t)(BK * 2);
    const size_t hstep = (size_t)HALF * K * 2;
    const size_t tstep = 2 * hstep;
    const unsigned ldsw = (unsigned)wid * 1024u;
    const int aoff = lds_byte(wr * 64 + fr, fq * 8), boff = lds_byte(wc * 32 + fr, fq * 8);
#define PG8_SA(b, h) (((b) * 2 + (h)) * HTB)
#define PG8_SB(b, h) ((4 + (b) * 2 + (h)) * HTB)
#define PG8_STAGE(bufoff, gbase, voff) do { _Pragma("unroll") for (int _i = 0; _i < 2; ++_i) \
        __builtin_amdgcn_global_load_lds((const unsigned*)((const char*)(gbase) + (voff)[_i]), (PG8_LAS unsigned*)(lds + (bufoff) + ldsw + _i * 8192), 16, 0, 0); } while (0)
#define PG8_LDA(dst, b, h) do { _Pragma("unroll") for (int m = 0; m < 4; ++m) _Pragma("unroll") for (int k = 0; k < 2; ++k) dst[m][k] = *(const PG8_LAS bf16x8*)(lds + PG8_SA(b, h) + aoff + m * 2048 + k * 1024); } while (0)
#define PG8_LDB(dst, b, h) do { _Pragma("unroll") for (int n = 0; n < 2; ++n) _Pragma("unroll") for (int k = 0; k < 2; ++k) dst[n][k] = *(const PG8_LAS bf16x8*)(lds + PG8_SB(b, h) + boff + n * 2048 + k * 1024); } while (0)
#define PG8_MMA(ai, bj, At, Bt) do { __builtin_amdgcn_s_setprio(1); _Pragma("unroll") for (int m = 0; m < 4; ++m) _Pragma("unroll") for (int n = 0; n < 2; ++n) _Pragma("unroll") for (int k = 0; k < 2; ++k) \
        acc[ai][bj][m][n] = __builtin_amdgcn_mfma_f32_16x16x32_bf16(Bt[n][k], At[m][k], acc[ai][bj][m][n], 0, 0, 0); __builtin_amdgcn_s_setprio(0); } while (0)
#define PG8_WAIT_V(n) asm volatile("s_waitcnt vmcnt(" #n ")" ::: "memory")
#define PG8_WAIT_L(n) asm volatile("s_waitcnt lgkmcnt(" #n ")" ::: "memory")
#define PG8_BAR __builtin_amdgcn_s_barrier()
#define PG8_SCHED __builtin_amdgcn_sched_barrier(0)
    Unit cur, nxt; int ui = 0;
    if (!S.next(0, cur)) return;
    f32x4 acc[2][2][4][2];
#pragma unroll
    for (int a = 0; a < 2; ++a)
#pragma unroll
        for (int b = 0; b < 2; ++b)
#pragma unroll
            for (int m = 0; m < 4; ++m)
#pragma unroll
                for (int n = 0; n < 2; ++n) acc[a][b][m][n] = (f32x4){0.f, 0.f, 0.f, 0.f};
    bf16x8 At[4][2], B0[2][2], B1[2][2];
    const char* cA = (const char*)g.A + (size_t)cur.pm * tstep + (g.npg ? (size_t)(cur.pn / g.npg) * g.a_gstride : (size_t)0); const char* cB = (const char*)g.Bt + (size_t)cur.pn * tstep;
    S.a_ready(cur);
    PG8_STAGE(PG8_SB(0, 0), cB, voffB); PG8_STAGE(PG8_SA(0, 0), cA, voffA); PG8_STAGE(PG8_SB(0, 1), cB + hstep, voffB); PG8_STAGE(PG8_SA(0, 1), cA + hstep, voffA);
    if (wr == 1) PG8_BAR;
    PG8_WAIT_V(4); PG8_BAR;
    PG8_STAGE(PG8_SB(1, 0), cB + kstep, voffB); PG8_STAGE(PG8_SA(1, 0), cA + kstep, voffA); PG8_STAGE(PG8_SB(1, 1), cB + hstep + kstep, voffB);
    PG8_WAIT_V(6); PG8_BAR;
    PG8_STAMP();
    for (;;) {
        const bool has_next = S.next(ui + 1, nxt);
        const char* nA = has_next ? (const char*)g.A + (size_t)nxt.pm * tstep + (g.npg ? (size_t)(nxt.pn / g.npg) * g.a_gstride : (size_t)0) : cA; const char* nB = has_next ? (const char*)g.Bt + (size_t)nxt.pn * tstep : cB;
        for (int t = 0; t < nt; t += 2) {
            const bool last = (t == nt - 2);
            const char* a1 = cA + (size_t)(t + 1) * kstep;
            const char* a2 = last ? nA : cA + (size_t)(t + 2) * kstep; const char* b2 = last ? nB : cB + (size_t)(t + 2) * kstep;
            const char* a3 = a2 + kstep; const char* b3 = b2 + kstep;
            if (last && has_next) S.a_ready(nxt);
            PG8_LDB(B0, 0, 0); PG8_SCHED; PG8_LDA(At, 0, 0); PG8_STAGE(PG8_SA(1, 1), a1 + hstep, voffA);
            PG8_WAIT_L(8); PG8_BAR; PG8_WAIT_L(0); PG8_MMA(0, 0, At, B0); PG8_BAR; PG8_SCHED;
            PG8_LDB(B1, 0, 1); PG8_STAGE(PG8_SB(0, 0), b2, voffB);
            PG8_BAR; PG8_WAIT_L(0); PG8_MMA(0, 1, At, B1); PG8_BAR;
            PG8_LDA(At, 0, 1); PG8_STAGE(PG8_SA(0, 0), a2, voffA);
            PG8_BAR; PG8_WAIT_L(0); PG8_MMA(1, 0, At, B0); PG8_BAR; PG8_SCHED;
            PG8_STAGE(PG8_SB(0, 1), b2 + hstep, voffB);
            PG8_WAIT_V(6); PG8_BAR; PG8_MMA(1, 1, At, B1); PG8_BAR;
            PG8_LDB(B0, 1, 0); PG8_SCHED; PG8_LDA(At, 1, 0); PG8_STAGE(PG8_SA(0, 1), a2 + hstep, voffA);
            PG8_WAIT_L(8); PG8_BAR; PG8_WAIT_L(0); PG8_MMA(0, 0, At, B0); PG8_BAR; PG8_SCHED;
            PG8_LDB(B1, 1, 1); PG8_STAGE(PG8_SB(1, 0), b3, voffB);
            PG8_BAR; PG8_WAIT_L(0); PG8_MMA(0, 1, At, B1); PG8_BAR;
            PG8_LDA(At, 1, 1); PG8_STAGE(PG8_SA(1, 0), a3, voffA);
            PG8_BAR; PG8_WAIT_L(0); PG8_MMA(1, 0, At, B0); PG8_BAR; PG8_SCHED;
            PG8_STAGE(PG8_SB(1, 1), b3 + hstep, voffB);
            PG8_WAIT_V(6); PG8_BAR; PG8_MMA(1, 1, At, B1); PG8_BAR;
        }
        PG8_STAMP();
        if constexpr (!Epi::AFTER_DRAIN) { E(acc, cur, wr, wc, fr, fq); S.done(cur); }
        PG8_STAMP();
        if (!has_next) break;
#pragma unroll
        for (int a = 0; a < 2; ++a)
#pragma unroll
            for (int b = 0; b < 2; ++b)
#pragma unroll
                for (int m = 0; m < 4; ++m)
#pragma unroll
                    for (int n = 0; n < 2; ++n) acc[a][b][m][n] = (f32x4){0.f, 0.f, 0.f, 0.f};
        cur = nxt; cA = nA; cB = nB; ++ui;
    }
    PG8_WAIT_V(0);
    if (wr == 0) PG8_BAR;
    PG8_BAR;
    if constexpr (Epi::AFTER_DRAIN) { E.fused(acc, cur, wr, wc, fr, fq, lds, wid, lane); S.done(cur); }
    PG8_STAMP();
    if (STAMP && wid == 0) { stamps[lane] = lane < nts ? (((unsigned long long)(unsigned)ts_hi << 32) | (unsigned)ts_lo) : 0ull;
        if (lane == 62) stamps[62] = rt_entry; if (lane == 63) stamps[63] = (unsigned long long)wall_clock64(); }
#undef PG8_STAMP
#undef PG8_SA
#undef PG8_SB
#undef PG8_STAGE
#undef PG8_LDA
#undef PG8_LDB
#undef PG8_MMA
#undef PG8_WAIT_V
#undef PG8_WAIT_L
#undef PG8_BAR
#undef PG8_SCHED
}
}

#define LAS __attribute__((address_space(3)))
typedef unsigned short bf16;
typedef short bf16x8 __attribute__((ext_vector_type(8)));
typedef float f32x4 __attribute__((ext_vector_type(4)));
typedef float f32x2 __attribute__((ext_vector_type(2)));
typedef float f32x16 __attribute__((ext_vector_type(16)));
typedef unsigned u32x4 __attribute__((ext_vector_type(4)));
typedef unsigned u32x2 __attribute__((ext_vector_type(2)));
typedef __bf16 bf16x2_t __attribute__((ext_vector_type(2)));
#define DI __device__ __forceinline__
#define MFMA32(a, b, c) __builtin_amdgcn_mfma_f32_32x32x16_bf16((a), (b), (c), 0, 0, 0)

DI float bf2f(unsigned short b) { return __uint_as_float(((unsigned)b) << 16); }
DI float bflo(unsigned w) { return __uint_as_float(w << 16); }
DI float bfhi(unsigned w) { return __uint_as_float(w & 0xffff0000u); }
DI unsigned pk2(float lo, float hi) { f32x2 v; v.x = lo; v.y = hi; return __builtin_bit_cast(unsigned, __builtin_convertvector(v, bf16x2_t)); }
DI unsigned short f2bf(float f) { return (unsigned short)(pk2(f, 0.f) & 0xffffu); }
DI int crow(int reg, int h) { return (reg & 3) + 8 * (reg >> 2) + 4 * h; }
DI bf16x8 pack_step(const f32x16& x, int s) {
    u32x4 p; p.x = pk2(x[8 * s], x[8 * s + 1]); p.y = pk2(x[8 * s + 2], x[8 * s + 3]); p.z = pk2(x[8 * s + 4], x[8 * s + 5]); p.w = pk2(x[8 * s + 6], x[8 * s + 7]);
    return __builtin_bit_cast(bf16x8, p);
}
DI bf16x8 pack8f(f32x4 a, f32x4 b) { u32x4 p; p.x = pk2(a.x, a.y); p.y = pk2(a.z, a.w); p.z = pk2(b.x, b.y); p.w = pk2(b.z, b.w); return __builtin_bit_cast(bf16x8, p); }
DI bf16x8 join8(u32x2 lo, u32x2 hi) { u32x4 p; p.x = lo.x; p.y = lo.y; p.z = hi.x; p.w = hi.y; return __builtin_bit_cast(bf16x8, p); }
DI float wave_sum(float v) {
#pragma unroll
    for (int o = 1; o < 64; o <<= 1) v += __shfl_xor(v, o);
    return v;
}
DI float half_sum(float v) {
#pragma unroll
    for (int o = 1; o < 32; o <<= 1) v += __shfl_xor(v, o);
    return v;
}
#define DPP_ROR(x, n) __builtin_bit_cast(float, __builtin_amdgcn_update_dpp(0, __builtin_bit_cast(int, (x)), 0x120 + (n), 0xf, 0xf, false))
DI float row16_sum(float x) { x += DPP_ROR(x, 8); x += DPP_ROR(x, 4); x += DPP_ROR(x, 2); x += DPP_ROR(x, 1); return x; }
DI float sigmoidf_(float x) { return 1.0f / (1.0f + __expf(-x)); }
DI float siluf_(float x) { return x / (1.0f + __expf(-x)); }
DI float gelu_erf(float x) { return 0.5f * x * (1.0f + erff(x * 0.70710678118654752f)); }
DI float logsigmoidf_(float x) { return fminf(x, 0.f) - log1pf(__expf(-fabsf(x))); }

#define XB_TMO      128
#define XB_XCNT(j)  (256  + 64 * (j))
#define XB_XSUB(j)  (1280 + 64 * (j))
#define XB_XGEN(j)  (2304 + 64 * (j))
#define XB_TOP      3328
#define XB_TOPGEN   3392
#define XCD_BAR_WORDS 3456
#define XB_SPIN_CAP (1u << 18)
__device__ __forceinline__ unsigned xb_ld(unsigned* p)              { return __hip_atomic_load(p, __ATOMIC_RELAXED, __HIP_MEMORY_SCOPE_AGENT); }
__device__ __forceinline__ unsigned xb_add(unsigned* p, unsigned v) { return __hip_atomic_fetch_add(p, v, __ATOMIC_RELAXED, __HIP_MEMORY_SCOPE_AGENT); }
__device__ __forceinline__ unsigned xb_xcc_id() { return (unsigned)__builtin_amdgcn_s_getreg((3 << 11) | 20) & 0xFu; }
#define XB_SPIN(cond, bar) do { unsigned _sp = 0; while (cond) { __builtin_amdgcn_s_sleep(1); \
    if ((++_sp & 255u) == 0u) { if (xb_ld(&(bar)[XB_TMO])) break; if (_sp > XB_SPIN_CAP) { atomicAdd(&(bar)[XB_TMO], 1u); break; } } } } while (0)
struct XcdBarrier { unsigned* bar; unsigned x; volatile LAS unsigned* st; };
__device__ __forceinline__ XcdBarrier xcd_barrier_post(unsigned* bar, volatile LAS unsigned* st) {
    XcdBarrier b; b.bar = bar; b.x = xb_xcc_id(); b.st = st;
    if (threadIdx.x == 0) (void)xb_add(&bar[XB_XCNT(b.x)], 1u);
    return b;
}
__device__ __forceinline__ void xcd_barrier_complete(unsigned* bar, unsigned x, unsigned& nloc, unsigned& nx) {
    const unsigned G = gridDim.x * gridDim.y * gridDim.z;
    unsigned sum, cnt, mine, sp = 0u;
    for (;;) {
        sum = 0u; cnt = 0u; mine = 0u;
#pragma unroll
        for (unsigned j = 0; j < 16; ++j) { const unsigned c = xb_ld(&bar[XB_XCNT(j)]); sum += c; cnt += (c > 0u) ? 1u : 0u; mine = (j == x) ? c : mine; }
        if (sum == G) break;
        __builtin_amdgcn_s_sleep(1);
        if ((++sp & 255u) == 0u) { if (xb_ld(&bar[XB_TMO])) break; if (sp > XB_SPIN_CAP) { atomicAdd(&bar[XB_TMO], 1u); break; } }
    }
    nloc = mine > 0u ? mine : 1u; nx = cnt > 0u ? cnt : 1u;
}
__device__ __forceinline__ void xcd_barrier(const XcdBarrier& b) {
    asm volatile("s_waitcnt vmcnt(0)" ::: "memory");
    __syncthreads();
    if (threadIdx.x == 0) {
        unsigned* bar = b.bar;
        __builtin_amdgcn_s_waitcnt(0);
        unsigned nloc = b.st[0], nx = b.st[1];
        if (nloc == 0u) { xcd_barrier_complete(bar, b.x, nloc, nx); b.st[0] = nloc; b.st[1] = nx; }
        const unsigned old = xb_add(&bar[XB_XSUB(b.x)], 1u);
        const unsigned gen = old / nloc;
        if (old + 1u == (gen + 1u) * nloc) {
            __builtin_amdgcn_fence(__ATOMIC_RELEASE, "agent");
            asm volatile("s_waitcnt vmcnt(0)" ::: "memory");
            const unsigned og = xb_add(&bar[XB_TOP], 1u);
            const unsigned tg = og / nx;
            if (og + 1u == (tg + 1u) * nx) xb_add(&bar[XB_TOPGEN], 1u);
            else XB_SPIN(xb_ld(&bar[XB_TOPGEN]) == tg, bar);
            __builtin_amdgcn_fence(__ATOMIC_ACQUIRE, "agent");
            xb_add(&bar[XB_XGEN(b.x)], 1u);
            asm volatile("s_waitcnt vmcnt(0)" ::: "memory");
        } else {
            XB_SPIN(xb_ld(&bar[XB_XGEN(b.x)]) == gen, bar);
            __builtin_amdgcn_fence(__ATOMIC_ACQUIRE, "agent");
            asm volatile("s_waitcnt vmcnt(0)" ::: "memory");
        }
    }
    __syncthreads();
}

constexpr int NB = 4, SEQ = 4096, T = NB * SEQ, DM = 2048, BW = 1024, NIN = 23320;
constexpr int N1 = 15360, LDP = 14848, N1BF_TILES = 58, NM = 8192;
constexpr int AQ = 0, AK = 512, AV = 1024, AG = 2048, BQ = 3072, BK_ = 4096, BV = 5120, BIQ = 6144, BG = 6656, CR = 7680, CK = 8704, CV = 9728, CG = 10752, DU = 11776, DV = 12800, DG = 13824;
constexpr int GLR = 0, IK = 16, IW = 80, WLR = 96, ALR = 192;
constexpr size_t MiB = 1u << 20;
constexpr size_t WS_CTL = 0, CTL_BYTES = 1 * MiB;
constexpr size_t WS_WT1 = 1 * MiB;
constexpr size_t WS_WTM = 121 * MiB;
constexpr size_t WS_WTP = 185 * MiB;
constexpr size_t WS_WTO = 217 * MiB;
constexpr size_t WS_WSB = 233 * MiB;
constexpr size_t WS_H   = 234 * MiB;
constexpr size_t WS_P   = 298 * MiB;
constexpr size_t WS_SM  = 762 * MiB;
constexpr size_t WS_RW  = 794 * MiB;
constexpr size_t WS_VT  = 1050 * MiB;
constexpr size_t WS_SC  = 1082 * MiB;
constexpr size_t WS_BM  = 1212 * MiB;
constexpr size_t WS_YS  = 1220 * MiB;
constexpr size_t WS_END = 1348 * MiB;
constexpr size_t RW_ARR = (size_t)T * 1024 * 2;
constexpr int CW_BAR = 64, CW_Q = 4096;
constexpr int LDS_BYTES = 147456, MISC_OFF = LDS_BYTES - 256;
constexpr int NPHASE = 21;

struct Args { const float* in[24]; const int* pos; float* out; unsigned char* ws; int ph_lo, ph_hi; };

template <int MODE> struct Epi {
    static constexpr bool PERM = true, AFTER_DRAIN = false;
    unsigned char* O; float* O2;
    __device__ __forceinline__ void operator()(const pg8::f32x4 (&acc)[2][2][4][2], const pg8::Unit& u, int wr, int wc, int fr, int fq) const {
        const int row0 = u.pm * 256 + wr * 64 + fr, cl = wc * 32 + 8 * fq;
        if ((MODE == 0 && u.pn >= N1BF_TILES) || MODE == 3) {
            float* base; int ldc;
            if (MODE == 0) { base = O2 + (u.pn - N1BF_TILES) * 256 + cl; ldc = 512; } else { base = (float*)O + u.pn * 256 + cl; ldc = DM; }
#pragma unroll
            for (int ai = 0; ai < 2; ++ai)
#pragma unroll
                for (int m = 0; m < 4; ++m) { float* rowp = base + (size_t)(row0 + ai * 128 + m * 16) * ldc;
#pragma unroll
                    for (int bj = 0; bj < 2; ++bj) { *(pg8::f32x4*)(rowp + bj * 128) = acc[ai][bj][m][0]; *(pg8::f32x4*)(rowp + bj * 128 + 4) = acc[ai][bj][m][1]; } }
        } else {
            bf16* base; int ldc;
            if (MODE == 0) { base = (bf16*)O + u.pn * 256 + cl; ldc = LDP; }
            else if (MODE == 1) { const int g = u.pn >> 3; base = (bf16*)O + (size_t)g * T * DM + (u.pn & 7) * 256 + cl; ldc = DM; }
            else { base = (bf16*)O + u.pn * 256 + cl; ldc = NM; }
#pragma unroll
            for (int ai = 0; ai < 2; ++ai)
#pragma unroll
                for (int m = 0; m < 4; ++m) { bf16* rowp = base + (size_t)(row0 + ai * 128 + m * 16) * ldc;
#pragma unroll
                    for (int bj = 0; bj < 2; ++bj) { pg8::f32x4 v0 = acc[ai][bj][m][0], v1 = acc[ai][bj][m][1];
                        if (MODE == 2) {
#pragma unroll
                            for (int e = 0; e < 4; ++e) { v0[e] = sigmoidf_(v0[e]); v1[e] = sigmoidf_(v1[e]); } }
                        u32x4 w; w.x = pk2(v0[0], v0[1]); w.y = pk2(v0[2], v0[3]); w.z = pk2(v1[0], v1[1]); w.w = pk2(v1[2], v1[3]);
                        *(u32x4*)(rowp + bj * 128) = w; } }
        }
    }
};

DI int map1(int n) {
    if (n < 2048) return n;
    if (n < 6656) return n + 16;
    if (n < 10752) return n + 88;
    if (n < LDP) return n + 280;
    const int m = n - LDP;
    if (m < 16) return 2048 + m;
    if (m < 80) return 6672 + (m - 16);
    if (m < 88) return 6736 + (m - 80);
    if (m < 96) return -1;
    if (m < 192) return 10840 + (m - 96);
    if (m < 288) return 10936 + (m - 192);
    return -1;
}
DI void tr_item(const float* W, size_t ldw, int K, bf16* WT, int k0, int sc, int nd, LAS float* scr, int lane) {
#pragma unroll 8
    for (int i = 0; i < 32; ++i) { const int kk = 2 * i + (lane >> 5); const float v = sc >= 0 ? W[(size_t)(k0 + kk) * ldw + sc] : 0.f; scr[kk * 33 + (lane & 31)] = v; }
    asm volatile("s_waitcnt lgkmcnt(0)" ::: "memory");
    const int c = lane & 7;
#pragma unroll
    for (int jj = 0; jj < 4; ++jj) { const int n = (lane >> 3) + 8 * jj; const LAS float* s = scr + (8 * c) * 33 + n;
        u32x4 o; o.x = pk2(s[0 * 33], s[1 * 33]); o.y = pk2(s[2 * 33], s[3 * 33]); o.z = pk2(s[4 * 33], s[5 * 33]); o.w = pk2(s[6 * 33], s[7 * 33]);
        *(u32x4*)(WT + (size_t)(nd + n) * K + k0 + 8 * c) = o; }
    asm volatile("s_waitcnt lgkmcnt(0)" ::: "memory");
}
DI void phase_prologue(const Args& a, LAS unsigned char* lds, int tid, int lane, int wave, int bid, int G) {
    LAS float* scr = (LAS float*)(lds + wave * 8704);
    const int gw = bid * 8 + wave, NGW = G * 8;
    constexpr int I1 = 32 * 480, IM = 32 * 256, IP = 4 * 16 * 64, IO = 32 * 64, IL = I1 + IM + IP + IO;
    for (int it = gw; it < 2 * IL; it += NGW) {
        const int l = it / IL; int r = it - l * IL;
        const float* win = a.in[4] + (size_t)l * DM * NIN;
        if (r < I1) { const int kb = r / 480, nb = r % 480; tr_item(win, NIN, DM, (bf16*)(a.ws + WS_WT1) + (size_t)l * N1 * DM, 64 * kb, map1(32 * nb + (lane & 31)), 32 * nb, scr, lane); continue; } r -= I1;
        if (r < IM) { const int kb = r / 256, nb = r % 256; tr_item(win, NIN, DM, (bf16*)(a.ws + WS_WTM) + (size_t)l * NM * DM, 64 * kb, 15128 + 32 * nb + (lane & 31), 32 * nb, scr, lane); continue; } r -= IM;
        if (r < IP) { const int g = r / 1024, q = r % 1024, kb = q / 64, nb = q % 64;
            tr_item(a.in[22] + ((size_t)(l * 4 + g) << 21), DM, BW, (bf16*)(a.ws + WS_WTP) + ((size_t)(l * 4 + g) << 21), 64 * kb, 32 * nb + (lane & 31), 32 * nb, scr, lane); continue; } r -= IP;
        { const int kb = r / 64, nb = r % 64; tr_item(a.in[23] + ((size_t)l << 22), DM, DM, (bf16*)(a.ws + WS_WTO) + ((size_t)l << 22), 64 * kb, 32 * nb + (lane & 31), 32 * nb, scr, lane); }
    }
    bf16* wsb = (bf16*)(a.ws + WS_WSB);
    for (int e = bid * 512 + tid; e < 2 * 8 * 128 * 128; e += G * 512) { const int j = e & 127, i = (e >> 7) & 127; wsb[e] = (i < 64 && j >= 64) ? (bf16)0 : f2bf(a.in[20][e]); }
}

DI void phase_prenorm(const float* x, const float* g, bf16* h, int gw, int NGW, int lane) {
    for (int m = gw; m < T; m += NGW) {
        const f32x4* xr = (const f32x4*)(x + (size_t)m * DM) + lane; f32x4 v[8]; float s = 0.f;
#pragma unroll
        for (int j = 0; j < 8; ++j) { v[j] = xr[64 * j]; s += (v[j].x * v[j].x + v[j].y * v[j].y) + (v[j].z * v[j].z + v[j].w * v[j].w); }
        const float rs = 1.0f / sqrtf(wave_sum(s) * (1.0f / DM) + 1e-6f);
        u32x2* o = (u32x2*)(h + (size_t)m * DM) + lane;
#pragma unroll
        for (int j = 0; j < 8; ++j) { const f32x4 gv = ((const f32x4*)g)[lane + 64 * j]; u32x2 w; w.x = pk2(v[j].x * rs * gv.x, v[j].y * rs * gv.y); w.y = pk2(v[j].z * rs * gv.z, v[j].w * rs * gv.w); o[64 * j] = w; }
    }
}
DI void phase_postnorm(const float* x, const float* y, const float* g, float* out, int gw, int NGW, int lane) {
    for (int m = gw; m < T; m += NGW) {
        const f32x4* yr = (const f32x4*)(y + (size_t)m * DM) + lane; f32x4 v[8]; float s = 0.f;
#pragma unroll
        for (int j = 0; j < 8; ++j) { v[j] = yr[64 * j]; s += (v[j].x * v[j].x + v[j].y * v[j].y) + (v[j].z * v[j].z + v[j].w * v[j].w); }
        const float rs = 1.0f / sqrtf(wave_sum(s) * (1.0f / DM) + 1e-6f);
        const f32x4* xr = (const f32x4*)(x + (size_t)m * DM) + lane; f32x4* o = (f32x4*)(out + (size_t)m * DM) + lane;
#pragma unroll
        for (int j = 0; j < 8; ++j) { const f32x4 gv = ((const f32x4*)g)[lane + 64 * j]; const f32x4 xv = xr[64 * j]; o[64 * j] = xv + v[j] * rs * gv; }
    }
}
DI void phase_merge(const bf16* gates, const bf16* proj, bf16* merged, int gtid, int NT) {
    for (int it = gtid; it < T * (DM / 8); it += NT) {
        const int t = it >> 8, d = (it & 255) * 8;
        float acc[8];
#pragma unroll
        for (int e = 0; e < 8; ++e) acc[e] = 0.f;
#pragma unroll
        for (int g = 0; g < 4; ++g) { const u32x4 gv = *(const u32x4*)(gates + (size_t)t * NM + g * DM + d); const u32x4 pv = *(const u32x4*)(proj + ((size_t)g * T + t) * DM + d);
#pragma unroll
            for (int e = 0; e < 4; ++e) { acc[2 * e] += bflo(gv[e]) * bflo(pv[e]); acc[2 * e + 1] += bfhi(gv[e]) * bfhi(pv[e]); } }
        u32x4 o; o.x = pk2(acc[0], acc[1]); o.y = pk2(acc[2], acc[3]); o.z = pk2(acc[4], acc[5]); o.w = pk2(acc[6], acc[7]);
        *(u32x4*)(merged + (size_t)t * DM + d) = o;
    }
}

DI void prep_rope_token(bf16* P, float* SM, const int* pos, int t, int lane) {
    const float p = (float)pos[t];
    { const int i = lane & 15; const float inv = (float)pow(500000.0, -(double)(2 * i) / 32.0); const float ang = p * inv; double sd, cd; sincos((double)ang, &sd, &cd); const float c = (float)cd, s = (float)sd;
#pragma unroll
      for (int r = 0; r < 2; ++r) { const int pr = lane + 64 * r, hd = pr >> 4;
#pragma unroll
        for (int w = 0; w < 2; ++w) { bf16* q = P + (unsigned)t * LDP + (w ? BK_ : BQ) + hd * 128 + i; const float x1 = bf2f(q[0]), x2 = bf2f(q[16]); q[0] = f2bf(x1 * c - x2 * s); q[16] = f2bf(x2 * c + x1 * s); } } }
    { const int i = lane & 7; const float inv = (float)pow(500000.0, -(double)(2 * i) / 16.0); const float ang = p * inv; double sd, cd; sincos((double)ang, &sd, &cd); const float c = (float)cd, s = (float)sd;
      { const int hd = lane >> 3; bf16* q = P + (unsigned)t * LDP + BIQ + hd * 64 + i; const float x1 = bf2f(q[0]), x2 = bf2f(q[8]); q[0] = f2bf(x1 * c - x2 * s); q[8] = f2bf(x2 * c + x1 * s); }
      if (lane < 8) { float* q = SM + (unsigned)t * 512 + IK + i; const float x1 = q[0], x2 = q[8]; q[0] = x1 * c - x2 * s; q[8] = x2 * c + x1 * s; } }
}
DI void prep_sgu_token(bf16* P, const float* lng, const float* lnb, int t, int lane) {
    bf16* vrow = P + (unsigned)t * LDP + DV; bf16* urow = P + (unsigned)t * LDP + DU;
    float x[16]; float s = 0.f;
#pragma unroll
    for (int r = 0; r < 2; ++r) { const u32x4 w = *(const u32x4*)(vrow + 8 * lane + 512 * r);
#pragma unroll
        for (int e = 0; e < 4; ++e) { x[8 * r + 2 * e] = gelu_erf(bflo(w[e])); x[8 * r + 2 * e + 1] = gelu_erf(bfhi(w[e])); } }
#pragma unroll
    for (int e = 0; e < 16; ++e) s += x[e];
    const float mean = wave_sum(s) * (1.0f / 1024.0f); float s2 = 0.f;
#pragma unroll
    for (int e = 0; e < 16; ++e) { x[e] -= mean; s2 += x[e] * x[e]; }
    const float rstd = 1.0f / sqrtf(wave_sum(s2) * (1.0f / 1024.0f) + 1e-5f);
#pragma unroll
    for (int r = 0; r < 2; ++r) { const int c0 = 8 * lane + 512 * r; const f32x4 g0 = *(const f32x4*)(lng + c0), g1 = *(const f32x4*)(lng + c0 + 4), b0 = *(const f32x4*)(lnb + c0), b1 = *(const f32x4*)(lnb + c0 + 4);
        u32x4 o; o.x = pk2(x[8 * r + 0] * rstd * g0.x + b0.x, x[8 * r + 1] * rstd * g0.y + b0.y); o.y = pk2(x[8 * r + 2] * rstd * g0.z + b0.z, x[8 * r + 3] * rstd * g0.w + b0.w);
        o.z = pk2(x[8 * r + 4] * rstd * g1.x + b1.x, x[8 * r + 5] * rstd * g1.y + b1.y); o.w = pk2(x[8 * r + 6] * rstd * g1.z + b1.z, x[8 * r + 7] * rstd * g1.w + b1.w);
        *(u32x4*)(vrow + c0) = o; }
#pragma unroll
    for (int r = 0; r < 2; ++r) { const u32x4 w = *(const u32x4*)(urow + 8 * lane + 512 * r); u32x4 o;
#pragma unroll
        for (int e = 0; e < 4; ++e) o[e] = pk2(gelu_erf(bflo(w[e])), gelu_erf(bfhi(w[e])));
        *(u32x4*)(urow + 8 * lane + 512 * r) = o; }
}
DI void prep_unit(const Args& a, int l, int unit, LAS unsigned char* lds, int tid, int lane, int wave) {
    bf16* P = (bf16*)(a.ws + WS_P); float* SM = (float*)(a.ws + WS_SM);
    const int t0 = unit * 16, s0 = t0 & (SEQ - 1);
#pragma unroll 1
    for (int tt = 0; tt < 2; ++tt) { const int t = t0 + 2 * wave + tt; prep_rope_token(P, SM, a.pos, t, lane); prep_sgu_token(P, a.in[18] + l * BW, a.in[19] + l * BW, t, lane); }
    const float* mu = a.in[8] + l * 4288;
    LAS float* tw = (LAS float*)lds; LAS float* al = tw + 16 * 96;
    for (int e = tid; e < 16 * 96; e += 512) { const int tok = e / 96, i = e - tok * 96; const int t = t0 + tok; const bool hp = (s0 + tok) > 0;
        const float cw = SM[(unsigned)t * 512 + WLR + i], pw = hp ? SM[(unsigned)(t - 1) * 512 + WLR + i] : 0.f; tw[e] = tanhf(cw + (pw - cw) * mu[3072 + i]);
        const float ca = SM[(unsigned)t * 512 + ALR + i], pa = hp ? SM[(unsigned)(t - 1) * 512 + ALR + i] : 0.f; al[e] = ca + (pa - ca) * mu[3168 + i]; }
    __syncthreads();
    float aw[16][2], aa[16][2];
#pragma unroll
    for (int k = 0; k < 16; ++k) { aw[k][0] = 0.f; aw[k][1] = 0.f; aa[k][0] = 0.f; aa[k][1] = 0.f; }
    const float* ww2 = a.in[10] + (size_t)l * 96 * BW; const float* wa2 = a.in[12] + (size_t)l * 96 * BW;
#pragma unroll 1
    for (int i0 = 0; i0 < 96; i0 += 4) {
        float wv[4][2], av[4][2];
#pragma unroll
        for (int ii = 0; ii < 4; ++ii) { wv[ii][0] = ww2[(i0 + ii) * BW + tid]; wv[ii][1] = ww2[(i0 + ii) * BW + tid + 512]; av[ii][0] = wa2[(i0 + ii) * BW + tid]; av[ii][1] = wa2[(i0 + ii) * BW + tid + 512]; }
#pragma unroll
        for (int k = 0; k < 16; ++k) { const f32x4 x = *(const LAS f32x4*)(tw + k * 96 + i0); const f32x4 y = *(const LAS f32x4*)(al + k * 96 + i0);
#pragma unroll
            for (int ii = 0; ii < 4; ++ii) { aw[k][0] += x[ii] * wv[ii][0]; aw[k][1] += x[ii] * wv[ii][1]; aa[k][0] += y[ii] * av[ii][0]; aa[k][1] += y[ii] * av[ii][1]; } }
    }
    bf16* RWr = (bf16*)(a.ws + WS_RW); bf16* RWk = RWr + (size_t)T * 1024; bf16* RWv = RWk + (size_t)T * 1024; bf16* RWkk = RWv + (size_t)T * 1024; bf16* RWa = RWkk + (size_t)T * 1024; bf16* RWg = RWa + (size_t)T * 1024;
    float* RWw = (float*)(a.ws + WS_RW + 6 * RW_ARR);
#pragma unroll
    for (int c = 0; c < 2; ++c) {
        const int j = tid + 512 * c;
        const float w0 = a.in[9][l * BW + j], a0 = a.in[11][l * BW + j], kkc = a.in[13][l * BW + j], kac = a.in[14][l * BW + j];
        const float mr = mu[j], mk = mu[1024 + j], mv = mu[2048 + j], mg = mu[3264 + j];
#pragma unroll
        for (int k = 0; k < 16; ++k) {
            const int t = t0 + k; const bool hp = (s0 + k) > 0; const bf16* pc = P + (unsigned)t * LDP; const bf16* pp = pc - LDP;
            const float sg = sigmoidf_(w0 + aw[k][c]); const float wdec = __expf(-0.606531f * sg); const float av_ = sigmoidf_(a0 + aa[k][c]);
            const float rc = bf2f(pc[CR + j]), rp = hp ? bf2f(pp[CR + j]) : 0.f, r_l = rc + (rp - rc) * mr;
            const float kc = bf2f(pc[CK + j]), kp_ = hp ? bf2f(pp[CK + j]) : 0.f, k_l = kc + (kp_ - kc) * mk;
            const float vc = bf2f(pc[CV + j]), vp = hp ? bf2f(pp[CV + j]) : 0.f, v_l = vc + (vp - vc) * mv;
            const float gc = bf2f(pc[CG + j]), gp = hp ? bf2f(pp[CG + j]) : 0.f, g_l = gc + (gp - gc) * mg;
            const float kk = k_l * kkc, kmod = k_l * (1.0f + (av_ - 1.0f) * kac);
            const float ss = wave_sum(kk * kk); const float kkn = kk * (1.0f / sqrtf(ss + 1e-12f));
            const size_t o = (unsigned)t * 1024 + j;
            RWr[o] = f2bf(r_l); RWk[o] = f2bf(kmod); RWv[o] = f2bf(v_l); RWkk[o] = f2bf(kkn); RWa[o] = f2bf(av_); RWg[o] = f2bf(g_l); RWw[o] = wdec;
        }
    }
    __syncthreads();
}
DI void vt_unit(const Args& a, int unit, LAS unsigned char* lds, int tid) {
    const bf16* P = (const bf16*)(a.ws + WS_P); bf16* VT = (bf16*)(a.ws + WS_VT);
    const int hd = unit & 7, st = (unit >> 3) & 63, b = unit >> 9;
    LAS bf16* tile = (LAS bf16*)lds;
#pragma unroll
    for (int r = 0; r < 2; ++r) { const int ch = tid + 512 * r, s = ch >> 4, c = ch & 15;
        *(LAS u32x4*)(tile + s * 136 + 8 * c) = *(const u32x4*)(P + (unsigned)(b * SEQ + st * 64 + s) * LDP + BV + hd * 128 + 8 * c); }
    __syncthreads();
    { const int d = tid & 127, sq = tid >> 7; unsigned w[8];
#pragma unroll
      for (int i = 0; i < 8; ++i) w[i] = (unsigned)tile[(16 * sq + 2 * i) * 136 + d] | ((unsigned)tile[(16 * sq + 2 * i + 1) * 136 + d] << 16);
      bf16* o = VT + ((unsigned)((b * 8 + hd) * 128 + d)) * SEQ + st * 64 + 16 * sq;
      u32x4 o0, o1; o0.x = w[0]; o0.y = w[1]; o0.z = w[2]; o0.w = w[3]; o1.x = w[4]; o1.y = w[5]; o1.z = w[6]; o1.w = w[7];
      *(u32x4*)o = o0; *(u32x4*)(o + 8) = o1; }
    __syncthreads();
}

DI void gla_unit(const Args& a, int l, int unit, LAS unsigned char* lds, int tid, int lane, int wave) {
    const bf16* P = (const bf16*)(a.ws + WS_P); const float* SM = (const float*)(a.ws + WS_SM); bf16* YA = (bf16*)(a.ws + WS_YS);
    const int b = unit >> 2, hd = unit & 3;
    LAS float* la = (LAS float*)lds;
    LAS float* et = la + 64 * 128;
    LAS float* tot = et + 128;
    LAS float* glr = tot + 128;
    LAS float* red = glr + 64 * 16;
    LAS float* rsv = red + 512;
    LAS bf16* kdT = (LAS bf16*)(rsv + 64);
    LAS bf16* vT = kdT + 128 * 72;
    const int k2 = tid & 127, cg = tid >> 7, r32 = lane & 31, hh = lane >> 5;
    LAS float* wgl = (LAS float*)(vT + 256 * 72);
    for (int e = tid; e < 16 * 128; e += 512) wgl[e] = a.in[5][(size_t)l * 16 * 512 + (e >> 7) * 512 + hd * 128 + (e & 127)];
    const float bg = a.in[6][l * 512 + hd * 128 + k2];
    const float hg = a.in[7][l * 256 + 32 * wave + r32];
    f32x16 S[4];
#pragma unroll
    for (int kt = 0; kt < 4; ++kt)
#pragma unroll
        for (int r = 0; r < 16; ++r) S[kt][r] = 0.f;
#pragma unroll 1
    for (int c = 0; c < 64; ++c) {
        const int t0 = b * SEQ + c * 64;
        if (tid < 256) { const int tok = tid >> 2, q4 = (tid & 3) * 4; *(LAS f32x4*)(glr + tok * 16 + q4) = *(const f32x4*)(SM + (unsigned)(t0 + tok) * 512 + GLR + q4); }
        __syncthreads();
#pragma unroll 4
        for (int i = 0; i < 16; ++i) { const int tok = cg * 16 + i; float x = bg;
#pragma unroll
            for (int q = 0; q < 4; ++q) { const f32x4 gv = *(const LAS f32x4*)(glr + tok * 16 + 4 * q); x += gv.x * wgl[(4 * q) * 128 + k2] + gv.y * wgl[(4 * q + 1) * 128 + k2] + gv.z * wgl[(4 * q + 2) * 128 + k2] + gv.w * wgl[(4 * q + 3) * 128 + k2]; }
            la[tok * 128 + k2] = logsigmoidf_(x) * (1.0f / 16.0f); }
        __syncthreads();
        if (tid < 128) { float run = 0.f;
#pragma unroll 8
            for (int tok = 0; tok < 64; ++tok) { run += la[tok * 128 + tid]; la[tok * 128 + tid] = run; }
            tot[tid] = run; et[tid] = __expf(run); }
        __syncthreads();
        { const int cc = tid & 63, kg = tid >> 6;
          const bf16* kp = P + (unsigned)(t0 + cc) * LDP + AK + hd * 128 + kg * 16;
#pragma unroll
          for (int q = 0; q < 2; ++q) { const u32x4 w = *(const u32x4*)(kp + 8 * q);
#pragma unroll
              for (int e = 0; e < 4; ++e) { const int k0 = kg * 16 + 8 * q + 2 * e;
                  kdT[k0 * 72 + cc] = f2bf(bflo(w[e]) * __expf(tot[k0] - la[cc * 128 + k0]));
                  kdT[(k0 + 1) * 72 + cc] = f2bf(bfhi(w[e]) * __expf(tot[k0 + 1] - la[cc * 128 + k0 + 1])); } }
          const bf16* vp = P + (unsigned)(t0 + cc) * LDP + AV + hd * 256 + kg * 32;
#pragma unroll
          for (int q = 0; q < 4; ++q) { const u32x4 w = *(const u32x4*)(vp + 8 * q);
#pragma unroll
              for (int e = 0; e < 4; ++e) { const int v0 = kg * 32 + 8 * q + 2 * e; vT[v0 * 72 + cc] = (bf16)(w[e] & 0xffffu); vT[(v0 + 1) * 72 + cc] = (bf16)(w[e] >> 16); } } }
        __syncthreads();
        bf16x8 Bv[4];
#pragma unroll
        for (int st = 0; st < 4; ++st) Bv[st] = *(const LAS bf16x8*)(vT + (32 * wave + r32) * 72 + 16 * st + 8 * hh);
#pragma unroll
        for (int kt = 0; kt < 4; ++kt) {
#pragma unroll
            for (int g4 = 0; g4 < 4; ++g4) { const f32x4 e = *(const LAS f32x4*)(et + 32 * kt + 8 * g4 + 4 * hh);
#pragma unroll
                for (int j = 0; j < 4; ++j) S[kt][4 * g4 + j] *= e[j]; }
#pragma unroll
            for (int st = 0; st < 4; ++st) { const bf16x8 A = *(const LAS bf16x8*)(kdT + (32 * kt + r32) * 72 + 16 * st + 8 * hh); S[kt] = MFMA32(A, Bv[st], S[kt]); }
        }
        f32x16 O[2];
#pragma unroll
        for (int ct = 0; ct < 2; ++ct) {
#pragma unroll
            for (int r = 0; r < 16; ++r) O[ct][r] = 0.f;
#pragma unroll
            for (int kt = 0; kt < 4; ++kt)
#pragma unroll
                for (int s = 0; s < 2; ++s) { const bf16x8 Bf = pack_step(S[kt], s);
                    const bf16* qp = P + (unsigned)(t0 + 32 * ct + r32) * LDP + AQ + hd * 128 + 32 * kt + 16 * s + 4 * hh;
                    const bf16x8 A = join8(*(const u32x2*)qp, *(const u32x2*)(qp + 8)); O[ct] = MFMA32(A, Bf, O[ct]); asm volatile("" ::: "memory"); }
        }
#pragma unroll
        for (int ct = 0; ct < 2; ++ct)
#pragma unroll
            for (int r = 0; r < 16; ++r) { const float o = O[ct][r] * 0.08838834764831845f; O[ct][r] = o; const float p = half_sum(o * o); if (r32 == 0) red[wave * 64 + 32 * ct + crow(r, hh)] = p; }
        __syncthreads();
        if (tid < 64) { float s = 0.f;
#pragma unroll
            for (int w = 0; w < 8; ++w) s += red[w * 64 + tid];
            rsv[tid] = 1.0f / sqrtf(s * (1.0f / 256.0f) + 1e-6f); }
        __syncthreads();
#pragma unroll
        for (int ct = 0; ct < 2; ++ct)
#pragma unroll
            for (int g4 = 0; g4 < 4; ++g4) { const f32x4 rs = *(const LAS f32x4*)(rsv + 32 * ct + 8 * g4 + 4 * hh);
#pragma unroll
                for (int j = 0; j < 4; ++j) { const int t = t0 + 32 * ct + 8 * g4 + 4 * hh + j, col = hd * 256 + 32 * wave + r32;
                    const float gt = bf2f(P[(unsigned)t * LDP + AG + col]); YA[(unsigned)t * 1024 + col] = f2bf(O[ct][4 * g4 + j] * rs[j] * hg * siluf_(gt)); } }
    }
    __syncthreads();
}

DI void rwkv_unit(const Args& a, int l, int unit, LAS unsigned char* lds, int tid, int lane, int wave) {
    constexpr int TB = 32;
    const bf16* RWr = (const bf16*)(a.ws + WS_RW); const bf16* RWk = RWr + (size_t)T * 1024; const bf16* RWv = RWk + (size_t)T * 1024; const bf16* RWkk = RWv + (size_t)T * 1024; const bf16* RWa = RWkk + (size_t)T * 1024; const bf16* RWg = RWa + (size_t)T * 1024;
    const float* RWw = (const float*)(a.ws + WS_RW + 6 * RW_ARR);
    bf16* YC = (bf16*)(a.ws + WS_YS) + (size_t)2 * T * 1024;
    const int b = unit >> 4, hd = unit & 15;
    const int rg = lane >> 4, ks = lane & 15, row0 = 8 * wave + 2 * rg;
    LAS float* op = (LAS float*)lds;
    LAS float* vv = op + TB * 320;
    LAS float* yb = vv + TB * 64;
    LAS float* gl = yb + TB * 64;
    float S0[4] = {0.f, 0.f, 0.f, 0.f}, S1[4] = {0.f, 0.f, 0.f, 0.f};
    const int pt = tid >> 4, p4 = (tid & 15) * 4;
    const f32x4 rk4 = *(const f32x4*)(a.in[15] + l * 1024 + hd * 64 + p4), lg4 = *(const f32x4*)(a.in[16] + l * 1024 + hd * 64 + p4), lb4 = *(const f32x4*)(a.in[17] + l * 1024 + hd * 64 + p4);
#pragma unroll 1
    for (int blk = 0; blk < SEQ / TB; ++blk) {
        const int tb = b * SEQ + blk * TB;
        { const size_t g = (unsigned)(tb + pt) * 1024 + hd * 64 + p4;
          const u32x2 wr = *(const u32x2*)(RWr + g), wk = *(const u32x2*)(RWk + g), wv = *(const u32x2*)(RWv + g), wkk = *(const u32x2*)(RWkk + g), wa = *(const u32x2*)(RWa + g), wg = *(const u32x2*)(RWg + g);
          const f32x4 wd = *(const f32x4*)(RWw + g);
          f32x4 kk4, a4, o; kk4.x = bflo(wkk.x); kk4.y = bfhi(wkk.x); kk4.z = bflo(wkk.y); kk4.w = bfhi(wkk.y); a4.x = bflo(wa.x); a4.y = bfhi(wa.x); a4.z = bflo(wa.y); a4.w = bfhi(wa.y);
          LAS float* q = op + pt * 320 + p4;
          *(LAS f32x4*)(q) = -kk4; *(LAS f32x4*)(q + 64) = wd; *(LAS f32x4*)(q + 128) = kk4 * a4;
          o.x = bflo(wk.x); o.y = bfhi(wk.x); o.z = bflo(wk.y); o.w = bfhi(wk.y); *(LAS f32x4*)(q + 192) = o;
          o.x = bflo(wr.x); o.y = bfhi(wr.x); o.z = bflo(wr.y); o.w = bfhi(wr.y); *(LAS f32x4*)(q + 256) = o;
          o.x = bflo(wv.x); o.y = bfhi(wv.x); o.z = bflo(wv.y); o.w = bfhi(wv.y); *(LAS f32x4*)(vv + pt * 64 + p4) = o;
          o.x = bflo(wg.x); o.y = bfhi(wg.x); o.z = bflo(wg.y); o.w = bfhi(wg.y); *(LAS f32x4*)(gl + pt * 64 + p4) = o; }
        __syncthreads();
#pragma unroll 4
        for (int t = 0; t < TB; ++t) {
            const LAS float* o = op + t * 320 + 4 * ks;
            const f32x4 nk = *(const LAS f32x4*)(o), w = *(const LAS f32x4*)(o + 64), ka = *(const LAS f32x4*)(o + 128), kk = *(const LAS f32x4*)(o + 192), r = *(const LAS f32x4*)(o + 256);
            const f32x2 v2 = *(const LAS f32x2*)(vv + t * 64 + row0);
            float sa0 = (S0[0] * nk.x + S0[1] * nk.y) + (S0[2] * nk.z + S0[3] * nk.w), sa1 = (S1[0] * nk.x + S1[1] * nk.y) + (S1[2] * nk.z + S1[3] * nk.w);
            sa0 = row16_sum(sa0); sa1 = row16_sum(sa1);
#pragma unroll
            for (int i = 0; i < 4; ++i) { S0[i] = S0[i] * w[i] + sa0 * ka[i] + v2.x * kk[i]; S1[i] = S1[i] * w[i] + sa1 * ka[i] + v2.y * kk[i]; }
            float y0 = (S0[0] * r.x + S0[1] * r.y) + (S0[2] * r.z + S0[3] * r.w), y1 = (S1[0] * r.x + S1[1] * r.y) + (S1[2] * r.z + S1[3] * r.w);
            y0 = row16_sum(y0); y1 = row16_sum(y1);
            if (ks == 0) { f32x2 yy; yy.x = y0; yy.y = y1; *(LAS f32x2*)(yb + t * 64 + row0) = yy; }
        }
        __syncthreads();
        { const f32x4 y = *(const LAS f32x4*)(yb + pt * 64 + p4);
          const float mean = row16_sum((y.x + y.y) + (y.z + y.w)) * (1.0f / 64.0f); const f32x4 d = y - mean;
          const float var = row16_sum((d.x * d.x + d.y * d.y) + (d.z * d.z + d.w * d.w)) * (1.0f / 64.0f); const float rstd = 1.0f / sqrtf(var + 64e-5f);
          const f32x4 rr = *(const LAS f32x4*)(op + pt * 320 + 256 + p4), kk = *(const LAS f32x4*)(op + pt * 320 + 192 + p4);
          const float bs = row16_sum((rr.x * kk.x * rk4.x + rr.y * kk.y * rk4.y) + (rr.z * kk.z * rk4.z + rr.w * kk.w * rk4.w));
          const f32x4 v4 = *(const LAS f32x4*)(vv + pt * 64 + p4), g4 = *(const LAS f32x4*)(gl + pt * 64 + p4);
          f32x4 o = d * rstd * lg4 + lb4 + bs * v4;
          u32x2 w; w.x = pk2(o.x * siluf_(g4.x), o.y * siluf_(g4.y)); w.y = pk2(o.z * siluf_(g4.z), o.w * siluf_(g4.w));
          *(u32x2*)(YC + (unsigned)(tb + pt) * 1024 + hd * 64 + p4) = w; }
        __syncthreads();
    }
}

DI void sgu_unit(const Args& a, int l, int unit, LAS unsigned char* lds, int tid, int lane, int wave) {
    const bf16* P = (const bf16*)(a.ws + WS_P); bf16* YD = (bf16*)(a.ws + WS_YS) + (size_t)3 * T * 1024;
    const bf16* wsb = (const bf16*)(a.ws + WS_WSB) + (size_t)l * 8 * 128 * 128;
    const int g = unit & 7, ch = (unit >> 3) & 31, b = unit >> 8;
    const int t0 = b * SEQ + ch * 128, r32 = lane & 31, hh = lane >> 5;
    LAS bf16* vt = (LAS bf16*)lds;
#pragma unroll
    for (int r = 0; r < 4; ++r) { const int cidx = tid + 512 * r, j = cidx >> 4, c = cidx & 15;
        *(LAS u32x4*)(vt + j * 136 + 8 * c) = *(const u32x4*)(P + (unsigned)(t0 + j) * LDP + DV + g * 128 + 8 * c); }
    __syncthreads();
    const int it = wave >> 1, dt0 = (wave & 1) * 2;
    f32x16 acc[2];
#pragma unroll
    for (int x = 0; x < 2; ++x)
#pragma unroll
        for (int r = 0; r < 16; ++r) acc[x][r] = 0.f;
#pragma unroll
    for (int st = 0; st < 8; ++st) {
        const bf16x8 A = *(const bf16x8*)(wsb + ((unsigned)g * 128 + 32 * it + r32) * 128 + 16 * st + 8 * hh);
#pragma unroll
        for (int x = 0; x < 2; ++x) { const int d = 32 * (dt0 + x) + r32; u32x4 w;
#pragma unroll
            for (int e = 0; e < 4; ++e) { const int j = 16 * st + 8 * hh + 2 * e; w[e] = (unsigned)vt[j * 136 + d] | ((unsigned)vt[(j + 1) * 136 + d] << 16); }
            acc[x] = MFMA32(A, __builtin_bit_cast(bf16x8, w), acc[x]); }
    }
    const float* bs = a.in[21] + (size_t)l * 8 * 128 + g * 128;
#pragma unroll
    for (int x = 0; x < 2; ++x)
#pragma unroll
        for (int r = 0; r < 16; ++r) { const int i = 32 * it + crow(r, hh), t = t0 + i, col = g * 128 + 32 * (dt0 + x) + r32;
            const float sv = acc[x][r] + bs[i]; const float u = bf2f(P[(unsigned)t * LDP + DU + col]), gt = bf2f(P[(unsigned)t * LDP + DG + col]);
            YD[(unsigned)t * 1024 + col] = f2bf(u * sv * siluf_(gt)); }
    __syncthreads();
}

DI unsigned f2key(float f) { const unsigned u = __float_as_uint(f); return (u & 0x80000000u) ? ~u : (u | 0x80000000u); }
DI void dsa_index_unit(const Args& a, int unit, LAS unsigned char* lds, int tid, int lane, int wave) {
    const bf16* P = (const bf16*)(a.ws + WS_P); const float* SM = (const float*)(a.ws + WS_SM);
    const int b = unit >> 6, jq = 63 - (unit & 63);
    const int nch = jq + 1, nk = 64 * nch, ntile = 2 * nch, tq0 = b * SEQ + jq * 64;
    float* SCu = (float*)(a.ws + WS_SC) + (size_t)b * (4096 * 2080) + (unsigned)(jq * (jq + 1) / 2) * 4096;
    unsigned long long* BM = (unsigned long long*)(a.ws + WS_BM);
    const int r32 = lane & 31, hh = lane >> 5;
    LAS bf16* iql = (LAS bf16*)lds;
#pragma unroll
    for (int r = 0; r < 8; ++r) { const int cidx = tid + 512 * r, q = cidx >> 6, c = cidx & 63;
        *(LAS u32x4*)(iql + q * 520 + 8 * c) = *(const u32x4*)(P + (unsigned)(tq0 + q) * LDP + BIQ + 8 * c); }
    __syncthreads();
#pragma unroll 1
    for (int kt = wave; kt < ntile; kt += 8) {
        const int ts = b * SEQ + 32 * kt + r32;
        bf16x8 Ak[4];
#pragma unroll
        for (int st = 0; st < 4; ++st) { const float* p = SM + (unsigned)ts * 512 + IK + 16 * st + 8 * hh; Ak[st] = pack8f(*(const f32x4*)p, *(const f32x4*)(p + 4)); }
#pragma unroll 1
        for (int qh = 0; qh < 2; ++qh) {
            const int tq = tq0 + 32 * qh + r32;
            const f32x4 w0 = *(const f32x4*)(SM + (unsigned)tq * 512 + IW), w1 = *(const f32x4*)(SM + (unsigned)tq * 512 + IW + 4);
            f32x16 sc;
#pragma unroll
            for (int r = 0; r < 16; ++r) sc[r] = 0.f;
#pragma unroll
            for (int h8 = 0; h8 < 8; ++h8) { f32x16 acc;
#pragma unroll
                for (int r = 0; r < 16; ++r) acc[r] = 0.f;
#pragma unroll
                for (int st = 0; st < 4; ++st) { const bf16x8 Bq = *(const LAS bf16x8*)(iql + (32 * qh + r32) * 520 + h8 * 64 + 16 * st + 8 * hh); acc = MFMA32(Ak[st], Bq, acc); }
                const float wq = (h8 < 4 ? w0[h8 & 3] : w1[h8 & 3]) * 0.044194173824159216f;
#pragma unroll
                for (int r = 0; r < 16; ++r) sc[r] += wq * fmaxf(acc[r], 0.f); }
#pragma unroll
            for (int g4 = 0; g4 < 4; ++g4) { f32x4 o; o.x = sc[4 * g4]; o.y = sc[4 * g4 + 1]; o.z = sc[4 * g4 + 2]; o.w = sc[4 * g4 + 3];
                *(f32x4*)(SCu + (unsigned)(32 * qh + r32) * nk + 32 * kt + 8 * g4 + 4 * hh) = o; }
        }
    }
    __syncthreads();
    LAS unsigned* keys = (LAS unsigned*)(lds + wave * 16384);
#pragma unroll 1
    for (int qi = wave; qi < 64; qi += 8) {
        const float* row = SCu + (unsigned)qi * nk;
        unsigned long long myword = 0ull;
        if (nch <= 4) { myword = ~0ull; }
        else {
#pragma unroll 4
            for (int i = 0; i < nch; ++i) keys[i * 64 + lane] = f2key(row[64 * i + lane]);
            unsigned tau = 0u; int cnt_ge = 0;
#pragma unroll 1
            for (int bit = 31; bit >= 0; --bit) {
                const unsigned cand = tau | (1u << bit); int c = 0;
#pragma unroll 4
                for (int i = 0; i < nch; ++i) c += __builtin_popcountll(__ballot(keys[i * 64 + lane] >= cand));
                if (c >= 256) { tau = cand; cnt_ge = c; if (c == 256) break; }
            }
            if (cnt_ge == 256) {
#pragma unroll 4
                for (int i = 0; i < nch; ++i) { const unsigned long long m = __ballot(keys[i * 64 + lane] >= tau); myword = (lane == i) ? m : myword; }
            } else {
                int n_gt = 0;
#pragma unroll 1
                for (int i = 0; i < nch; ++i) n_gt += __builtin_popcountll(__ballot(keys[i * 64 + lane] > tau));
                int quota = 256 - n_gt;
#pragma unroll 1
                for (int i = 0; i < nch; ++i) { const unsigned kv = keys[i * 64 + lane]; const unsigned long long m_gt = __ballot(kv > tau); unsigned long long m_eq = __ballot(kv == tau), take = 0ull;
                    const int ne = __builtin_popcountll(m_eq);
                    if (ne <= quota) { take = m_eq; quota -= ne; } else { while (quota > 0) { const unsigned long long low = m_eq & (0ull - m_eq); take |= low; m_eq ^= low; --quota; } }
                    myword = (lane == i) ? (m_gt | take) : myword; }
            }
        }
        if (lane < nch) BM[(unsigned)(tq0 + qi) * 64 + lane] = myword;
    }
    __syncthreads();
}

DI void dsa_attn_unit(const Args& a, int unit, int lane, int wave) {
    const bf16* P = (const bf16*)(a.ws + WS_P); const bf16* VT = (const bf16*)(a.ws + WS_VT); const unsigned* BM32 = (const unsigned*)(a.ws + WS_BM);
    bf16* YB = (bf16*)(a.ws + WS_YS) + (size_t)T * 1024;
    const int qg = 15 - (unit >> 5), bh = unit & 31, b = bh >> 3, hd = bh & 7;
    const int qb32 = qg * 8 + wave, q0 = 32 * qb32, ntile = 2 * ((qb32 >> 1) + 1);
    const int r32 = lane & 31, hh = lane >> 5;
    const int tq = b * SEQ + q0 + r32;
    bf16x8 Bq[8];
#pragma unroll
    for (int st = 0; st < 8; ++st) Bq[st] = *(const bf16x8*)(P + (unsigned)tq * LDP + BQ + hd * 128 + 16 * st + 8 * hh);
    f32x16 O[4];
#pragma unroll
    for (int dt = 0; dt < 4; ++dt)
#pragma unroll
        for (int r = 0; r < 16; ++r) O[dt][r] = 0.f;
    float m = -1e30f, lsum = 0.f;
    const float sc2 = 0.08838834764831845f * 1.4426950408889634f;
    const bf16* vbase = VT + ((unsigned)((b * 8 + hd) * 128 + r32)) * SEQ + 4 * hh;
#pragma unroll 1
    for (int kt = 0; kt < ntile; ++kt) {
        const int ts = b * SEQ + 32 * kt + r32;
        f32x16 s;
#pragma unroll
        for (int r = 0; r < 16; ++r) s[r] = 0.f;
#pragma unroll
        for (int st = 0; st < 8; ++st) { const bf16x8 A = *(const bf16x8*)(P + (unsigned)ts * LDP + BK_ + hd * 128 + 16 * st + 8 * hh); s = MFMA32(A, Bq[st], s); }
        const unsigned mw = BM32[(unsigned)tq * 128 + kt];
        float tmax = -1e30f;
#pragma unroll
        for (int r = 0; r < 16; ++r) { const bool sel = (mw >> crow(r, hh)) & 1u; const float x = sel ? s[r] * sc2 : -INFINITY; s[r] = x; tmax = fmaxf(tmax, x); }
        tmax = fmaxf(tmax, __shfl_xor(tmax, 32));
        const float mn = fmaxf(m, tmax), alpha = __builtin_amdgcn_exp2f(m - mn); m = mn;
        float ps = 0.f;
#pragma unroll
        for (int r = 0; r < 16; ++r) { const float p = __builtin_amdgcn_exp2f(s[r] - mn); s[r] = p; ps += p; }
        lsum = lsum * alpha + ps;
#pragma unroll
        for (int dt = 0; dt < 4; ++dt)
#pragma unroll
            for (int r = 0; r < 16; ++r) O[dt][r] *= alpha;
#pragma unroll
        for (int ss = 0; ss < 2; ++ss) { const bf16x8 Bp = pack_step(s, ss);
#pragma unroll
            for (int dt = 0; dt < 4; ++dt) { const bf16* vp = vbase + (unsigned)(32 * dt) * SEQ + 32 * kt + 16 * ss;
                const bf16x8 A = join8(*(const u32x2*)vp, *(const u32x2*)(vp + 8)); O[dt] = MFMA32(A, Bp, O[dt]); } }
    }
    lsum += __shfl_xor(lsum, 32);
    const float inv = 1.0f / lsum;
#pragma unroll
    for (int dt = 0; dt < 4; ++dt)
#pragma unroll
        for (int g4 = 0; g4 < 4; ++g4) { const int col = hd * 128 + 32 * dt + 8 * g4 + 4 * hh;
            const u32x2 gw = *(const u32x2*)(P + (unsigned)tq * LDP + BG + col);
            u32x2 w; w.x = pk2(O[dt][4 * g4] * inv * siluf_(bflo(gw.x)), O[dt][4 * g4 + 1] * inv * siluf_(bfhi(gw.x))); w.y = pk2(O[dt][4 * g4 + 2] * inv * siluf_(bflo(gw.y)), O[dt][4 * g4 + 3] * inv * siluf_(bfhi(gw.y)));
            *(u32x2*)(YB + (unsigned)tq * 1024 + col) = w; }
}

DI int queue_next(unsigned* head, volatile LAS unsigned* slot, int tid) {
    __syncthreads();
    if (tid == 0) *slot = __hip_atomic_fetch_add(head, 1u, __ATOMIC_RELAXED, __HIP_MEMORY_SCOPE_AGENT);
    __syncthreads();
    return (int)*slot;
}

template <unsigned PMASK> DI void fwd_body(const Args& a) {
    extern __shared__ __attribute__((aligned(16))) unsigned char lds_raw[];
    LAS unsigned char* lds = (LAS unsigned char*)lds_raw;
    volatile LAS unsigned* MISC = (volatile LAS unsigned*)(lds + MISC_OFF);
    const int tid = threadIdx.x, lane = tid & 63, wave = __builtin_amdgcn_readfirstlane(tid >> 6), bid = blockIdx.x, G = gridDim.x;
    unsigned* ctl = (unsigned*)(a.ws + WS_CTL);
    if (tid < 64) MISC[tid] = 0u;
    __syncthreads();
    const bool one_launch = (a.ph_hi - a.ph_lo) > 1;
    XcdBarrier bar; bar.bar = ctl + CW_BAR; bar.x = 0; bar.st = nullptr;
    if (one_launch) bar = xcd_barrier_post(ctl + CW_BAR, MISC + 8);
    const int lo = a.ph_lo, hi = a.ph_hi;
#define IN0 ((PMASK & 1u) && lo <= 0 && 0 < hi)
#define INL(j) (((PMASK >> ((j) + 1)) & 1u) && lo <= pb + (j) && pb + (j) < hi)
#define SEAM(k) do { if (lo <= (k) && (k) + 1 < hi) xcd_barrier(bar); } while (0)
    const int gw = bid * 8 + wave, NGW = G * 8;

    if (IN0) { phase_prologue(a, lds, tid, lane, wave, bid, G); SEAM(0); }

#pragma unroll 1
    for (int l = 0; l < 2; ++l) {
        const int pb = 1 + 10 * l;
        const float* xin = l == 0 ? a.in[0] : a.out;
        if (INL(0)) { phase_prenorm(xin, a.in[2] + l * DM, (bf16*)(a.ws + WS_H), gw, NGW, lane); SEAM(pb + 0); }
        if (INL(1)) {
            pg8::Gemm g{(const pg8::bf16_t*)(a.ws + WS_H), (const pg8::bf16_t*)(a.ws + WS_WT1) + (size_t)l * N1 * DM, T, N1, DM, 0, 0};
            pg8::StaticOrder S; S.init(T, N1, G, bid);
            Epi<0> E{a.ws + WS_P, (float*)(a.ws + WS_SM)};
            pg8::gemm_phase<Epi<0>, pg8::StaticOrder, false>(lds, g, S, E, nullptr);
            SEAM(pb + 1);
        }
        if (INL(2)) {
            for (int u = bid; u < T / 16; u += G) prep_unit(a, l, u, lds, tid, lane, wave);
            for (int u = bid; u < 2048; u += G) vt_unit(a, u, lds, tid);
            SEAM(pb + 2);
        }
        if (INL(3)) {
            if (PMASK & (1u << 11)) { unsigned* head = ctl + CW_Q + 64 * (8 * l + 0); for (;;) { const int u = queue_next(head, MISC + 4, tid); if (u >= 64) break; rwkv_unit(a, l, u, lds, tid, lane, wave); } }
            if (PMASK & (1u << 12)) { unsigned* head = ctl + CW_Q + 64 * (8 * l + 1); for (;;) { const int u = queue_next(head, MISC + 4, tid); if (u >= 16) break; gla_unit(a, l, u, lds, tid, lane, wave); } }
            if (PMASK & (1u << 13)) { unsigned* head = ctl + CW_Q + 64 * (8 * l + 2); for (;;) { const int u = queue_next(head, MISC + 4, tid); if (u >= 256) break; dsa_index_unit(a, u, lds, tid, lane, wave); } }
            if (PMASK & (1u << 14)) { unsigned* head = ctl + CW_Q + 64 * (8 * l + 3); for (;;) { const int u = queue_next(head, MISC + 4, tid); if (u >= 1024) break; sgu_unit(a, l, u, lds, tid, lane, wave); } }
            SEAM(pb + 3);
        }
        if (INL(4)) {
            unsigned* head = ctl + CW_Q + 64 * (8 * l + 4);
            for (;;) { const int u = queue_next(head, MISC + 4, tid); if (u >= 512) break; dsa_attn_unit(a, u, lane, wave); }
            SEAM(pb + 4);
        }
        if (INL(5)) {
            pg8::Gemm g{(const pg8::bf16_t*)(a.ws + WS_YS), (const pg8::bf16_t*)(a.ws + WS_WTP) + ((size_t)l << 23), T, 4 * DM, BW, 8, (size_t)T * BW * 2};
            pg8::StaticOrder S; S.init(T, 4 * DM, G, bid);
            Epi<1> E{a.ws + WS_P, nullptr};
            pg8::gemm_phase<Epi<1>, pg8::StaticOrder, false>(lds, g, S, E, nullptr);
            SEAM(pb + 5);
        }
        if (INL(6)) {
            pg8::Gemm g{(const pg8::bf16_t*)(a.ws + WS_H), (const pg8::bf16_t*)(a.ws + WS_WTM) + (size_t)l * NM * DM, T, NM, DM, 0, 0};
            pg8::StaticOrder S; S.init(T, NM, G, bid);
            Epi<2> E{a.ws + WS_RW, nullptr};
            pg8::gemm_phase<Epi<2>, pg8::StaticOrder, false>(lds, g, S, E, nullptr);
            SEAM(pb + 6);
        }
        if (INL(7)) { phase_merge((const bf16*)(a.ws + WS_RW), (const bf16*)(a.ws + WS_P), (bf16*)(a.ws + WS_H), bid * 512 + tid, G * 512); SEAM(pb + 7); }
        if (INL(8)) {
            pg8::Gemm g{(const pg8::bf16_t*)(a.ws + WS_H), (const pg8::bf16_t*)(a.ws + WS_WTO) + ((size_t)l << 22), T, DM, DM, 0, 0};
            pg8::StaticOrder S; S.init(T, DM, G, bid);
            Epi<3> E{a.ws + WS_SC, nullptr};
            pg8::gemm_phase<Epi<3>, pg8::StaticOrder, false>(lds, g, S, E, nullptr);
            SEAM(pb + 8);
        }
        if (INL(9)) { phase_postnorm(xin, (const float*)(a.ws + WS_SC), a.in[3] + l * DM, a.out, gw, NGW, lane); SEAM(pb + 9); }
    }
#undef IN0
#undef INL
#undef SEAM
}

#if defined(ONE_LAUNCH) || defined(ANALYZE)
__global__ void __launch_bounds__(512, 2) fwd(Args a) { fwd_body<0x7fffu>(a); }
#endif
#if !defined(ONE_LAUNCH)
__global__ void __launch_bounds__(512, 2) fwd_p0(Args a) { fwd_body<1u << 0>(a); }
__global__ void __launch_bounds__(512, 2) fwd_p1(Args a) { fwd_body<1u << 1>(a); }
__global__ void __launch_bounds__(512, 2) fwd_p2(Args a) { fwd_body<1u << 2>(a); }
__global__ void __launch_bounds__(512, 2) fwd_p3(Args a) { fwd_body<1u << 3>(a); }
__global__ void __launch_bounds__(512, 2) fwd_p4a(Args a) { fwd_body<(1u << 4) | (1u << 11)>(a); }
__global__ void __launch_bounds__(512, 2) fwd_p4b(Args a) { fwd_body<(1u << 4) | (1u << 12)>(a); }
__global__ void __launch_bounds__(512, 2) fwd_p4c(Args a) { fwd_body<(1u << 4) | (1u << 13)>(a); }
__global__ void __launch_bounds__(512, 2) fwd_p4d(Args a) { fwd_body<(1u << 4) | (1u << 14)>(a); }
__global__ void __launch_bounds__(512, 2) fwd_p5(Args a) { fwd_body<1u << 5>(a); }
__global__ void __launch_bounds__(512, 2) fwd_p6(Args a) { fwd_body<1u << 6>(a); }
__global__ void __launch_bounds__(512, 2) fwd_p7(Args a) { fwd_body<1u << 7>(a); }
__global__ void __launch_bounds__(512, 2) fwd_p8(Args a) { fwd_body<1u << 8>(a); }
__global__ void __launch_bounds__(512, 2) fwd_p9(Args a) { fwd_body<1u << 9>(a); }
__global__ void __launch_bounds__(512, 2) fwd_p10(Args a) { fwd_body<1u << 10>(a); }
#endif
typedef void (*kern_t)(Args);
extern "C" void kernel_launch(void* const* d_in, const int* in_sizes, int n_in, void* d_out, int out_size, void* d_ws, size_t ws_size, hipStream_t stream) {
    static int grid = 0;
#if defined(ONE_LAUNCH)
    static const kern_t kerns[1] = {fwd};
    constexpr int NK = 1;
#else
    static const kern_t kerns[14] = {fwd_p0, fwd_p1, fwd_p2, fwd_p3, fwd_p4a, fwd_p4b, fwd_p4c, fwd_p4d, fwd_p5, fwd_p6, fwd_p7, fwd_p8, fwd_p9, fwd_p10};
    constexpr int NK = 14;
#endif
    if (grid == 0) {
        if (n_in != 24 || out_size != T * DM || ws_size < WS_END) { fprintf(stderr, "kernel_launch: unexpected shapes (n_in %d out %d ws %zu, need %zu)\n", n_in, out_size, ws_size, (size_t)WS_END); grid = -1; return; }
        int dev = 0, cus = 0, per_cu = 0;
        if (hipGetDevice(&dev) != hipSuccess || hipDeviceGetAttribute(&cus, hipDeviceAttributeMultiprocessorCount, dev) != hipSuccess) { grid = -1; return; }
        for (int k = 0; k < NK; ++k)
            if (hipFuncSetAttribute((const void*)kerns[k], hipFuncAttributeMaxDynamicSharedMemorySize, LDS_BYTES) != hipSuccess) { fprintf(stderr, "kernel_launch: hipFuncSetAttribute failed\n"); grid = -1; return; }
        if (hipOccupancyMaxActiveBlocksPerMultiprocessor(&per_cu, (const void*)kerns[0], 512, LDS_BYTES) != hipSuccess || per_cu < 1) { fprintf(stderr, "kernel_launch: occupancy query says %d\n", per_cu); }
        (void)hipGetLastError();
        grid = cus;
    }
    if (grid < 0) return;
    (void)hipMemsetAsync((char*)d_ws + WS_CTL, 0, CTL_BYTES, stream);
    Args a{};
    for (int i = 0; i < 24; ++i) a.in[i] = (const float*)d_in[i];
    a.pos = (const int*)d_in[1]; a.out = (float*)d_out; a.ws = (unsigned char*)d_ws;
#if defined(ONE_LAUNCH)
    a.ph_lo = 0; a.ph_hi = NPHASE; hipLaunchKernelGGL(fwd, dim3(grid), dim3(512), LDS_BYTES, stream, a);
#else
    a.ph_lo = 0; a.ph_hi = 1; hipLaunchKernelGGL(fwd_p0, dim3(grid), dim3(512), LDS_BYTES, stream, a);
    for (int l = 0; l < 2; ++l) {
        static const int phase_of[13] = {0, 1, 2, 3, 3, 3, 3, 4, 5, 6, 7, 8, 9};
        for (int k = 0; k < 13; ++k) { a.ph_lo = 1 + 10 * l + phase_of[k]; a.ph_hi = a.ph_lo + 1; hipLaunchKernelGGL(kerns[1 + k], dim3(grid), dim3(512), LDS_BYTES, stream, a); }
    }
#endif
}
```

```cpp
#include <hip/hip_runtime.h>
#include <cstdio>
#include <cstdint>
#define ONE_LAUNCH 1


#ifndef PG8_WGM
#define PG8_WGM 8
#endif
namespace pg8 {
#define PG8_LAS __attribute__((address_space(3)))
typedef unsigned short bf16_t;
typedef short bf16x8 __attribute__((ext_vector_type(8)));
typedef float f32x4 __attribute__((ext_vector_type(4)));
typedef unsigned u32x4 __attribute__((ext_vector_type(4)));
constexpr int BM = 256, BK = 64, HALF = 128, HTB = HALF * BK * 2  , STAGE_BYTES = 8 * HTB, NXCD = 8, WGM = PG8_WGM;

__host__ __device__ __forceinline__ int lds_byte(int r, int c) { const int st = (r >> 4) * 2 + (c >> 5), rr = r & 15, cc = c & 31, ob = rr * 64 + cc * 2; return st * 1024 + (ob ^ (((ob >> 9) & 1) << 5)); }
__host__ __device__ __forceinline__ void stage_rc(int b, int& R, int& C) { const int st = b / 1024, sb = b % 1024, swz = sb ^ (((sb >> 9) & 1) << 5); R = (st >> 1) * 16 + swz / 64; C = (st & 1) * 32 + (swz % 64) / 2; }
__host__ __device__ __forceinline__ int perm32(int rho) { const int n = rho >> 4, i = rho & 15; return 8 * (i >> 2) + 4 * n + (i & 3); }

struct Unit { int pm, pn; };
struct Gemm { const bf16_t* A; const bf16_t* Bt; int M, N, K; int npg; size_t a_gstride; };

struct StaticOrder {
    int nM, nN, nwg, G, c;
    __host__ __device__ void init(int M, int N, int G_, int c_) { nM = M / BM; nN = N / BM; nwg = nM * nN; G = G_; c = c_; }
    __host__ __device__ bool next(int i, Unit& u) const {
        const long L = (long)i * G + c; if (L >= nwg) return false;
        int wgid = (int)L; { const int q = nwg / NXCD, r = nwg % NXCD, xcd = wgid % NXCD, off = wgid / NXCD; wgid = (xcd < r ? xcd * (q + 1) : r * (q + 1) + (xcd - r) * q) + off; }
        const int nig = WGM * nN, gid = wgid / nig, fm = gid * WGM, gsz = (nM - fm) < WGM ? (nM - fm) : WGM;
        u.pm = fm + ((wgid % nig) % gsz); u.pn = (wgid % nig) / gsz; return true;
    }
    __device__ __forceinline__ void a_ready(const Unit&) const {}
    __device__ __forceinline__ void done(const Unit&) const {}
};
template <class Epi, class Sched, bool STAMP = false>
__device__ __forceinline__ void gemm_phase(PG8_LAS unsigned char* lds, const Gemm g, const Sched& S, const Epi& E, unsigned long long* stamps) {
    int tid_l = threadIdx.x; asm volatile("" : "+v"(tid_l));
    const int tid = tid_l, wid = __builtin_amdgcn_readfirstlane(tid >> 6), lane = tid & 63, wr = wid >> 2, wc = wid & 3, fr = lane & 15, fq = lane >> 4;
    const int K = g.K, nt = K / BK;
    int ts_lo = 0, ts_hi = 0, nts = 0; const unsigned long long rt_entry = STAMP ? (unsigned long long)wall_clock64() : 0ull;
#define PG8_STAMP() do { if (STAMP && wid == 0 && nts < 64) { const unsigned long long _c = (unsigned long long)clock64(); \
        ts_lo = (lane == nts) ? (int)(unsigned)_c : ts_lo; ts_hi = (lane == nts) ? (int)(unsigned)(_c >> 32) : ts_hi; ++nts; } } while (0)
    PG8_STAMP();
    unsigned voffA[2], voffB[2];
#pragma unroll
    for (int i = 0; i < 2; ++i) { int R, C; stage_rc(tid * 16 + i * 8192, R, C); const int Rb = Epi::PERM ? ((R & ~31) + perm32(R & 31)) : R;
        voffA[i] = (unsigned)(R * K + C) * 2u; voffB[i] = (unsigned)(Rb * K + C) * 2u; }
    const size_t kstep = (size_t)(BK * 2);
    const size_t hstep = (size_t)HALF * K * 2;
    const size_t tstep = 2 * hstep;
    const unsigned ldsw = (unsigned)wid * 1024u;
    const int aoff = lds_byte(wr * 64 + fr, fq * 8), boff = lds_byte(wc * 32 + fr, fq * 8);
#define PG8_SA(b, h) (((b) * 2 + (h)) * HTB)
#define PG8_SB(b, h) ((4 + (b) * 2 + (h)) * HTB)
#define PG8_STAGE(bufoff, gbase, voff) do { _Pragma("unroll") for (int _i = 0; _i < 2; ++_i) \
        __builtin_amdgcn_global_load_lds((const unsigned*)((const char*)(gbase) + (voff)[_i]), (PG8_LAS unsigned*)(lds + (bufoff) + ldsw + _i * 8192), 16, 0, 0); } while (0)
#define PG8_LDA(dst, b, h) do { _Pragma("unroll") for (int m = 0; m < 4; ++m) _Pragma("unroll") for (int k = 0; k < 2; ++k) dst[m][k] = *(const PG8_LAS bf16x8*)(lds + PG8_SA(b, h) + aoff + m * 2048 + k * 1024); } while (0)
#define PG8_LDB(dst, b, h) do { _Pragma("unroll") for (int n = 0; n < 2; ++n) _Pragma("unroll") for (int k = 0; k < 2; ++k) dst[n][k] = *(const PG8_LAS bf16x8*)(lds + PG8_SB(b, h) + boff + n * 2048 + k * 1024); } while (0)
#define PG8_MMA(ai, bj, At, Bt) do { __builtin_amdgcn_s_setprio(1); _Pragma("unroll") for (int m = 0; m < 4; ++m) _Pragma("unroll") for (int n = 0; n < 2; ++n) _Pragma("unroll") for (int k = 0; k < 2; ++k) \
        acc[ai][bj][m][n] = __builtin_amdgcn_mfma_f32_16x16x32_bf16(Bt[n][k], At[m][k], acc[ai][bj][m][n], 0, 0, 0); __builtin_amdgcn_s_setprio(0); } while (0)
#define PG8_WAIT_V(n) asm volatile("s_waitcnt vmcnt(" #n ")" ::: "memory")
#define PG8_WAIT_L(n) asm volatile("s_waitcnt lgkmcnt(" #n ")" ::: "memory")
#define PG8_BAR __builtin_amdgcn_s_barrier()
#define PG8_SCHED __builtin_amdgcn_sched_barrier(0)
    Unit cur, nxt; int ui = 0;
    if (!S.next(0, cur)) return;
    f32x4 acc[2][2][4][2];
#pragma unroll
    for (int a = 0; a < 2; ++a)
#pragma unroll
        for (int b = 0; b < 2; ++b)
#pragma unroll
            for (int m = 0; m < 4; ++m)
#pragma unroll
                for (int n = 0; n < 2; ++n) acc[a][b][m][n] = (f32x4){0.f, 0.f, 0.f, 0.f};
    bf16x8 At[4][2], B0[2][2], B1[2][2];
    const char* cA = (const char*)g.A + (size_t)cur.pm * tstep + (g.npg ? (size_t)(cur.pn / g.npg) * g.a_gstride : (size_t)0); const char* cB = (const char*)g.Bt + (size_t)cur.pn * tstep;
    S.a_ready(cur);
    PG8_STAGE(PG8_SB(0, 0), cB, voffB); PG8_STAGE(PG8_SA(0, 0), cA, voffA); PG8_STAGE(PG8_SB(0, 1), cB + hstep, voffB); PG8_STAGE(PG8_SA(0, 1), cA + hstep, voffA);
    if (wr == 1) PG8_BAR;
    PG8_WAIT_V(4); PG8_BAR;
    PG8_STAGE(PG8_SB(1, 0), cB + kstep, voffB); PG8_STAGE(PG8_SA(1, 0), cA + kstep, voffA); PG8_STAGE(PG8_SB(1, 1), cB + hstep + kstep, voffB);
    PG8_WAIT_V(6); PG8_BAR;
    PG8_STAMP();
    for (;;) {
        const bool has_next = S.next(ui + 1, nxt);
        const char* nA = has_next ? (const char*)g.A + (size_t)nxt.pm * tstep + (g.npg ? (size_t)(nxt.pn / g.npg) * g.a_gstride : (size_t)0) : cA; const char* nB = has_next ? (const char*)g.Bt + (size_t)nxt.pn * tstep : cB;
        for (int t = 0; t < nt; t += 2) {
            const bool last = (t == nt - 2);
            const char* a1 = cA + (size_t)(t + 1) * kstep;
            const char* a2 = last ? nA : cA + (size_t)(t + 2) * kstep; const char* b2 = last ? nB : cB + (size_t)(t + 2) * kstep;
            const char* a3 = a2 + kstep; const char* b3 = b2 + kstep;
            if (last && has_next) S.a_ready(nxt);
            PG8_LDB(B0, 0, 0); PG8_SCHED; PG8_LDA(At, 0, 0); PG8_STAGE(PG8_SA(1, 1), a1 + hstep, voffA);
            PG8_WAIT_L(8); PG8_BAR; PG8_WAIT_L(0); PG8_MMA(0, 0, At, B0); PG8_BAR; PG8_SCHED;
            PG8_LDB(B1, 0, 1); PG8_STAGE(PG8_SB(0, 0), b2, voffB);
            PG8_BAR; PG8_WAIT_L(0); PG8_MMA(0, 1, At, B1); PG8_BAR;
            PG8_LDA(At, 0, 1); PG8_STAGE(PG8_SA(0, 0), a2, voffA);
            PG8_BAR; PG8_WAIT_L(0); PG8_MMA(1, 0, At, B0); PG8_BAR; PG8_SCHED;
            PG8_STAGE(PG8_SB(0, 1), b2 + hstep, voffB);
            PG8_WAIT_V(6); PG8_BAR; PG8_MMA(1, 1, At, B1); PG8_BAR;
            PG8_LDB(B0, 1, 0); PG8_SCHED; PG8_LDA(At, 1, 0); PG8_STAGE(PG8_SA(0, 1), a2 + hstep, voffA);
            PG8_WAIT_L(8); PG8_BAR; PG8_WAIT_L(0); PG8_MMA(0, 0, At, B0); PG8_BAR; PG8_SCHED;
            PG8_LDB(B1, 1, 1); PG8_STAGE(PG8_SB(1, 0), b3, voffB);
            PG8_BAR; PG8_WAIT_L(0); PG8_MMA(0, 1, At, B1); PG8_BAR;
            PG8_LDA(At, 1, 1); PG8_STAGE(PG8_SA(1, 0), a3, voffA);
            PG8_BAR; PG8_WAIT_L(0); PG8_MMA(1, 0, At, B0); PG8_BAR; PG8_SCHED;
            PG8_STAGE(PG8_SB(1, 1), b3 + hstep, voffB);
            PG8_WAIT_V(6); PG8_BAR; PG8_MMA(1, 1, At, B1); PG8_BAR;
        }
        PG8_STAMP();
        if constexpr (!Epi::AFTER_DRAIN) { E(acc, cur, wr, wc, fr, fq); S.done(cur); }
        PG8_STAMP();
        if (!has_next) break;
#pragma unroll
        for (int a = 0; a < 2; ++a)
#pragma unroll
            for (int b = 0; b < 2; ++b)
#pragma unroll
                for (int m = 0; m < 4; ++m)
#pragma unroll
                    for (int n = 0; n < 2; ++n) acc[a][b][m][n] = (f32x4){0.f, 0.f, 0.f, 0.f};
        cur = nxt; cA = nA; cB = nB; ++ui;
    }
    PG8_WAIT_V(0);
    if (wr == 0) PG8_BAR;
    PG8_BAR;
    if constexpr (Epi::AFTER_DRAIN) { E.fused(acc, cur, wr, wc, fr, fq, lds, wid, lane); S.done(cur); }
    PG8_STAMP();
    if (STAMP && wid == 0) { stamps[lane] = lane < nts ? (((unsigned long long)(unsigned)ts_hi << 32) | (unsigned)ts_lo) : 0ull;
        if (lane == 62) stamps[62] = rt_entry; if (lane == 63) stamps[63] = (unsigned long long)wall_clock64(); }
#undef PG8_STAMP
#undef PG8_SA
#undef PG8_SB
#undef PG8_STAGE
#undef PG8_LDA
#undef PG8_LDB
#undef PG8_MMA
#undef PG8_WAIT_V
#undef PG8_WAIT_L
#undef PG8_BAR
#undef PG8_SCHED
}
template <class Epi, class Sched, bool ALIGN_EPI = false, bool SP2 = false>
__device__ __forceinline__ void gemm_phase2(PG8_LAS unsigned char* lds, const Gemm g, const Sched& S, const Epi& E) {
    int tid_l = threadIdx.x; asm volatile("" : "+v"(tid_l));
    const int tid = tid_l, wid = __builtin_amdgcn_readfirstlane(tid >> 6), lane = tid & 63, wr = wid >> 2, wc = wid & 3, fr = lane & 15, fq = lane >> 4;
    const int K = g.K, nt = K / BK;
    unsigned voffA[2], voffB[2];
#pragma unroll
    for (int i = 0; i < 2; ++i) { int R, C; stage_rc(tid * 16 + i * 8192, R, C); const int Rb = Epi::PERM ? ((R & ~31) + perm32(R & 31)) : R;
        voffA[i] = (unsigned)(R * K + C) * 2u; voffB[i] = (unsigned)(Rb * K + C) * 2u; }
    const size_t kstep = (size_t)(BK * 2);
    const size_t hstep = (size_t)HALF * K * 2;
    const size_t tstep = 2 * hstep;
    const unsigned ldsw = (unsigned)wid * 1024u;
    const int aoff = lds_byte(wr * 64 + fr, fq * 8), boff = lds_byte(wc * 32 + fr, fq * 8);
#define PG8_SA(b, h) (((b) * 2 + (h)) * HTB)
#define PG8_SB(b, h) ((4 + (b) * 2 + (h)) * HTB)
#define PG8_STAGE(bufoff, gbase, voff) do { _Pragma("unroll") for (int _i = 0; _i < 2; ++_i) \
        __builtin_amdgcn_global_load_lds((const unsigned*)((const char*)(gbase) + (voff)[_i]), (PG8_LAS unsigned*)(lds + (bufoff) + ldsw + _i * 8192), 16, 0, 0); } while (0)
#define PG8_LDA(dst, b, h) do { _Pragma("unroll") for (int m = 0; m < 4; ++m) _Pragma("unroll") for (int k = 0; k < 2; ++k) dst[m][k] = *(const PG8_LAS bf16x8*)(lds + PG8_SA(b, h) + aoff + m * 2048 + k * 1024); } while (0)
#define PG8_LDB(dst, b, h) do { _Pragma("unroll") for (int n = 0; n < 2; ++n) _Pragma("unroll") for (int k = 0; k < 2; ++k) dst[n][k] = *(const PG8_LAS bf16x8*)(lds + PG8_SB(b, h) + boff + n * 2048 + k * 1024); } while (0)
#define PG8_MMA(ai, bj, At, Bt) do { __builtin_amdgcn_s_setprio(1); _Pragma("unroll") for (int m = 0; m < 4; ++m) _Pragma("unroll") for (int n = 0; n < 2; ++n) _Pragma("unroll") for (int k = 0; k < 2; ++k) \
        acc[ai][bj][m][n] = __builtin_amdgcn_mfma_f32_16x16x32_bf16(Bt[n][k], At[m][k], acc[ai][bj][m][n], 0, 0, 0); __builtin_amdgcn_s_setprio(0); } while (0)
#define PG8_WAIT_V(n) asm volatile("s_waitcnt vmcnt(" #n ")" ::: "memory")
#define PG8_WAIT_L(n) asm volatile("s_waitcnt lgkmcnt(" #n ")" ::: "memory")
#define PG8_BAR __builtin_amdgcn_s_barrier()
#define PG8_SCHED __builtin_amdgcn_sched_barrier(0)
    Unit cur, nxt; int ui = 0;
    if (!S.next(0, cur)) return;
    f32x4 acc[2][2][4][2];
#pragma unroll
    for (int a = 0; a < 2; ++a)
#pragma unroll
        for (int b = 0; b < 2; ++b)
#pragma unroll
            for (int m = 0; m < 4; ++m)
#pragma unroll
                for (int n = 0; n < 2; ++n) acc[a][b][m][n] = (f32x4){0.f, 0.f, 0.f, 0.f};
    bf16x8 At[4][2], B0[2][2], B1[2][2];
    const char* cA = (const char*)g.A + (size_t)cur.pm * tstep + (g.npg ? (size_t)(cur.pn / g.npg) * g.a_gstride : (size_t)0); const char* cB = (const char*)g.Bt + (size_t)cur.pn * tstep;
    S.a_ready(cur);
    if constexpr (SP2) {
        PG8_STAGE(PG8_SB(0, 0), cB, voffB); PG8_STAGE(PG8_SB(0, 1), cB + hstep, voffB); PG8_STAGE(PG8_SA(0, 0), cA, voffA); PG8_STAGE(PG8_SA(0, 1), cA + hstep, voffA);
        if (wr == 1) PG8_BAR;
        PG8_WAIT_V(2); PG8_BAR;
        PG8_STAGE(PG8_SB(1, 0), cB + kstep, voffB); PG8_STAGE(PG8_SA(1, 0), cA + kstep, voffA); PG8_STAGE(PG8_SB(1, 1), cB + hstep + kstep, voffB);
        PG8_WAIT_V(6); PG8_BAR;
    } else {
        PG8_STAGE(PG8_SB(0, 0), cB, voffB); PG8_STAGE(PG8_SA(0, 0), cA, voffA); PG8_STAGE(PG8_SB(0, 1), cB + hstep, voffB); PG8_STAGE(PG8_SA(0, 1), cA + hstep, voffA);
        if (wr == 1) PG8_BAR;
        PG8_WAIT_V(4); PG8_BAR;
        PG8_STAGE(PG8_SB(1, 0), cB + kstep, voffB); PG8_STAGE(PG8_SA(1, 0), cA + kstep, voffA); PG8_STAGE(PG8_SB(1, 1), cB + hstep + kstep, voffB);
        PG8_WAIT_V(6); PG8_BAR;
    }
    for (;;) {
        const bool has_next = S.next(ui + 1, nxt);
        const char* nA = has_next ? (const char*)g.A + (size_t)nxt.pm * tstep + (g.npg ? (size_t)(nxt.pn / g.npg) * g.a_gstride : (size_t)0) : cA; const char* nB = has_next ? (const char*)g.Bt + (size_t)nxt.pn * tstep : cB;
        for (int t = 0; t < nt; t += 2) {
            const bool last = (t == nt - 2);
            const char* a1 = cA + (size_t)(t + 1) * kstep;
            const char* a2 = last ? nA : cA + (size_t)(t + 2) * kstep; const char* b2 = last ? nB : cB + (size_t)(t + 2) * kstep;
            const char* a3 = a2 + kstep; const char* b3 = b2 + kstep;
            if (last && has_next) S.a_ready(nxt);
            if constexpr (SP2) {
            PG8_LDB(B0, 0, 0); PG8_LDB(B1, 0, 1); PG8_SCHED; PG8_LDA(At, 0, 0); PG8_STAGE(PG8_SA(1, 1), a1 + hstep, voffA);
            PG8_WAIT_V(8); PG8_WAIT_L(0); PG8_BAR; PG8_MMA(0, 0, At, B0); PG8_MMA(0, 1, At, B1); PG8_BAR; PG8_SCHED;
            PG8_LDA(At, 0, 1); PG8_STAGE(PG8_SB(0, 0), b2, voffB); PG8_STAGE(PG8_SB(0, 1), b2 + hstep, voffB); PG8_STAGE(PG8_SA(0, 0), a2, voffA);
            PG8_WAIT_V(8); PG8_WAIT_L(0); PG8_BAR; PG8_MMA(1, 0, At, B0); PG8_MMA(1, 1, At, B1); PG8_BAR; PG8_SCHED;
            PG8_LDB(B0, 1, 0); PG8_LDB(B1, 1, 1); PG8_SCHED; PG8_LDA(At, 1, 0); PG8_STAGE(PG8_SA(0, 1), a2 + hstep, voffA);
            PG8_WAIT_V(8); PG8_WAIT_L(0); PG8_BAR; PG8_MMA(0, 0, At, B0); PG8_MMA(0, 1, At, B1); PG8_BAR; PG8_SCHED;
            PG8_LDA(At, 1, 1); PG8_STAGE(PG8_SB(1, 0), b3, voffB); PG8_STAGE(PG8_SB(1, 1), b3 + hstep, voffB); PG8_STAGE(PG8_SA(1, 0), a3, voffA);
            PG8_WAIT_V(8); PG8_WAIT_L(0); PG8_BAR; PG8_MMA(1, 0, At, B0); PG8_MMA(1, 1, At, B1); PG8_BAR; PG8_SCHED;
            } else {
            PG8_LDB(B0, 0, 0); PG8_SCHED; PG8_LDA(At, 0, 0); PG8_STAGE(PG8_SA(1, 1), a1 + hstep, voffA);
            PG8_WAIT_L(8); PG8_BAR; PG8_WAIT_L(0); PG8_MMA(0, 0, At, B0); PG8_BAR; PG8_SCHED;
            PG8_LDB(B1, 0, 1); PG8_STAGE(PG8_SB(0, 0), b2, voffB);
            PG8_BAR; PG8_WAIT_L(0); PG8_MMA(0, 1, At, B1); PG8_BAR;
            PG8_LDA(At, 0, 1); PG8_STAGE(PG8_SA(0, 0), a2, voffA);
            PG8_BAR; PG8_WAIT_L(0); PG8_MMA(1, 0, At, B0); PG8_BAR; PG8_SCHED;
            PG8_STAGE(PG8_SB(0, 1), b2 + hstep, voffB);
            PG8_WAIT_V(6); PG8_BAR; PG8_MMA(1, 1, At, B1); PG8_BAR;
            PG8_LDB(B0, 1, 0); PG8_SCHED; PG8_LDA(At, 1, 0); PG8_STAGE(PG8_SA(0, 1), a2 + hstep, voffA);
            PG8_WAIT_L(8); PG8_BAR; PG8_WAIT_L(0); PG8_MMA(0, 0, At, B0); PG8_BAR; PG8_SCHED;
            PG8_LDB(B1, 1, 1); PG8_STAGE(PG8_SB(1, 0), b3, voffB);
            PG8_BAR; PG8_WAIT_L(0); PG8_MMA(0, 1, At, B1); PG8_BAR;
            PG8_LDA(At, 1, 1); PG8_STAGE(PG8_SA(1, 0), a3, voffA);
            PG8_BAR; PG8_WAIT_L(0); PG8_MMA(1, 0, At, B0); PG8_BAR; PG8_SCHED;
            PG8_STAGE(PG8_SB(1, 1), b3 + hstep, voffB);
            PG8_WAIT_V(6); PG8_BAR; PG8_MMA(1, 1, At, B1); PG8_BAR;
            }
        }
        if constexpr (ALIGN_EPI) { if (wr == 0) PG8_BAR; }
        if constexpr (!Epi::AFTER_DRAIN) { E(acc, cur, wr, wc, fr, fq); S.done(cur); }
        if (!has_next) break;
#pragma unroll
        for (int a = 0; a < 2; ++a)
#pragma unroll
            for (int b = 0; b < 2; ++b)
#pragma unroll
                for (int m = 0; m < 4; ++m)
#pragma unroll
                    for (int n = 0; n < 2; ++n) acc[a][b][m][n] = (f32x4){0.f, 0.f, 0.f, 0.f};
        cur = nxt; cA = nA; cB = nB; ++ui;
        if constexpr (ALIGN_EPI) { if (wr == 1) PG8_BAR; }
    }
    PG8_WAIT_V(0);
    if constexpr (!ALIGN_EPI) { if (wr == 0) PG8_BAR; }
    PG8_BAR;
    if constexpr (Epi::AFTER_DRAIN) { E.fused(acc, cur, wr, wc, fr, fq, lds, wid, lane); S.done(cur); }
#undef PG8_SA
#undef PG8_SB
#undef PG8_STAGE
#undef PG8_LDA
#undef PG8_LDB
#undef PG8_MMA
#undef PG8_WAIT_V
#undef PG8_WAIT_L
#undef PG8_BAR
#undef PG8_SCHED
}

}

#define LAS __attribute__((address_space(3)))
typedef unsigned short bf16;
typedef short bf16x8 __attribute__((ext_vector_type(8)));
typedef float f32x4 __attribute__((ext_vector_type(4)));
typedef float f32x2 __attribute__((ext_vector_type(2)));
typedef float f32x16 __attribute__((ext_vector_type(16)));
typedef unsigned u32x4 __attribute__((ext_vector_type(4)));
typedef unsigned u32x2 __attribute__((ext_vector_type(2)));
typedef __bf16 bf16x2_t __attribute__((ext_vector_type(2)));
#define DI __device__ __forceinline__
#define MFMA32(a, b, c) __builtin_amdgcn_mfma_f32_32x32x16_bf16((a), (b), (c), 0, 0, 0)

DI float bf2f(unsigned short b) { return __uint_as_float(((unsigned)b) << 16); }
DI float bflo(unsigned w) { return __uint_as_float(w << 16); }
DI float bfhi(unsigned w) { return __uint_as_float(w & 0xffff0000u); }
DI unsigned pk2(float lo, float hi) { f32x2 v; v.x = lo; v.y = hi; return __builtin_bit_cast(unsigned, __builtin_convertvector(v, bf16x2_t)); }
DI unsigned short f2bf(float f) { return (unsigned short)(pk2(f, 0.f) & 0xffffu); }
DI int crow(int reg, int h) { return (reg & 3) + 8 * (reg >> 2) + 4 * h; }
DI bf16x8 pack_step(const f32x16& x, int s) {
    u32x4 p; p.x = pk2(x[8 * s], x[8 * s + 1]); p.y = pk2(x[8 * s + 2], x[8 * s + 3]); p.z = pk2(x[8 * s + 4], x[8 * s + 5]); p.w = pk2(x[8 * s + 6], x[8 * s + 7]);
    return __builtin_bit_cast(bf16x8, p);
}
DI bf16x8 pack8f(f32x4 a, f32x4 b) { u32x4 p; p.x = pk2(a.x, a.y); p.y = pk2(a.z, a.w); p.z = pk2(b.x, b.y); p.w = pk2(b.z, b.w); return __builtin_bit_cast(bf16x8, p); }
DI bf16x8 join8(u32x2 lo, u32x2 hi) { u32x4 p; p.x = lo.x; p.y = lo.y; p.z = hi.x; p.w = hi.y; return __builtin_bit_cast(bf16x8, p); }
DI float wave_sum(float v) {
#pragma unroll
    for (int o = 1; o < 64; o <<= 1) v += __shfl_xor(v, o);
    return v;
}
DI float half_sum(float v) {
#pragma unroll
    for (int o = 1; o < 32; o <<= 1) v += __shfl_xor(v, o);
    return v;
}
#define DPP_ROR(x, n) __builtin_bit_cast(float, __builtin_amdgcn_update_dpp(0, __builtin_bit_cast(int, (x)), 0x120 + (n), 0xf, 0xf, false))
DI float row16_sum(float x) { x += DPP_ROR(x, 8); x += DPP_ROR(x, 4); x += DPP_ROR(x, 2); x += DPP_ROR(x, 1); return x; }
DI float sigmoidf_(float x) { return __builtin_amdgcn_rcpf(1.0f + __expf(-x)); }
DI float siluf_(float x) { return x * __builtin_amdgcn_rcpf(1.0f + __expf(-x)); }
DI float gelu_erf(float v) {
    const float t = __builtin_amdgcn_rcpf(fabsf(v) * 0.2316418882f + 1.0f);
    float q = t * 0.5307027145f + (-0.7265760135f); q = q * t + 0.7107068705f; q = q * t + (-0.142248368f); q = q * t + 0.127414796f; q = q * t;
    const float e = __builtin_amdgcn_exp2f((v * v) * (-0.72134752044f));
    const float m = v * (q * e);
    return v < 0.f ? m : v - m;
}
DI float logsigmoidf_(float x) { return fminf(x, 0.f) - log1pf(__expf(-fabsf(x))); }

#define XB_TMO      128
#define XB_XCNT(j)  (256  + 64 * (j))
#define XB_XSUB(j)  (1280 + 64 * (j))
#define XB_XGEN(j)  (2304 + 64 * (j))
#define XB_TOP      3328
#define XB_TOPGEN   3392
#define XCD_BAR_WORDS 3456
#define XB_SPIN_CAP (1u << 18)
__device__ __forceinline__ unsigned xb_ld(unsigned* p)              { return __hip_atomic_load(p, __ATOMIC_RELAXED, __HIP_MEMORY_SCOPE_AGENT); }
__device__ __forceinline__ unsigned xb_add(unsigned* p, unsigned v) { return __hip_atomic_fetch_add(p, v, __ATOMIC_RELAXED, __HIP_MEMORY_SCOPE_AGENT); }
__device__ __forceinline__ unsigned xb_xcc_id() { return (unsigned)__builtin_amdgcn_s_getreg((3 << 11) | 20) & 0xFu; }
#define XB_SPIN(cond, bar) do { unsigned _sp = 0; while (cond) { __builtin_amdgcn_s_sleep(1); \
    if ((++_sp & 255u) == 0u) { if (xb_ld(&(bar)[XB_TMO])) break; if (_sp > XB_SPIN_CAP) { atomicAdd(&(bar)[XB_TMO], 1u); break; } } } } while (0)
struct XcdBarrier { unsigned* bar; unsigned x; volatile LAS unsigned* st; };
__device__ __forceinline__ XcdBarrier xcd_barrier_post(unsigned* bar, volatile LAS unsigned* st) {
    XcdBarrier b; b.bar = bar; b.x = xb_xcc_id(); b.st = st;
    if (threadIdx.x == 0) (void)xb_add(&bar[XB_XCNT(b.x)], 1u);
    return b;
}
__device__ __forceinline__ void xcd_barrier_complete(unsigned* bar, unsigned x, unsigned& nloc, unsigned& nx) {
    const unsigned G = gridDim.x * gridDim.y * gridDim.z;
    unsigned sum, cnt, mine, sp = 0u;
    for (;;) {
        sum = 0u; cnt = 0u; mine = 0u;
#pragma unroll
        for (unsigned j = 0; j < 16; ++j) { const unsigned c = xb_ld(&bar[XB_XCNT(j)]); sum += c; cnt += (c > 0u) ? 1u : 0u; mine = (j == x) ? c : mine; }
        if (sum == G) break;
        __builtin_amdgcn_s_sleep(1);
        if ((++sp & 255u) == 0u) { if (xb_ld(&bar[XB_TMO])) break; if (sp > XB_SPIN_CAP) { atomicAdd(&bar[XB_TMO], 1u); break; } }
    }
    nloc = mine > 0u ? mine : 1u; nx = cnt > 0u ? cnt : 1u;
}
__device__ __forceinline__ void xcd_barrier(const XcdBarrier& b) {
    asm volatile("s_waitcnt vmcnt(0)" ::: "memory");
    __syncthreads();
    if (threadIdx.x == 0) {
        unsigned* bar = b.bar;
        __builtin_amdgcn_s_waitcnt(0);
        unsigned nloc = b.st[0], nx = b.st[1];
        if (nloc == 0u) { xcd_barrier_complete(bar, b.x, nloc, nx); b.st[0] = nloc; b.st[1] = nx; }
        const unsigned old = xb_add(&bar[XB_XSUB(b.x)], 1u);
        const unsigned gen = old / nloc;
        if (old + 1u == (gen + 1u) * nloc) {
            __builtin_amdgcn_fence(__ATOMIC_RELEASE, "agent");
            asm volatile("s_waitcnt vmcnt(0)" ::: "memory");
            const unsigned og = xb_add(&bar[XB_TOP], 1u);
            const unsigned tg = og / nx;
            if (og + 1u == (tg + 1u) * nx) xb_add(&bar[XB_TOPGEN], 1u);
            else XB_SPIN(xb_ld(&bar[XB_TOPGEN]) == tg, bar);
            __builtin_amdgcn_fence(__ATOMIC_ACQUIRE, "agent");
            xb_add(&bar[XB_XGEN(b.x)], 1u);
            asm volatile("s_waitcnt vmcnt(0)" ::: "memory");
        } else {
            XB_SPIN(xb_ld(&bar[XB_XGEN(b.x)]) == gen, bar);
            __builtin_amdgcn_fence(__ATOMIC_ACQUIRE, "agent");
            asm volatile("s_waitcnt vmcnt(0)" ::: "memory");
        }
    }
    __syncthreads();
}

constexpr int NB = 4, SEQ = 4096, T = NB * SEQ, DM = 2048, BW = 1024, NIN = 23320;
constexpr int N1 = 15360, LDP = 14848, N1BF_TILES = 58, NM = 8192;
constexpr int AQ = 0, AK = 512, AV = 1024, AG = 2048, BQ = 3072, BK_ = 4096, BV = 5120, BIQ = 6144, BG = 6656, CR = 7680, CK = 8704, CV = 9728, CG = 10752, DU = 11776, DV = 12800, DG = 13824;
constexpr int GLR = 0, IK = 16, IW = 80, WLR = 96, ALR = 192;
constexpr size_t MiB = 1u << 20;
constexpr size_t WS_CTL = 0, CTL_BYTES = 64 * 1024;
constexpr size_t WS_WT1 = 1 * MiB;
constexpr size_t WS_WTM = 121 * MiB;
constexpr size_t WS_WTP = 185 * MiB;
constexpr size_t WS_WTO = 217 * MiB;
constexpr size_t WS_WSB = 233 * MiB;
constexpr size_t WS_H   = 234 * MiB;
constexpr size_t WS_P   = 298 * MiB;
constexpr size_t WS_SM  = 762 * MiB;
constexpr size_t WS_RW  = 794 * MiB;
constexpr size_t WS_VT  = 1050 * MiB;
constexpr size_t WS_SC  = 1082 * MiB;
constexpr size_t WS_BM  = 1212 * MiB;
constexpr size_t WS_YS  = 1220 * MiB;
constexpr size_t WS_ROPE = 1348 * MiB;
constexpr size_t WS_KV = 1351 * MiB;
constexpr size_t WS_ET = 1415 * MiB;
constexpr size_t WS_WLR = 1416 * MiB;
constexpr size_t WS_END = 1418 * MiB;
constexpr size_t RW_ARR = (size_t)T * 1024 * 2;
constexpr int CW_BAR = 64, CW_Q = 4096;
constexpr int LDS_BYTES = 147456, MISC_OFF = LDS_BYTES - 256;
constexpr int NPHASE = 21;

struct Args { const float* in[24]; const int* pos; float* out; unsigned char* ws; int ph_lo, ph_hi; };

template <int MODE> struct Epi {
    static constexpr bool PERM = true, AFTER_DRAIN = false;
    unsigned char* O; float* O2; const float* R = nullptr;
    static __device__ __forceinline__ void rot4(pg8::f32x4& a0, pg8::f32x4& a1, const pg8::f32x4 c0, const pg8::f32x4 c1) {
        const float x0 = a0[0], x1 = a0[1], x2 = a0[2], x3 = a0[3], y0 = a1[0], y1 = a1[1], y2 = a1[2], y3 = a1[3];
        a0[0] = x0 * c0[0] - y0 * c0[1]; a1[0] = y0 * c0[0] + x0 * c0[1]; a0[1] = x1 * c0[2] - y1 * c0[3]; a1[1] = y1 * c0[2] + x1 * c0[3];
        a0[2] = x2 * c1[0] - y2 * c1[1]; a1[2] = y2 * c1[0] + x2 * c1[1]; a0[3] = x3 * c1[2] - y3 * c1[3]; a1[3] = y3 * c1[2] + x3 * c1[3];
    }
    __device__ __forceinline__ void operator()(const pg8::f32x4 (&acc)[2][2][4][2], const pg8::Unit& u, int wr, int wc, int fr, int fq) const {
        const int row0 = u.pm * 256 + wr * 64 + fr, cl = wc * 32 + 8 * fq;
        if (MODE == 2) {
            const bf16* proj = (const bf16*)O2; bf16* merged = (bf16*)O;
            const unsigned d0 = u.pn * 64 + wc * 16 + 4 * fq;
            u32x2 pv[2][4][4];
#pragma unroll
            for (int ai = 0; ai < 2; ++ai)
#pragma unroll
                for (int m = 0; m < 4; ++m)
#pragma unroll
                    for (int g = 0; g < 4; ++g) pv[ai][m][g] = *(const u32x2*)(proj + ((unsigned)(g * T + row0 + ai * 128 + m * 16) * (unsigned)DM + d0));
#pragma unroll
            for (int ai = 0; ai < 2; ++ai)
#pragma unroll
                for (int m = 0; m < 4; ++m) { float o0 = 0.f, o1 = 0.f, o2 = 0.f, o3 = 0.f;
#pragma unroll
                    for (int g = 0; g < 4; ++g) { const pg8::f32x4 v = acc[ai][g >> 1][m][g & 1]; const u32x2 p = pv[ai][m][g];
                        o0 += sigmoidf_(v[0]) * bflo(p.x); o1 += sigmoidf_(v[1]) * bfhi(p.x); o2 += sigmoidf_(v[2]) * bflo(p.y); o3 += sigmoidf_(v[3]) * bfhi(p.y); }
                    u32x2 w; w.x = pk2(o0, o1); w.y = pk2(o2, o3);
                    *(u32x2*)(merged + ((unsigned)(row0 + ai * 128 + m * 16) * (unsigned)DM + d0)) = w; }
        } else if ((MODE == 0 && u.pn >= N1BF_TILES) || MODE == 3) {
            float* base; int ldc;
            if (MODE == 0) { base = O2 + (u.pn - N1BF_TILES) * 256 + cl; ldc = 512; } else { base = (float*)O + u.pn * 256 + cl; ldc = DM; }
            if (MODE == 0 && u.pn == N1BF_TILES && wc == 0) {
                pg8::f32x4 cs[2][4][2];
#pragma unroll
                for (int ai = 0; ai < 2; ++ai)
#pragma unroll
                    for (int m = 0; m < 4; ++m) { const float* cp = R + (unsigned)(row0 + ai * 128 + m * 16) * 48 + 32 + 8 * (fq & 1); cs[ai][m][0] = *(const pg8::f32x4*)cp; cs[ai][m][1] = *(const pg8::f32x4*)(cp + 4); }
#pragma unroll
                for (int ai = 0; ai < 2; ++ai)
#pragma unroll
                    for (int m = 0; m < 4; ++m) { float* rowp = base + (size_t)(row0 + ai * 128 + m * 16) * ldc;
                        pg8::f32x4 k0 = acc[ai][0][m][0], k1 = acc[ai][0][m][1], r0 = k0, r1 = k1; rot4(r0, r1, cs[ai][m][0], cs[ai][m][1]);
                        if (fq >= 2) { k0 = r0; k1 = r1; }
                        *(pg8::f32x4*)rowp = k0; *(pg8::f32x4*)(rowp + 4) = k1;
                        *(pg8::f32x4*)(rowp + 128) = acc[ai][1][m][0]; *(pg8::f32x4*)(rowp + 128 + 4) = acc[ai][1][m][1]; }
            } else {
#pragma unroll
            for (int ai = 0; ai < 2; ++ai)
#pragma unroll
                for (int m = 0; m < 4; ++m) { float* rowp = base + (size_t)(row0 + ai * 128 + m * 16) * ldc;
#pragma unroll
                    for (int bj = 0; bj < 2; ++bj) { *(pg8::f32x4*)(rowp + bj * 128) = acc[ai][bj][m][0]; *(pg8::f32x4*)(rowp + bj * 128 + 4) = acc[ai][bj][m][1]; } }
            }
        } else {
            bf16* base; int ldc;
            if (MODE == 0) { base = (bf16*)O + u.pn * 256 + cl; ldc = LDP; }
            else if (MODE == 1) { const int g = u.pn >> 3; base = (bf16*)O + (size_t)g * T * DM + (u.pn & 7) * 256 + cl; ldc = DM; }
            else { base = (bf16*)O + u.pn * 256 + cl; ldc = NM; }
            const bool ropeA = MODE == 0 && u.pn >= BQ / 256 && u.pn < BV / 256 && wc == 0;
            const bool ropeI = MODE == 0 && u.pn >= BIQ / 256 && u.pn < BG / 256 && (wc & 1) == 0;
            if (ropeA || ropeI) {
                pg8::f32x4 cs[2][4][2];
#pragma unroll
                for (int ai = 0; ai < 2; ++ai)
#pragma unroll
                    for (int m = 0; m < 4; ++m) { const float* cp = R + (unsigned)(row0 + ai * 128 + m * 16) * 48 + (ropeA ? 8 * fq : 32 + 8 * (fq & 1)); cs[ai][m][0] = *(const pg8::f32x4*)cp; cs[ai][m][1] = *(const pg8::f32x4*)(cp + 4); }
                const bool on = ropeA || fq < 2;
#pragma unroll
                for (int ai = 0; ai < 2; ++ai)
#pragma unroll
                    for (int m = 0; m < 4; ++m) { bf16* rowp = base + (size_t)(row0 + ai * 128 + m * 16) * ldc;
#pragma unroll
                        for (int bj = 0; bj < 2; ++bj) { pg8::f32x4 v0 = acc[ai][bj][m][0], v1 = acc[ai][bj][m][1], r0 = v0, r1 = v1;
                            rot4(r0, r1, cs[ai][m][0], cs[ai][m][1]); if (on) { v0 = r0; v1 = r1; }
                            u32x4 w; w.x = pk2(v0[0], v0[1]); w.y = pk2(v0[2], v0[3]); w.z = pk2(v1[0], v1[1]); w.w = pk2(v1[2], v1[3]);
                            *(u32x4*)(rowp + bj * 128) = w; } }
            } else {
#pragma unroll
            for (int ai = 0; ai < 2; ++ai)
#pragma unroll
                for (int m = 0; m < 4; ++m) { bf16* rowp = base + (size_t)(row0 + ai * 128 + m * 16) * ldc;
#pragma unroll
                    for (int bj = 0; bj < 2; ++bj) { pg8::f32x4 v0 = acc[ai][bj][m][0], v1 = acc[ai][bj][m][1];
                        if (MODE == 0 && u.pn >= DU / 256 && u.pn < DG / 256) {
#pragma unroll
                            for (int e = 0; e < 4; ++e) { v0[e] = gelu_erf(v0[e]); v1[e] = gelu_erf(v1[e]); } }
                        u32x4 w; w.x = pk2(v0[0], v0[1]); w.y = pk2(v0[2], v0[3]); w.z = pk2(v1[0], v1[1]); w.w = pk2(v1[2], v1[3]);
                        *(u32x4*)(rowp + bj * 128) = w; } }
            }
        }
    }
};

DI int map1(int n) {
    if (n < 2048) return n;
    if (n < 6656) return n + 16;
    if (n < 10752) return n + 88;
    if (n < LDP) return n + 280;
    const int m = n - LDP;
    if (m < 16) return 2048 + m;
    if (m < 80) { int p = m - 16; if (p < 16) p = 4 * (p >> 3) + (p & 3) + 8 * ((p >> 2) & 1); return 6672 + p; }
    if (m < 88) return 6736 + (m - 80);
    if (m < 96) return -1;
    if (m < 192) return 10840 + (m - 96);
    if (m < 288) return 10936 + (m - 192);
    return -1;
}
DI void tr_item(const float* W, size_t ldw, int K, bf16* WT, int k0, int sc, int nd, LAS float* scr, int lane) {
#pragma unroll 8
    for (int i = 0; i < 32; ++i) { const int kk = 2 * i + (lane >> 5); const float v = sc >= 0 ? W[(size_t)(k0 + kk) * ldw + sc] : 0.f; scr[kk * 33 + (lane & 31)] = v; }
    asm volatile("s_waitcnt lgkmcnt(0)" ::: "memory");
    const int c = lane & 7;
#pragma unroll
    for (int jj = 0; jj < 4; ++jj) { const int n = (lane >> 3) + 8 * jj; const LAS float* s = scr + (8 * c) * 33 + n;
        u32x4 o; o.x = pk2(s[0 * 33], s[1 * 33]); o.y = pk2(s[2 * 33], s[3 * 33]); o.z = pk2(s[4 * 33], s[5 * 33]); o.w = pk2(s[6 * 33], s[7 * 33]);
        *(u32x4*)(WT + (size_t)(nd + n) * K + k0 + 8 * c) = o; }
    asm volatile("s_waitcnt lgkmcnt(0)" ::: "memory");
}
DI void tr_item64(const float* W, size_t ldw, int K, bf16* WT, int k0, int sc0, int nd, LAS float* scr, int lane, int gsel = -1) {
    const int kr = lane >> 4, c4 = 4 * (lane & 15);
    f32x4 v[16];
#pragma unroll
    for (int i = 0; i < 16; ++i) v[i] = *(const f32x4*)(W + (size_t)(k0 + 4 * i + kr) * ldw + sc0 + c4);
#pragma unroll
    for (int i = 0; i < 16; ++i) { LAS float* d = scr + (4 * i + kr) * 65 + c4; d[0] = v[i].x; d[1] = v[i].y; d[2] = v[i].z; d[3] = v[i].w; }
    asm volatile("s_waitcnt lgkmcnt(0)" ::: "memory");
    const int c = lane & 7;
#pragma unroll
    for (int jj = 0; jj < 8; ++jj) { const int n = (lane >> 3) + 8 * jj; const LAS float* s = scr + (8 * c) * 65 + n;
        u32x4 o; o.x = pk2(s[0 * 65], s[1 * 65]); o.y = pk2(s[2 * 65], s[3 * 65]); o.z = pk2(s[4 * 65], s[5 * 65]); o.w = pk2(s[6 * 65], s[7 * 65]);
        int nr = n;
        if (gsel >= 0 && gsel < 4) nr = 128 * (gsel >> 1) + 32 * (n >> 4) + 8 * ((n >> 2) & 3) + 4 * (gsel & 1) + (n & 3);
        if (gsel == 4 && n < 32) nr = 8 * ((n & 15) >> 2) + (n & 3) + 4 * (n >> 4);
        if (gsel == 5 && n < 16) nr = 8 * ((n & 7) >> 2) + (n & 3) + 4 * (n >> 3);
        *(u32x4*)(WT + (size_t)(nd + nr) * K + k0 + 8 * c) = o; }
    asm volatile("s_waitcnt lgkmcnt(0)" ::: "memory");
}
DI int map1_base(int n0) { return n0 < 2048 ? n0 : (n0 < 6656 ? n0 + 16 : (n0 < 10752 ? n0 + 88 : n0 + 280)); }
DI void phase_prologue(const Args& a, LAS unsigned char* lds, int tid, int lane, int wave, int bid, int G, int sel = 15) {
    LAS float* scr = (LAS float*)(lds + wave * 16640);
    const int gw = bid * 8 + wave, NGW = G * 8;
    constexpr int I1 = 32 * 232, IS = 32 * 16, IM = 32 * 128, IP = 4 * 16 * 32, IO = 32 * 32, IL = I1 + IS + IM + IP + IO;
    if (sel & 1) for (int it = gw; it < 2 * IL; it += NGW) {
        const int l = it / IL; int r = it - l * IL;
        const float* win = a.in[4] + (size_t)l * DM * NIN;
        if (r < I1) { const int kb = r % 32, nb = r / 32; const int n0 = 64 * nb, gs = (n0 >= BQ && n0 < BV && (n0 & 127) == 0) ? 4 : ((n0 >= BIQ && n0 < BG) ? 5 : -1);
            tr_item64(win, NIN, DM, (bf16*)(a.ws + WS_WT1) + (size_t)l * N1 * DM, 64 * kb, map1_base(n0), n0, scr, lane, gs); continue; } r -= I1;
        if (r < IS) { const int kb = r % 32, nb = 464 + r / 32; tr_item(win, NIN, DM, (bf16*)(a.ws + WS_WT1) + (size_t)l * N1 * DM, 64 * kb, map1(32 * nb + (lane & 31)), 32 * nb, scr, lane); continue; } r -= IS;
        if (r < IM) { const int kb = r % 32, nb = r / 32; tr_item64(win, NIN, DM, (bf16*)(a.ws + WS_WTM) + (size_t)l * NM * DM, 64 * kb, 15128 + 64 * nb, 256 * (nb & 31), scr, lane, nb >> 5); continue; } r -= IM;
        if (r < IP) { const int g = r / 512, q = r % 512, kb = q % 16, nb = q / 16;
            tr_item64(a.in[22] + ((size_t)(l * 4 + g) << 21), DM, BW, (bf16*)(a.ws + WS_WTP) + ((size_t)(l * 4 + g) << 21), 64 * kb, 64 * nb, 64 * nb, scr, lane); continue; } r -= IP;
        { const int kb = r % 32, nb = r / 32; tr_item64(a.in[23] + ((size_t)l << 22), DM, DM, (bf16*)(a.ws + WS_WTO) + ((size_t)l << 22), 64 * kb, 64 * nb, 64 * nb, scr, lane); }
    }
    if (sel & 2) { f32x2* rope = (f32x2*)(a.ws + WS_ROPE);
      for (int e = bid * 512 + tid; e < T * 24; e += G * 512) { const int t = e / 24, i = e - t * 24;
          const float inv = i < 16 ? (float)pow(500000.0, -(double)(2 * i) / 32.0) : (float)pow(500000.0, -(double)(2 * (i - 16)) / 16.0);
          const float ang = (float)a.pos[t] * inv; double sd, cd; sincos((double)ang, &sd, &cd); f32x2 o; o.x = (float)cd; o.y = (float)sd; rope[e] = o; } }
    if (sel & 4) { bf16* wl = (bf16*)(a.ws + WS_WLR);
      for (int e = bid * 512 + tid; e < 2 * 2 * 96 * 1024; e += G * 512) { const int n = e & 1023, k = (e >> 10) % 96, lm = (e >> 10) / 96, l = lm >> 1, m = lm & 1;
          const float x = a.in[m ? 12 : 10][(size_t)l * 96 * BW + k * BW + n]; const bf16 hi = f2bf(x); const bf16 lo = f2bf(x - bf2f(hi));
          wl[((size_t)(lm * 2 + 0) * 1024 + n) * 96 + k] = hi; wl[((size_t)(lm * 2 + 1) * 1024 + n) * 96 + k] = lo; } }
    bf16* wsb = (bf16*)(a.ws + WS_WSB);
    if (sel & 8) for (int e = bid * 512 + tid; e < 2 * 8 * 128 * 128; e += G * 512) { const int j = e & 127, i = (e >> 7) & 127; wsb[e] = (i < 64 && j >= 64) ? (bf16)0 : f2bf(a.in[20][e]); }
}

DI void phase_prenorm(const float* x, const float* g, bf16* h, int gw, int NGW, int lane) {
    for (int m = gw; m < T; m += NGW) {
        const f32x4* xr = (const f32x4*)(x + (size_t)m * DM) + lane; f32x4 v[8]; float s = 0.f;
#pragma unroll
        for (int j = 0; j < 8; ++j) { v[j] = xr[64 * j]; s += (v[j].x * v[j].x + v[j].y * v[j].y) + (v[j].z * v[j].z + v[j].w * v[j].w); }
        const float rs = 1.0f / sqrtf(wave_sum(s) * (1.0f / DM) + 1e-6f);
        u32x2* o = (u32x2*)(h + (size_t)m * DM) + lane;
#pragma unroll
        for (int j = 0; j < 8; ++j) { const f32x4 gv = ((const f32x4*)g)[lane + 64 * j]; u32x2 w; w.x = pk2(v[j].x * rs * gv.x, v[j].y * rs * gv.y); w.y = pk2(v[j].z * rs * gv.z, v[j].w * rs * gv.w); o[64 * j] = w; }
    }
}
DI void phase_postnorm(const float* x, const float* y, const float* g, float* out, const float* gnext, bf16* hnext, int gw, int NGW, int lane) {
    for (int m = gw; m < T; m += NGW) {
        const f32x4* yr = (const f32x4*)(y + (size_t)m * DM) + lane; const f32x4* xr = (const f32x4*)(x + (size_t)m * DM) + lane; f32x4 v[8], xv[8]; float s = 0.f;
#pragma unroll
        for (int j = 0; j < 8; ++j) { v[j] = yr[64 * j]; xv[j] = xr[64 * j]; s += (v[j].x * v[j].x + v[j].y * v[j].y) + (v[j].z * v[j].z + v[j].w * v[j].w); }
        const float rs = 1.0f / sqrtf(wave_sum(s) * (1.0f / DM) + 1e-6f);
        f32x4* o = (f32x4*)(out + (size_t)m * DM) + lane; float s2 = 0.f;
#pragma unroll
        for (int j = 0; j < 8; ++j) { const f32x4 gv = ((const f32x4*)g)[lane + 64 * j]; const f32x4 r = xv[j] + v[j] * rs * gv; o[64 * j] = r; v[j] = r; s2 += (r.x * r.x + r.y * r.y) + (r.z * r.z + r.w * r.w); }
        if (hnext) {
            const float rs2 = 1.0f / sqrtf(wave_sum(s2) * (1.0f / DM) + 1e-6f);
            u32x2* ho = (u32x2*)(hnext + (size_t)m * DM) + lane;
#pragma unroll
            for (int j = 0; j < 8; ++j) { const f32x4 gv = ((const f32x4*)gnext)[lane + 64 * j]; u32x2 w; w.x = pk2(v[j].x * rs2 * gv.x, v[j].y * rs2 * gv.y); w.y = pk2(v[j].z * rs2 * gv.z, v[j].w * rs2 * gv.w); ho[64 * j] = w; }
        }
    }
}
DI void phase_merge(const bf16* gates, const bf16* proj, bf16* merged, int gtid, int NT) {
    for (int it = gtid; it < T * (DM / 8); it += NT) {
        const int t = it >> 8, d = (it & 255) * 8;
        float acc[8];
#pragma unroll
        for (int e = 0; e < 8; ++e) acc[e] = 0.f;
#pragma unroll
        for (int g = 0; g < 4; ++g) { const u32x4 gv = *(const u32x4*)(gates + (size_t)t * NM + g * DM + d); const u32x4 pv = *(const u32x4*)(proj + ((size_t)g * T + t) * DM + d);
#pragma unroll
            for (int e = 0; e < 4; ++e) { acc[2 * e] += bflo(gv[e]) * bflo(pv[e]); acc[2 * e + 1] += bfhi(gv[e]) * bfhi(pv[e]); } }
        u32x4 o; o.x = pk2(acc[0], acc[1]); o.y = pk2(acc[2], acc[3]); o.z = pk2(acc[4], acc[5]); o.w = pk2(acc[6], acc[7]);
        *(u32x4*)(merged + (size_t)t * DM + d) = o;
    }
}

struct RopeL { unsigned short q[2][2][2]; unsigned short iq[2]; float ik[2]; f32x2 csa, csi; };
DI void rope_load(RopeL& L, const bf16* P, const float* SM, const f32x2* rope, int t, int lane) {
    const int i = lane & 15, i8 = lane & 7;
    L.csa = rope[(unsigned)t * 24 + i]; L.csi = rope[(unsigned)t * 24 + 16 + i8];
#pragma unroll
    for (int r = 0; r < 2; ++r)
#pragma unroll
        for (int w = 0; w < 2; ++w) { const bf16* q = P + (unsigned)t * LDP + (w ? BK_ : BQ) + ((lane + 64 * r) >> 4) * 128 + i; L.q[r][w][0] = q[0]; L.q[r][w][1] = q[16]; }
    { const bf16* q = P + (unsigned)t * LDP + BIQ + (lane >> 3) * 64 + i8; L.iq[0] = q[0]; L.iq[1] = q[8]; }
    { const float* q = SM + (unsigned)t * 512 + IK + i8; L.ik[0] = q[0]; L.ik[1] = q[8]; }
}
DI void rope_finish(const RopeL& L, bf16* P, float* SM, int t, int lane) {
    const int i = lane & 15, i8 = lane & 7;
#pragma unroll
    for (int r = 0; r < 2; ++r)
#pragma unroll
        for (int w = 0; w < 2; ++w) { bf16* q = P + (unsigned)t * LDP + (w ? BK_ : BQ) + ((lane + 64 * r) >> 4) * 128 + i; const float x1 = bf2f(L.q[r][w][0]), x2 = bf2f(L.q[r][w][1]);
            q[0] = f2bf(x1 * L.csa.x - x2 * L.csa.y); q[16] = f2bf(x2 * L.csa.x + x1 * L.csa.y); }
    { bf16* q = P + (unsigned)t * LDP + BIQ + (lane >> 3) * 64 + i8; const float x1 = bf2f(L.iq[0]), x2 = bf2f(L.iq[1]); q[0] = f2bf(x1 * L.csi.x - x2 * L.csi.y); q[8] = f2bf(x2 * L.csi.x + x1 * L.csi.y); }
    if (lane < 8) { float* q = SM + (unsigned)t * 512 + IK + i8; q[0] = L.ik[0] * L.csi.x - L.ik[1] * L.csi.y; q[8] = L.ik[1] * L.csi.x + L.ik[0] * L.csi.y; }
}
struct SguL { u32x4 v[2]; };
DI void sgu_load(SguL& L, const bf16* P, int t, int lane) {
#pragma unroll
    for (int r = 0; r < 2; ++r) L.v[r] = *(const u32x4*)(P + (unsigned)t * LDP + DV + 8 * lane + 512 * r);
}
DI void sgu_finish(const SguL& L, bf16* P, const float* lng, const float* lnb, int t, int lane) {
    bf16* vrow = P + (unsigned)t * LDP + DV;
    float x[16]; float s = 0.f;
#pragma unroll
    for (int r = 0; r < 2; ++r)
#pragma unroll
        for (int e = 0; e < 4; ++e) { x[8 * r + 2 * e] = bflo(L.v[r][e]); x[8 * r + 2 * e + 1] = bfhi(L.v[r][e]); }
#pragma unroll
    for (int e = 0; e < 16; ++e) s += x[e];
    const float mean = wave_sum(s) * (1.0f / 1024.0f); float s2 = 0.f;
#pragma unroll
    for (int e = 0; e < 16; ++e) { x[e] -= mean; s2 += x[e] * x[e]; }
    const float rstd = 1.0f / sqrtf(wave_sum(s2) * (1.0f / 1024.0f) + 1e-5f);
#pragma unroll
    for (int r = 0; r < 2; ++r) { const int c0 = 8 * lane + 512 * r; const f32x4 g0 = *(const f32x4*)(lng + c0), g1 = *(const f32x4*)(lng + c0 + 4), b0 = *(const f32x4*)(lnb + c0), b1 = *(const f32x4*)(lnb + c0 + 4);
        u32x4 o; o.x = pk2(x[8 * r + 0] * rstd * g0.x + b0.x, x[8 * r + 1] * rstd * g0.y + b0.y); o.y = pk2(x[8 * r + 2] * rstd * g0.z + b0.z, x[8 * r + 3] * rstd * g0.w + b0.w);
        o.z = pk2(x[8 * r + 4] * rstd * g1.x + b1.x, x[8 * r + 5] * rstd * g1.y + b1.y); o.w = pk2(x[8 * r + 6] * rstd * g1.z + b1.z, x[8 * r + 7] * rstd * g1.w + b1.w);
        *(u32x4*)(vrow + c0) = o; }
}
DI float quad_sum(float x) {
    x += __builtin_bit_cast(float, __builtin_amdgcn_update_dpp(0, __builtin_bit_cast(int, x), 0xB1, 0xf, 0xf, false));
    x += __builtin_bit_cast(float, __builtin_amdgcn_update_dpp(0, __builtin_bit_cast(int, x), 0x4E, 0xf, 0xf, false));
    return x;
}
struct RwkvL { u32x4 c[3][2], p[3][2]; };
DI void rwkvp_load(RwkvL& L, const bf16* P, int t, int lane) {
    const bool hp = (t & (SEQ - 1)) > 0; const int j = 16 * lane;
    const bf16* pc = P + (unsigned)t * LDP + j; const bf16* pp = hp ? pc - LDP : pc;
#pragma unroll
    for (int w = 0; w < 3; ++w) { const int off = w == 0 ? CR : (w == 1 ? CK : CV);
#pragma unroll
        for (int q = 0; q < 2; ++q) { L.c[w][q] = *(const u32x4*)(pc + off + 8 * q); u32x4 p = *(const u32x4*)(pp + off + 8 * q); if (!hp) { p.x = 0u; p.y = 0u; p.z = 0u; p.w = 0u; } L.p[w][q] = p; } }
}
DI void rwkvp_finish(const RwkvL& L, const Args& a, int l, int t, int lane) {
    bf16* RWr = (bf16*)(a.ws + WS_RW); bf16* RWk = RWr + (size_t)T * 1024; bf16* RWv = RWk + (size_t)T * 1024; bf16* RWkk = RWv + (size_t)T * 1024;
    const float* mu = a.in[8] + l * 4288; const float* kkc = a.in[13] + l * BW;
    const int j = 16 * lane;
    float kl[16]; float ss = 0.f;
#pragma unroll
    for (int w = 0; w < 3; ++w) {
        bf16* dst = (w == 0 ? RWr : (w == 1 ? RWk : RWv)) + (unsigned)t * 1024 + j;
#pragma unroll
        for (int q = 0; q < 2; ++q) { const u32x4 c = L.c[w][q], p = L.p[w][q];
            const f32x4 m0 = *(const f32x4*)(mu + 1024 * w + j + 8 * q), m1 = *(const f32x4*)(mu + 1024 * w + j + 8 * q + 4);
            float x[8];
#pragma unroll
            for (int e = 0; e < 4; ++e) { const float c0 = bflo(c[e]), c1 = bfhi(c[e]), p0 = bflo(p[e]), p1 = bfhi(p[e]); const float ma = e < 2 ? m0[2 * e] : m1[2 * e - 4], mb = e < 2 ? m0[2 * e + 1] : m1[2 * e - 3];
                x[2 * e] = c0 + (p0 - c0) * ma; x[2 * e + 1] = c1 + (p1 - c1) * mb; }
            u32x4 o; o.x = pk2(x[0], x[1]); o.y = pk2(x[2], x[3]); o.z = pk2(x[4], x[5]); o.w = pk2(x[6], x[7]);
            *(u32x4*)(dst + 8 * q) = o;
            if (w == 1) { const f32x4 k0 = *(const f32x4*)(kkc + j + 8 * q), k1 = *(const f32x4*)(kkc + j + 8 * q + 4);
#pragma unroll
                for (int e = 0; e < 8; ++e) { const float kk = x[e] * (e < 4 ? k0[e & 3] : k1[e & 3]); kl[8 * q + e] = kk; ss += kk * kk; } }
        }
    }
    const float rn = 1.0f / sqrtf(quad_sum(ss) + 1e-12f);
    u32x4 o0, o1; o0.x = pk2(kl[0] * rn, kl[1] * rn); o0.y = pk2(kl[2] * rn, kl[3] * rn); o0.z = pk2(kl[4] * rn, kl[5] * rn); o0.w = pk2(kl[6] * rn, kl[7] * rn);
    o1.x = pk2(kl[8] * rn, kl[9] * rn); o1.y = pk2(kl[10] * rn, kl[11] * rn); o1.z = pk2(kl[12] * rn, kl[13] * rn); o1.w = pk2(kl[14] * rn, kl[15] * rn);
    *(u32x4*)(RWkk + (unsigned)t * 1024 + j) = o0; *(u32x4*)(RWkk + (unsigned)t * 1024 + j + 8) = o1;
}
DI void prep_lowrank_unit(const Args& a, int l, int unit, LAS unsigned char* lds, int tid, int lane, int wave) {
    const float* SM = (const float*)(a.ws + WS_SM);
    bf16* RWa = (bf16*)(a.ws + WS_RW) + (size_t)4 * T * 1024; float* RWw = (float*)(a.ws + WS_RW + 6 * RW_ARR);
    const float* mu = a.in[8] + l * 4288;
    const int t0 = unit * 32, s0 = t0 & (SEQ - 1);
    LAS bf16* AH = (LAS bf16*)lds;
    for (int e = tid; e < 32 * 96; e += 512) { const int tok = e / 96, i = e - tok * 96; const int t = t0 + tok; const bool hp = (s0 + tok) > 0;
        const float cw = SM[(unsigned)t * 512 + WLR + i], pw = hp ? SM[(unsigned)(t - 1) * 512 + WLR + i] : 0.f; const float xw = tanhf(cw + (pw - cw) * mu[3072 + i]);
        const float ca = SM[(unsigned)t * 512 + ALR + i], pa = hp ? SM[(unsigned)(t - 1) * 512 + ALR + i] : 0.f; const float xa = ca + (pa - ca) * mu[3168 + i];
        const bf16 hw = f2bf(xw), ha = f2bf(xa);
        AH[(0 * 32 + tok) * 104 + i] = hw; AH[(1 * 32 + tok) * 104 + i] = f2bf(xw - bf2f(hw)); AH[(2 * 32 + tok) * 104 + i] = ha; AH[(3 * 32 + tok) * 104 + i] = f2bf(xa - bf2f(ha)); }
    __syncthreads();
    const int r32 = lane & 31, hh = lane >> 5;
    const bf16* WL = (const bf16*)(a.ws + WS_WLR) + (size_t)l * (2 * 2 * 1024 * 96);
#pragma unroll 1
    for (int c = 0; c < 4; ++c) {
        const int n = 128 * wave + 32 * c + r32;
        f32x16 aw, aa;
#pragma unroll
        for (int r = 0; r < 16; ++r) { aw[r] = 0.f; aa[r] = 0.f; }
        bf16x8 Bf[3][4];
#define LR_LD(slot_, s_) do { _Pragma("unroll") for (int mp_ = 0; mp_ < 4; ++mp_) Bf[slot_][mp_] = *(const bf16x8*)(WL + ((unsigned)(mp_ * 1024 + n)) * 96 + 16 * (s_) + 8 * hh); } while (0)
        LR_LD(0, 0); LR_LD(1, 1);
#pragma unroll
        for (int st = 0; st < 6; ++st) {
            if (st + 2 < 6) LR_LD((st + 2) % 3, st + 2);
            __builtin_amdgcn_sched_barrier(0);
            const bf16x8 Ahw = *(const LAS bf16x8*)(AH + (0 * 32 + r32) * 104 + 16 * st + 8 * hh), Alw = *(const LAS bf16x8*)(AH + (1 * 32 + r32) * 104 + 16 * st + 8 * hh);
            const bf16x8 Aha = *(const LAS bf16x8*)(AH + (2 * 32 + r32) * 104 + 16 * st + 8 * hh), Ala = *(const LAS bf16x8*)(AH + (3 * 32 + r32) * 104 + 16 * st + 8 * hh);
            aw = MFMA32(Ahw, Bf[st % 3][0], aw); aw = MFMA32(Ahw, Bf[st % 3][1], aw); aw = MFMA32(Alw, Bf[st % 3][0], aw);
            aa = MFMA32(Aha, Bf[st % 3][2], aa); aa = MFMA32(Aha, Bf[st % 3][3], aa); aa = MFMA32(Ala, Bf[st % 3][2], aa);
        }
#undef LR_LD
        const float w0 = a.in[9][l * BW + n], a0 = a.in[11][l * BW + n];
#pragma unroll
        for (int r = 0; r < 16; ++r) { const unsigned o = (unsigned)(t0 + crow(r, hh)) * 1024 + n;
            RWw[o] = __expf(-0.606531f * sigmoidf_(w0 + aw[r])); RWa[o] = f2bf(sigmoidf_(a0 + aa[r])); }
    }
    __syncthreads();
}
DI void vt_unit(const Args& a, int unit, LAS unsigned char* lds, int tid) {
    const bf16* P = (const bf16*)(a.ws + WS_P); bf16* VT = (bf16*)(a.ws + WS_VT);
    const int hd = unit & 7, st = (unit >> 3) & 63, b = unit >> 9;
    LAS bf16* tile = (LAS bf16*)lds;
#pragma unroll
    for (int r = 0; r < 2; ++r) { const int ch = tid + 512 * r, s = ch >> 4, c = ch & 15;
        *(LAS u32x4*)(tile + s * 136 + 8 * c) = *(const u32x4*)(P + (unsigned)(b * SEQ + st * 64 + s) * LDP + BV + hd * 128 + 8 * c); }
    __syncthreads();
    { const int d = tid & 127, sq = tid >> 7; unsigned w[8];
#pragma unroll
      for (int i = 0; i < 8; ++i) w[i] = (unsigned)tile[(16 * sq + 2 * i) * 136 + d] | ((unsigned)tile[(16 * sq + 2 * i + 1) * 136 + d] << 16);
      bf16* o = VT + ((unsigned)((b * 8 + hd) * 128 + d)) * SEQ + st * 64 + 16 * sq;
      u32x4 o0, o1; o0.x = w[0]; o0.y = w[1]; o0.z = w[2]; o0.w = w[3]; o1.x = w[4]; o1.y = w[5]; o1.z = w[6]; o1.w = w[7];
      *(u32x4*)o = o0; *(u32x4*)(o + 8) = o1; }
    __syncthreads();
}

typedef short s16x4 __attribute__((ext_vector_type(4)));
DI bf16x8 tr_frag(const LAS unsigned char* p, int rs4) {
    const s16x4 lo = __builtin_bit_cast(s16x4, __builtin_amdgcn_ds_read_tr16_b64_v4i16((LAS s16x4*)p));
    const s16x4 hi = __builtin_bit_cast(s16x4, __builtin_amdgcn_ds_read_tr16_b64_v4i16((LAS s16x4*)(p + rs4)));
    return __builtin_shufflevector(lo, hi, 0, 1, 2, 3, 4, 5, 6, 7);
}
DI void gla_kv_unit(const Args& a, int l, int unit, LAS unsigned char* lds, int tid, int lane, int wave) {
    const bf16* P = (const bf16*)(a.ws + WS_P); const float* SM = (const float*)(a.ws + WS_SM);
    const int hd = unit & 3, c = (unit >> 2) & 63, b = unit >> 8;
    LAS float* la = (LAS float*)lds;
    LAS float* ptot = la + 64 * 128;
    LAS float* glr = ptot + 4 * 128;
    LAS float* wgl = glr + 64 * 16;
    const int k2 = tid & 127, cg = tid >> 7;
    const int t0 = b * SEQ + c * 64;
    u32x4 kr[2]; float wv[4];
#pragma unroll
    for (int r = 0; r < 2; ++r) { const int pc = tid + 512 * r; kr[r] = *(const u32x4*)(P + (unsigned)(t0 + (pc >> 4)) * LDP + AK + hd * 128 + (pc & 15) * 8); }
#pragma unroll
    for (int r = 0; r < 4; ++r) { const int e = tid + 512 * r; wv[r] = a.in[5][(unsigned)(l * 16 * 512 + (e >> 7) * 512 + hd * 128 + (e & 127))]; }
    const float bg = a.in[6][l * 512 + hd * 128 + k2];
    const f32x4 gl = *(const f32x4*)(SM + (unsigned)(t0 + ((tid & 255) >> 2)) * 512 + GLR + (tid & 3) * 4);
    __builtin_amdgcn_sched_barrier(0);
#pragma unroll
    for (int r = 0; r < 4; ++r) wgl[tid + 512 * r] = wv[r];
    if (tid < 256) *(LAS f32x4*)(glr + (tid >> 2) * 16 + (tid & 3) * 4) = gl;
    __syncthreads();
    float pre[16]; float run = 0.f;
    { float wr[16];
#pragma unroll
      for (int q = 0; q < 16; ++q) wr[q] = wgl[q * 128 + k2];
#pragma unroll
      for (int i = 0; i < 16; ++i) { const int tok = cg * 16 + i; float x = bg;
#pragma unroll
          for (int q = 0; q < 4; ++q) { const f32x4 gv = *(const LAS f32x4*)(glr + tok * 16 + 4 * q); x += gv.x * wr[4 * q] + gv.y * wr[4 * q + 1] + gv.z * wr[4 * q + 2] + gv.w * wr[4 * q + 3]; }
          run += logsigmoidf_(x) * (1.0f / 16.0f); pre[i] = run; } }
    ptot[cg * 128 + k2] = run;
    __syncthreads();
    { const float p0 = ptot[k2], p1 = ptot[128 + k2], p2 = ptot[256 + k2], p3 = ptot[384 + k2];
      const float tot = ((p0 + p1) + p2) + p3;
      const float off = cg == 0 ? 0.f : cg == 1 ? p0 : cg == 2 ? p0 + p1 : (p0 + p1) + p2;
      const float base = tot - off;
#pragma unroll
      for (int i = 0; i < 16; ++i) la[(cg * 16 + i) * 128 + k2] = __expf(base - pre[i]);
      if (cg == 0) ((float*)(a.ws + WS_ET))[(unsigned)unit * 128 + k2] = __expf(tot); }
    __syncthreads();
    bf16* KD = (bf16*)(a.ws + WS_KV) + (unsigned)unit * (64 * 128);
#pragma unroll
    for (int r = 0; r < 2; ++r) { const int pc = tid + 512 * r, tok = pc >> 4, kg = pc & 15;
        const f32x4 d0 = *(const LAS f32x4*)(la + tok * 128 + kg * 8), d1 = *(const LAS f32x4*)(la + tok * 128 + kg * 8 + 4);
        u32x4 o; o.x = pk2(bflo(kr[r].x) * d0.x, bfhi(kr[r].x) * d0.y); o.y = pk2(bflo(kr[r].y) * d0.z, bfhi(kr[r].y) * d0.w);
        o.z = pk2(bflo(kr[r].z) * d1.x, bfhi(kr[r].z) * d1.y); o.w = pk2(bflo(kr[r].w) * d1.z, bfhi(kr[r].w) * d1.w);
        *(u32x4*)(KD + pc * 8) = o; }
    __syncthreads();
}
DI void gla_scan_unit(const Args& a, int l, int unit, LAS unsigned char* lds, int tid, int lane, int wave) {
    const bf16* P = (const bf16*)(a.ws + WS_P); bf16* YA = (bf16*)(a.ws + WS_YS);
    const int b = unit >> 2, hd = unit & 3, r32 = lane & 31, hh = lane >> 5;
    LAS float* etl = (LAS float*)lds;
    LAS float* ssq = etl + 64 * 128;
    LAS float* hgl = ssq + 64 * 16;
    LAS bf16* qbuf = (LAS bf16*)(hgl + 256);
    LAS unsigned char* kimg = (LAS unsigned char*)(qbuf + 64 * 132);
    LAS unsigned char* vimg = kimg + 64 * 320;
    { const float* ET = (const float*)(a.ws + WS_ET);
      for (int e = tid; e < 64 * 128; e += 512) { const int c = e >> 7, k = e & 127; etl[e] = ET[(unsigned)(((b * 64 + c) * 4 + hd) * 128 + k)]; }
      if (tid < 256) hgl[tid] = a.in[7][l * 256 + tid]; }
    const int qrow = tid >> 3, qseg = tid & 7;
    const bf16* KDb = (const bf16*)(a.ws + WS_KV) + (unsigned)((b * 64) * 4 + hd) * (64 * 128);
    u32x4 Kn[2], Vn[4], Qn[2]; u32x2 Gt[2][4];
#define GS_LOAD(c_) do { const int cc_ = (c_) < 64 ? (c_) : 63; int tl_ = tid; asm volatile("" : "+v"(tl_)); \
        const bf16* Pc_ = P + (size_t)(b * SEQ + cc_ * 64) * LDP; const bf16* Kc_ = KDb + (size_t)cc_ * (4 * 8192); \
        _Pragma("unroll") for (int r = 0; r < 2; ++r) Kn[r] = *(const u32x4*)(Kc_ + (unsigned)(tl_ * 8 + 4096 * r)); \
        _Pragma("unroll") for (int r = 0; r < 4; ++r) Vn[r] = *(const u32x4*)(Pc_ + (unsigned)(((tl_ >> 5) + 16 * r) * LDP + AV + hd * 256 + (tl_ & 31) * 8)); \
        Qn[0] = *(const u32x4*)(Pc_ + (unsigned)((tl_ >> 3) * LDP + AQ + hd * 128 + 16 * (tl_ & 7))); Qn[1] = *(const u32x4*)(Pc_ + (unsigned)((tl_ >> 3) * LDP + AQ + hd * 128 + 16 * (tl_ & 7) + 8)); } while (0)
#define GS_PUT() do { \
        _Pragma("unroll") for (int r = 0; r < 2; ++r) { const int pc = tid + 512 * r; *(LAS u32x4*)(kimg + (pc >> 4) * 320 + (pc & 15) * 16) = Kn[r]; } \
        _Pragma("unroll") for (int r = 0; r < 4; ++r) { const int pc = tid + 512 * r; *(LAS u32x4*)(vimg + (pc >> 5) * 576 + (pc & 31) * 16) = Vn[r]; } \
        { LAS u32x2* d = (LAS u32x2*)(qbuf + qrow * 132 + 16 * qseg); u32x2 t; t.x = Qn[0].x; t.y = Qn[0].y; d[0] = t; t.x = Qn[0].z; t.y = Qn[0].w; d[1] = t; t.x = Qn[1].x; t.y = Qn[1].y; d[2] = t; t.x = Qn[1].z; t.y = Qn[1].w; d[3] = t; } } while (0)
#define GS_GATE(c_) do { const int cc_ = (c_) < 64 ? (c_) : 63; int tl_ = tid; asm volatile("" : "+v"(tl_)); \
        const bf16* Pc_ = P + (size_t)(b * SEQ + cc_ * 64) * LDP; \
        _Pragma("unroll") for (int ct = 0; ct < 2; ++ct) _Pragma("unroll") for (int g = 0; g < 4; ++g) \
            Gt[ct][g] = *(const u32x2*)(Pc_ + (unsigned)((32 * ct + (tl_ & 31)) * LDP + AG + hd * 256 + 32 * wave + 4 * ((tl_ >> 5) & 1) + 8 * g)); } while (0)
    GS_LOAD(0); GS_GATE(0);
    __builtin_amdgcn_sched_barrier(0);
    GS_PUT();
    GS_LOAD(1);
    f32x16 S[4];
#pragma unroll
    for (int kt = 0; kt < 4; ++kt)
#pragma unroll
        for (int r = 0; r < 16; ++r) S[kt][r] = 0.f;
    const int rhalf = (lane >> 4) & 1, qi = (lane >> 2) & 3, pi = lane & 3;
    const LAS unsigned char* vb = vimg + (8 * hh + qi) * 576 + (32 * wave + 16 * rhalf + 4 * pi) * 2;
    const LAS unsigned char* kb = kimg + (8 * hh + qi) * 320 + (16 * rhalf + 4 * pi) * 2;
    __syncthreads();
#pragma unroll 1
    for (int c = 0; c < 64; ++c) {
        const int t0 = b * SEQ + c * 64;
#pragma unroll
        for (int kt = 0; kt < 4; ++kt) {
#pragma unroll
            for (int g4 = 0; g4 < 4; ++g4) { const f32x4 e = *(const LAS f32x4*)(etl + c * 128 + 32 * kt + 8 * g4 + 4 * hh);
                S[kt][4 * g4] *= e.x; S[kt][4 * g4 + 1] *= e.y; S[kt][4 * g4 + 2] *= e.z; S[kt][4 * g4 + 3] *= e.w; }
#pragma unroll
            for (int st = 0; st < 4; ++st) { const bf16x8 A = tr_frag(kb + 16 * st * 320 + 64 * kt, 4 * 320), Bv = tr_frag(vb + 16 * st * 576, 4 * 576); S[kt] = MFMA32(A, Bv, S[kt]); }
            __builtin_amdgcn_sched_barrier(0); }
        f32x16 O[2];
#pragma unroll
        for (int ct = 0; ct < 2; ++ct) {
#pragma unroll
            for (int r = 0; r < 16; ++r) O[ct][r] = 0.f;
#pragma unroll
            for (int kt = 0; kt < 4; ++kt)
#pragma unroll
                for (int s2 = 0; s2 < 2; ++s2) { const bf16x8 Sf = pack_step(S[kt], s2);
                    const LAS bf16* qp = qbuf + (32 * ct + r32) * 132 + 32 * kt + 16 * s2 + 4 * hh;
                    const bf16x8 Qf = join8(*(const LAS u32x2*)qp, *(const LAS u32x2*)(qp + 8)); O[ct] = MFMA32(Sf, Qf, O[ct]); }
            __builtin_amdgcn_sched_barrier(0);
            float ss = 0.f;
#pragma unroll
            for (int r = 0; r < 16; ++r) { O[ct][r] *= 0.08838834764831845f; ss += O[ct][r] * O[ct][r]; }
            ssq[(32 * ct + r32) * 16 + 2 * wave + hh] = ss;
        }
        __syncthreads();
        GS_PUT();
        GS_LOAD(c + 2);
        __builtin_amdgcn_sched_barrier(0);
#pragma unroll
        for (int ct = 0; ct < 2; ++ct) { const LAS f32x4* sp = (const LAS f32x4*)(ssq + (32 * ct + r32) * 16);
            const f32x4 s0 = sp[0], s1 = sp[1], s2 = sp[2], s3 = sp[3];
            const float tot = ((s0.x + s0.y) + (s0.z + s0.w)) + ((s1.x + s1.y) + (s1.z + s1.w)) + ((s2.x + s2.y) + (s2.z + s2.w)) + ((s3.x + s3.y) + (s3.z + s3.w));
            const float rs = 1.0f / sqrtf(tot * (1.0f / 256.0f) + 1e-6f);
            int tl_ = tid; asm volatile("" : "+v"(tl_));
            bf16* yp = YA + (size_t)t0 * 1024 + (unsigned)((32 * ct + (tl_ & 31)) * 1024 + hd * 256 + 32 * wave + 4 * ((tl_ >> 5) & 1));
#pragma unroll
            for (int g = 0; g < 4; ++g) { const f32x4 hg = *(const LAS f32x4*)(hgl + 32 * wave + 8 * g + 4 * hh); const u32x2 gt = Gt[ct][g];
                u32x2 w; w.x = pk2(O[ct][4 * g] * rs * hg.x * siluf_(bflo(gt.x)), O[ct][4 * g + 1] * rs * hg.y * siluf_(bfhi(gt.x)));
                w.y = pk2(O[ct][4 * g + 2] * rs * hg.z * siluf_(bflo(gt.y)), O[ct][4 * g + 3] * rs * hg.w * siluf_(bfhi(gt.y)));
                *(u32x2*)(yp + 8 * g) = w; } }
        GS_GATE(c + 1);
        __syncthreads();
    }
#undef GS_LOAD
#undef GS_PUT
#undef GS_GATE
}

DI void mm16x8(f32x4& acc0, f32x4& acc1, const LAS float* ap, const LAS float* bp, int bstep) {
    float av[8], bv[8];
#pragma unroll
    for (int j = 0; j < 8; ++j) { av[j] = ap[4 * j]; bv[j] = bp[j * bstep]; }
#pragma unroll
    for (int j = 0; j < 8; j += 2) { acc0 = __builtin_amdgcn_mfma_f32_16x16x4f32(av[j], bv[j], acc0, 0, 0, 0); acc1 = __builtin_amdgcn_mfma_f32_16x16x4f32(av[j + 1], bv[j + 1], acc1, 0, 0, 0); }
}
DI void helper_sync(volatile LAS unsigned* hs, unsigned& epoch, int lane) {
    asm volatile("s_waitcnt lgkmcnt(0)" ::: "memory");
    epoch += 4u;
    if (lane == 0) __hip_atomic_fetch_add((LAS unsigned*)hs, 1u, __ATOMIC_RELAXED, __HIP_MEMORY_SCOPE_WORKGROUP);
    while (*hs < epoch) __builtin_amdgcn_s_sleep(1);
    asm volatile("" ::: "memory");
}
DI void rwkv_unit(const Args& a, int l, int unit, LAS unsigned char* lds, int tid, int lane, int wave) {
    constexpr int TB = 32, NBLK = SEQ / TB, OPS = 256, BUF = TB * OPS;
    const bf16* RWr = (const bf16*)(a.ws + WS_RW); const bf16* RWk = RWr + (size_t)T * 1024; const bf16* RWv = RWk + (size_t)T * 1024; const bf16* RWkk = RWv + (size_t)T * 1024; const bf16* RWa = RWkk + (size_t)T * 1024;
    const float* RWw = (const float*)(a.ws + WS_RW + 6 * RW_ARR);
    bf16* YC = (bf16*)(a.ws + WS_YS) + (size_t)2 * T * 1024;
    const int half = unit & 1, hd = (unit >> 1) & 15, b = unit >> 5;
    LAS float* ob = (LAS float*)lds;
    LAS float* RT = ob + 2 * BUF;
    LAS float* BT = RT + 32 * 65;
    LAS float* KT = BT + 32 * 65;
    LAS float* NRB = KT + 32 * 65;
    LAS float* NRK = NRB + 32 * 33;
    LAS float* UU = NRK + 32 * 33;
    LAS float* S0 = UU + 2 * 1024;
    LAS float* VB = S0 + 2 * 32 * 65;
    LAS bf16* RB = (LAS bf16*)(VB + 3 * 1024);
    volatile LAS unsigned* hs = (volatile LAS unsigned*)(VB + 3 * 1024 + 2048);
    if (tid == 0) *hs = 0u;
    unsigned epoch = 0u;
    const int rg = lane >> 4, ks = lane & 15, row0 = 8 * (wave & 3) + 2 * rg;
    f32x2 S0a = {0.f, 0.f}, S0b = {0.f, 0.f}, S1a = {0.f, 0.f}, S1b = {0.f, 0.f};
    const int hid = wave - 4, htid = tid - 256;
    u32x2 gk[2], gkk[2], ga[2], gr[2], gv[2]; f32x4 gw[2];
    const f32x4 kav = *(const f32x4*)(a.in[14] + l * BW + hd * 64 + (htid & 15) * 4);
#define RW_SLOAD(blk_) do { const int tb_ = b * SEQ + (blk_) * TB; _Pragma("unroll") for (int j_ = 0; j_ < 2; ++j_) { const int pt_ = (htid >> 4) + 16 * j_, p4_ = (htid & 15) * 4; \
            const unsigned g_ = (unsigned)(tb_ + pt_) * 1024 + hd * 64 + p4_; \
            gk[j_] = *(const u32x2*)(RWk + g_); gkk[j_] = *(const u32x2*)(RWkk + g_); ga[j_] = *(const u32x2*)(RWa + g_); gr[j_] = *(const u32x2*)(RWr + g_); gw[j_] = *(const f32x4*)(RWw + g_); \
            gv[j_] = *(const u32x2*)(RWv + (unsigned)(tb_ + pt_) * 1024 + hd * 64 + 32 * half + (p4_ & 31)); } } while (0)
#define RW_SPUT(blk_) do { LAS float* d_ = ob + ((blk_) & 1) * BUF; LAS float* vd_ = VB + ((blk_) % 3) * 1024; _Pragma("unroll") for (int j_ = 0; j_ < 2; ++j_) { const int pt_ = (htid >> 4) + 16 * j_, p4_ = (htid & 15) * 4; \
            LAS float* q_ = d_ + pt_ * OPS + p4_; *(LAS u32x2*)(RB + ((blk_) & 1) * 2048 + pt_ * 64 + p4_) = gr[j_]; \
            f32x4 kk_, aa_, kl_; kk_.x = bflo(gkk[j_].x); kk_.y = bfhi(gkk[j_].x); kk_.z = bflo(gkk[j_].y); kk_.w = bfhi(gkk[j_].y); aa_.x = bflo(ga[j_].x); aa_.y = bfhi(ga[j_].x); aa_.z = bflo(ga[j_].y); aa_.w = bfhi(ga[j_].y); \
            kl_.x = bflo(gk[j_].x); kl_.y = bfhi(gk[j_].x); kl_.z = bflo(gk[j_].y); kl_.w = bfhi(gk[j_].y); \
            *(LAS f32x4*)(q_) = -kk_; *(LAS f32x4*)(q_ + 64) = gw[j_]; *(LAS f32x4*)(q_ + 128) = kk_ * aa_; *(LAS f32x4*)(q_ + 192) = kl_ * (1.0f + (aa_ - 1.0f) * kav); \
            if ((htid & 15) < 8) { f32x4 o_; o_.x = bflo(gv[j_].x); o_.y = bfhi(gv[j_].x); o_.z = bflo(gv[j_].y); o_.w = bfhi(gv[j_].y); *(LAS f32x4*)(vd_ + pt_ * 32 + p4_) = o_; } } } while (0)
    if (wave >= 4) { RW_SLOAD(0); RW_SPUT(0); RW_SLOAD(1); }
    __syncthreads();
#pragma unroll 1
    for (int blk = 0; blk <= NBLK; ++blk) {
        if (wave < 4) {
            if (blk < NBLK) {
                __builtin_amdgcn_s_setprio(2);
                const LAS float* cur = ob + (blk & 1) * BUF; const LAS float* vcur = VB + (blk % 3) * 1024;
                { LAS float* s0 = S0 + (blk & 1) * (32 * 65) + row0 * 65 + 4 * ks;
                  s0[0] = S0a.x; s0[1] = S0a.y; s0[2] = S0b.x; s0[3] = S0b.y; s0[65] = S1a.x; s0[66] = S1a.y; s0[67] = S1b.x; s0[68] = S1b.y; }
                LAS float* ub = UU + (blk & 1) * 1024 + row0;
                f32x4 onk[3], ow[3], oka[3], okk[3]; f32x2 ov[3];
#define RW_LD(slot_, t_) do { const LAS float* o_ = cur + (t_) * OPS + 4 * ks; onk[slot_] = *(const LAS f32x4*)(o_); ow[slot_] = *(const LAS f32x4*)(o_ + 64); oka[slot_] = *(const LAS f32x4*)(o_ + 128); \
        okk[slot_] = *(const LAS f32x4*)(o_ + 192); ov[slot_] = *(const LAS f32x2*)(vcur + (t_) * 32 + row0); } while (0)
                RW_LD(0, 0); RW_LD(1, 1);
#pragma unroll
                for (int t = 0; t < TB; ++t) {
                    if (t + 2 < TB) RW_LD((t + 2) % 3, t + 2);
                    __builtin_amdgcn_sched_barrier(0);
                    const f32x4 nk = onk[t % 3], w = ow[t % 3], ka = oka[t % 3], kk = okk[t % 3]; const f32x2 v2 = ov[t % 3];
                    const f32x2 nka = {nk.x, nk.y}, nkb = {nk.z, nk.w}, wa = {w.x, w.y}, wb = {w.z, w.w}, kaa = {ka.x, ka.y}, kab = {ka.z, ka.w}, kka = {kk.x, kk.y}, kkb = {kk.z, kk.w};
                    f32x2 p0 = S0a * nka + S0b * nkb, p1 = S1a * nka + S1b * nkb;
                    const float sa0 = row16_sum(p0.x + p0.y), sa1 = row16_sum(p1.x + p1.y);
                    const f32x2 sa0v = {sa0, sa0}, sa1v = {sa1, sa1}, v0v = {v2.x, v2.x}, v1v = {v2.y, v2.y};
                    S0a = S0a * wa + sa0v * kaa + v0v * kka; S0b = S0b * wb + sa0v * kab + v0v * kkb;
                    S1a = S1a * wa + sa1v * kaa + v1v * kka; S1b = S1b * wb + sa1v * kab + v1v * kkb;
                    { f32x2 uv = {sa0, sa1}; *(LAS f32x2*)(ub + t * 32) = uv; }
                }
#undef RW_LD
                __builtin_amdgcn_s_setprio(0);
            }
        } else {
            if (blk + 1 < NBLK) RW_SPUT(blk + 1);
            if (blk + 2 < NBLK) RW_SLOAD(blk + 2);
            if (blk >= 1) {
                const int pb = blk - 1, tt = hid >> 1, rr = hid & 1, l15 = lane & 15, l4 = lane >> 4;
                const LAS float* s0 = S0 + (pb & 1) * (32 * 65); const LAS float* uu = UU + (pb & 1) * 1024; const LAS float* vv = VB + (pb % 3) * 1024;
                f32x4 acc = {0.f, 0.f, 0.f, 0.f}, acc1 = {0.f, 0.f, 0.f, 0.f};
                mm16x8(acc, acc1, RT + (16 * tt + l15) * 65 + l4, s0 + (16 * rr + l15) * 65 + l4, 4);
                mm16x8(acc, acc1, RT + (16 * tt + l15) * 65 + 32 + l4, s0 + (16 * rr + l15) * 65 + 32 + l4, 4);
                mm16x8(acc, acc1, NRB + (16 * tt + l15) * 33 + l4, uu + l4 * 32 + 16 * rr + l15, 128);
                mm16x8(acc, acc1, NRK + (16 * tt + l15) * 33 + l4, vv + l4 * 32 + 16 * rr + l15, 128);
                acc = acc + acc1;
                const unsigned yo = (unsigned)(b * SEQ + pb * TB + 16 * tt + 4 * l4) * 1024 + hd * 64 + 32 * half + 16 * rr + l15;
#pragma unroll
                for (int r = 0; r < 4; ++r) YC[yo + (unsigned)r * 1024] = f2bf(acc[r]);
            }
            helper_sync(hs, epoch, lane);
            if (blk < NBLK) {
                { const LAS float* cur = ob + (blk & 1) * BUF; const int k = 16 * hid + (lane & 15), sg = lane >> 4;
                  const LAS bf16* rb = RB + (blk & 1) * 2048 + k;
                  float wl[8], Wc = 1.0f;
#pragma unroll
                  for (int j = 0; j < 8; ++j) { Wc *= cur[(8 * sg + j) * OPS + 64 + k]; wl[j] = Wc; }
                  const float p1 = __shfl(Wc, (lane - 16) & 63), p2 = __shfl(Wc, (lane - 32) & 63), p3 = __shfl(Wc, (lane - 48) & 63);
                  const float pre = (sg >= 1 ? p1 : 1.0f) * (sg >= 2 ? p2 : 1.0f) * (sg >= 3 ? p3 : 1.0f);
#pragma unroll
                  for (int j = 0; j < 8; ++j) { const int t = 8 * sg + j; const float Wt = wl[j] * pre, inv = __builtin_amdgcn_rcpf(Wt);
                      RT[t * 65 + k] = Wt * bf2f(rb[t * 64]); BT[t * 65 + k] = cur[t * OPS + 128 + k] * inv; KT[t * 65 + k] = cur[t * OPS + 192 + k] * inv; } }
                helper_sync(hs, epoch, lane);
                { const int l15 = lane & 15, l4 = lane >> 4;
#pragma unroll 1
                  for (int q = hid; q < 6; q += 4) {
                      const int mk = q >= 3, qq = q - 3 * mk, tt = qq >= 1, ii = qq == 2;
                      const LAS float* src = mk ? KT : BT; LAS float* dst = mk ? NRK : NRB;
                      f32x4 acc = {0.f, 0.f, 0.f, 0.f}, acc1 = {0.f, 0.f, 0.f, 0.f};
                      mm16x8(acc, acc1, RT + (16 * tt + l15) * 65 + l4, src + (16 * ii + l15) * 65 + l4, 4);
                      mm16x8(acc, acc1, RT + (16 * tt + l15) * 65 + 32 + l4, src + (16 * ii + l15) * 65 + 32 + l4, 4);
                      acc = acc + acc1;
#pragma unroll
                      for (int r = 0; r < 4; ++r) { const int t = 16 * tt + 4 * l4 + r, i = 16 * ii + l15; dst[t * 33 + i] = (i <= t) ? acc[r] : 0.f; }
                      if (qq == 0) {
#pragma unroll
                          for (int r = 0; r < 4; ++r) dst[(4 * l4 + r) * 33 + 16 + l15] = 0.f; }
                  } }
            }
        }
        __syncthreads();
    }
#undef RW_SLOAD
#undef RW_SPUT
}
DI void rwkv_post_token(const Args& a, int l, int t, int lane) {
    const bf16* P = (const bf16*)(a.ws + WS_P);
    const bf16* RWr = (const bf16*)(a.ws + WS_RW); const bf16* RWk = RWr + (size_t)T * 1024; const bf16* RWv = RWk + (size_t)T * 1024; const bf16* RWa = RWr + (size_t)4 * T * 1024;
    bf16* YC = (bf16*)(a.ws + WS_YS) + (size_t)2 * T * 1024;
    const float* mu = a.in[8] + l * 4288 + 3264;
    const bool hp = (t & (SEQ - 1)) > 0;
    u32x2 wy[4], wr[4], wk[4], wv[4], wa[4], gc[4], gp[4];
#pragma unroll
    for (int c = 0; c < 4; ++c) { const int j = 256 * c + 4 * lane; const unsigned o = (unsigned)t * 1024 + j;
        wy[c] = *(const u32x2*)(YC + o); wr[c] = *(const u32x2*)(RWr + o); wk[c] = *(const u32x2*)(RWk + o); wv[c] = *(const u32x2*)(RWv + o); wa[c] = *(const u32x2*)(RWa + o);
        gc[c] = *(const u32x2*)(P + (unsigned)t * LDP + CG + j); u32x2 g0 = {0u, 0u}; if (hp) g0 = *(const u32x2*)(P + (unsigned)(t - 1) * LDP + CG + j); gp[c] = g0; }
#pragma unroll
    for (int c = 0; c < 4; ++c) {
        const int j = 256 * c + 4 * lane; const unsigned o = (unsigned)t * 1024 + j;
        const f32x4 ka4 = *(const f32x4*)(a.in[14] + l * 1024 + j); const f32x4 av = {bflo(wa[c].x), bfhi(wa[c].x), bflo(wa[c].y), bfhi(wa[c].y)};
        const f32x4 m4 = *(const f32x4*)(mu + j), rk4 = *(const f32x4*)(a.in[15] + l * 1024 + j), lg4 = *(const f32x4*)(a.in[16] + l * 1024 + j), lb4 = *(const f32x4*)(a.in[17] + l * 1024 + j);
        f32x4 y = {bflo(wy[c].x), bfhi(wy[c].x), bflo(wy[c].y), bfhi(wy[c].y)}, r = {bflo(wr[c].x), bfhi(wr[c].x), bflo(wr[c].y), bfhi(wr[c].y)}, kl = {bflo(wk[c].x), bfhi(wk[c].x), bflo(wk[c].y), bfhi(wk[c].y)}, v = {bflo(wv[c].x), bfhi(wv[c].x), bflo(wv[c].y), bfhi(wv[c].y)};
        const f32x4 k = kl * (1.0f + (av - 1.0f) * ka4);
        f32x4 g = {bflo(gc[c].x), bfhi(gc[c].x), bflo(gc[c].y), bfhi(gc[c].y)}; const f32x4 gq = {bflo(gp[c].x), bfhi(gp[c].x), bflo(gp[c].y), bfhi(gp[c].y)};
        g = g + (gq - g) * m4;
        const float mean = row16_sum((y.x + y.y) + (y.z + y.w)) * (1.0f / 64.0f); const f32x4 d = y - mean;
        const float var = row16_sum((d.x * d.x + d.y * d.y) + (d.z * d.z + d.w * d.w)) * (1.0f / 64.0f); const float rstd = 1.0f / sqrtf(var + 64e-5f);
        const float bs = row16_sum((r.x * k.x * rk4.x + r.y * k.y * rk4.y) + (r.z * k.z * rk4.z + r.w * k.w * rk4.w));
        const f32x4 ov = d * rstd * lg4 + lb4 + bs * v;
        u32x2 w; w.x = pk2(ov.x * siluf_(g.x), ov.y * siluf_(g.y)); w.y = pk2(ov.z * siluf_(g.z), ov.w * siluf_(g.w));
        *(u32x2*)(YC + o) = w;
    }
}

DI void sgu_unit(const Args& a, int l, int unit, LAS unsigned char* lds, int tid, int lane, int wave) {
    const bf16* P = (const bf16*)(a.ws + WS_P); bf16* YD = (bf16*)(a.ws + WS_YS) + (size_t)3 * T * 1024;
    const bf16* wsb = (const bf16*)(a.ws + WS_WSB) + (size_t)l * 8 * 128 * 128;
    const int g = unit & 7, ch = (unit >> 3) & 31, b = unit >> 8;
    const int t0 = b * SEQ + ch * 128, r32 = lane & 31, hh = lane >> 5;
    LAS bf16* vt = (LAS bf16*)lds;
#pragma unroll
    for (int r = 0; r < 4; ++r) { const int cidx = tid + 512 * r, j = cidx >> 4, c = cidx & 15;
        *(LAS u32x4*)(vt + j * 136 + 8 * c) = *(const u32x4*)(P + (unsigned)(t0 + j) * LDP + DV + g * 128 + 8 * c); }
    __syncthreads();
    const int it = wave >> 1, dt0 = (wave & 1) * 2;
    f32x16 acc[2];
#pragma unroll
    for (int x = 0; x < 2; ++x)
#pragma unroll
        for (int r = 0; r < 16; ++r) acc[x][r] = 0.f;
#pragma unroll
    for (int st = 0; st < 8; ++st) {
        const bf16x8 A = *(const bf16x8*)(wsb + ((unsigned)g * 128 + 32 * it + r32) * 128 + 16 * st + 8 * hh);
#pragma unroll
        for (int x = 0; x < 2; ++x) { const int d = 32 * (dt0 + x) + r32; u32x4 w;
#pragma unroll
            for (int e = 0; e < 4; ++e) { const int j = 16 * st + 8 * hh + 2 * e; w[e] = (unsigned)vt[j * 136 + d] | ((unsigned)vt[(j + 1) * 136 + d] << 16); }
            acc[x] = MFMA32(A, __builtin_bit_cast(bf16x8, w), acc[x]); }
    }
    const float* bs = a.in[21] + (size_t)l * 8 * 128 + g * 128;
    unsigned short uu[2][16], gg[2][16]; f32x4 bsv[4];
#pragma unroll
    for (int g4 = 0; g4 < 4; ++g4) bsv[g4] = *(const f32x4*)(bs + 32 * it + 8 * g4 + 4 * hh);
#pragma unroll
    for (int x = 0; x < 2; ++x)
#pragma unroll
        for (int r = 0; r < 16; ++r) { const int t = t0 + 32 * it + crow(r, hh), col = g * 128 + 32 * (dt0 + x) + r32;
            uu[x][r] = P[(unsigned)t * LDP + DU + col]; gg[x][r] = P[(unsigned)t * LDP + DG + col]; }
#pragma unroll
    for (int x = 0; x < 2; ++x)
#pragma unroll
        for (int r = 0; r < 16; ++r) { const int t = t0 + 32 * it + crow(r, hh), col = g * 128 + 32 * (dt0 + x) + r32;
            const float sv = acc[x][r] + bsv[r >> 2][r & 3];
            YD[(unsigned)t * 1024 + col] = f2bf(bf2f(uu[x][r]) * sv * siluf_(bf2f(gg[x][r]))); }
    __syncthreads();
}

DI unsigned f2key(float f) { const unsigned u = __float_as_uint(f); return (u & 0x80000000u) ? ~u : (u | 0x80000000u); }
DI unsigned wave_sum_u32(unsigned x) {
    x += (unsigned)__builtin_amdgcn_update_dpp(0, (int)x, 0x128, 0xf, 0xf, false); x += (unsigned)__builtin_amdgcn_update_dpp(0, (int)x, 0x124, 0xf, 0xf, false);
    x += (unsigned)__builtin_amdgcn_update_dpp(0, (int)x, 0x122, 0xf, 0xf, false); x += (unsigned)__builtin_amdgcn_update_dpp(0, (int)x, 0x121, 0xf, 0xf, false);
    return (unsigned)__builtin_amdgcn_readlane((int)x, 0) + (unsigned)__builtin_amdgcn_readlane((int)x, 16) + (unsigned)__builtin_amdgcn_readlane((int)x, 32) + (unsigned)__builtin_amdgcn_readlane((int)x, 48);
}
DI void dsa_index_unit(const Args& a, int unit, LAS unsigned char* lds, int tid, int lane, int wave) {
    const bf16* P = (const bf16*)(a.ws + WS_P); const float* SM = (const float*)(a.ws + WS_SM);
    const int b = unit >> 6, jq = 63 - (unit & 63);
    const int nch = jq + 1, nk = 64 * nch, ntile = 2 * nch, tq0 = b * SEQ + jq * 64;
    float* SCu = (float*)(a.ws + WS_SC) + (size_t)b * (4096 * 2080) + (unsigned)(jq * (jq + 1) / 2) * 4096;
    unsigned long long* BM = (unsigned long long*)(a.ws + WS_BM);
    const int r32 = lane & 31, hh = lane >> 5;
    LAS bf16* iql = (LAS bf16*)lds;
#pragma unroll
    for (int r = 0; r < 8; ++r) { const int cidx = tid + 512 * r, q = cidx >> 6, c = cidx & 63;
        *(LAS u32x4*)(iql + q * 520 + 8 * c) = *(const u32x4*)(P + (unsigned)(tq0 + q) * LDP + BIQ + 8 * c); }
    __syncthreads();
#pragma unroll 1
    for (int kt = wave; kt < ntile; kt += 8) {
        const int ts = b * SEQ + 32 * kt + r32;
        bf16x8 Ak[4];
#pragma unroll
        for (int st = 0; st < 4; ++st) { const float* p = SM + (unsigned)ts * 512 + IK + 16 * st + 8 * hh; Ak[st] = pack8f(*(const f32x4*)p, *(const f32x4*)(p + 4)); }
#pragma unroll 1
        for (int qh = 0; qh < 2; ++qh) {
            const int tq = tq0 + 32 * qh + r32;
            const f32x4 w0 = *(const f32x4*)(SM + (unsigned)tq * 512 + IW), w1 = *(const f32x4*)(SM + (unsigned)tq * 512 + IW + 4);
            f32x16 sc;
#pragma unroll
            for (int r = 0; r < 16; ++r) sc[r] = 0.f;
#pragma unroll
            for (int h8 = 0; h8 < 8; ++h8) { f32x16 acc;
#pragma unroll
                for (int r = 0; r < 16; ++r) acc[r] = 0.f;
#pragma unroll
                for (int st = 0; st < 4; ++st) { const bf16x8 Bq = *(const LAS bf16x8*)(iql + (32 * qh + r32) * 520 + h8 * 64 + 16 * st + 8 * hh); acc = MFMA32(Ak[st], Bq, acc); }
                const float wq = (h8 < 4 ? w0[h8 & 3] : w1[h8 & 3]) * 0.044194173824159216f;
#pragma unroll
                for (int r = 0; r < 16; ++r) sc[r] += wq * fmaxf(acc[r], 0.f); }
#pragma unroll
            for (int g4 = 0; g4 < 4; ++g4) { f32x4 o; o.x = sc[4 * g4]; o.y = sc[4 * g4 + 1]; o.z = sc[4 * g4 + 2]; o.w = sc[4 * g4 + 3];
                *(f32x4*)(SCu + (unsigned)(32 * qh + r32) * nk + 32 * kt + 8 * g4 + 4 * hh) = o; }
        }
    }
    __syncthreads();
    LAS unsigned* keys = (LAS unsigned*)(lds + wave * 16384);
#pragma unroll 1
    for (int qi = wave; qi < 64; qi += 8) {
        const float* row = SCu + (unsigned)qi * nk;
        unsigned long long myword = 0ull;
        if (nch <= 4) { myword = ~0ull; }
        else {
            unsigned key[64];
#pragma unroll
            for (int i = 0; i < 64; ++i) key[i] = __float_as_uint(row[(i < nch ? 64 * i : 0) + lane]);
            asm volatile("" ::: "memory");
#pragma unroll
            for (int i = 0; i < 64; ++i) key[i] = i < nch ? f2key(__uint_as_float(key[i])) : 0u;
            unsigned tau = 0u; int cnt_ge = 0;
#pragma unroll 1
            for (int bit = 31; bit >= 0; --bit) {
                const unsigned cand = tau | (1u << bit); unsigned cl = 0u;
#define CNT8(i0) asm volatile("v_cmp_ge_u32_e64 s[80:81], %1, %9\n\tv_cmp_ge_u32_e64 s[82:83], %2, %9\n\tv_cmp_ge_u32_e64 s[84:85], %3, %9\n\tv_cmp_ge_u32_e64 s[86:87], %4, %9\n\t" \
                     "v_cmp_ge_u32_e64 s[88:89], %5, %9\n\tv_cmp_ge_u32_e64 s[90:91], %6, %9\n\tv_cmp_ge_u32_e64 s[92:93], %7, %9\n\tv_cmp_ge_u32_e64 s[94:95], %8, %9\n\t" \
                     "v_addc_co_u32_e64 %0, s[96:97], 0, %0, s[80:81]\n\tv_addc_co_u32_e64 %0, s[96:97], 0, %0, s[82:83]\n\tv_addc_co_u32_e64 %0, s[96:97], 0, %0, s[84:85]\n\tv_addc_co_u32_e64 %0, s[96:97], 0, %0, s[86:87]\n\t" \
                     "v_addc_co_u32_e64 %0, s[96:97], 0, %0, s[88:89]\n\tv_addc_co_u32_e64 %0, s[96:97], 0, %0, s[90:91]\n\tv_addc_co_u32_e64 %0, s[96:97], 0, %0, s[92:93]\n\tv_addc_co_u32_e64 %0, s[96:97], 0, %0, s[94:95]" \
                     : "+v"(cl) : "v"(key[i0]), "v"(key[i0 + 1]), "v"(key[i0 + 2]), "v"(key[i0 + 3]), "v"(key[i0 + 4]), "v"(key[i0 + 5]), "v"(key[i0 + 6]), "v"(key[i0 + 7]), "v"(cand) \
                     : "s80", "s81", "s82", "s83", "s84", "s85", "s86", "s87", "s88", "s89", "s90", "s91", "s92", "s93", "s94", "s95", "s96", "s97")
                CNT8(0);
                if (nch > 8) { CNT8(8); }
                if (nch > 16) { CNT8(16); CNT8(24); }
                if (nch > 32) { CNT8(32); CNT8(40); }
                if (nch > 48) { CNT8(48); CNT8(56); }
#undef CNT8
                const int c = (int)wave_sum_u32(cl);
                if (c >= 256) { tau = cand; cnt_ge = c; if (c == 256) break; }
            }
            if (cnt_ge == 256) {
#pragma unroll
                for (int i = 0; i < 64; ++i) { const unsigned long long m = __ballot(key[i] >= tau); myword = (lane == i) ? m : myword; }
            } else {
#pragma unroll
                for (int i = 0; i < 64; ++i) keys[i * 64 + lane] = key[i];
                int n_gt = 0;
#pragma unroll 1
                for (int i = 0; i < nch; ++i) n_gt += __builtin_popcountll(__ballot(keys[i * 64 + lane] > tau));
                int quota = 256 - n_gt;
#pragma unroll 1
                for (int i = 0; i < nch; ++i) { const unsigned kv = keys[i * 64 + lane]; const unsigned long long m_gt = __ballot(kv > tau); unsigned long long m_eq = __ballot(kv == tau), take = 0ull;
                    const int ne = __builtin_popcountll(m_eq);
                    if (ne <= quota) { take = m_eq; quota -= ne; } else { while (quota > 0) { const unsigned long long low = m_eq & (0ull - m_eq); take |= low; m_eq ^= low; --quota; } }
                    myword = (lane == i) ? (m_gt | take) : myword; }
            }
        }
        if (lane < nch) BM[(unsigned)(tq0 + qi) * 64 + lane] = myword;
    }
    __syncthreads();
}

DI void dsa_attn_unit(const Args& a, int unit, LAS unsigned char* lds, int tid, int lane, int wave) {
    const bf16* P = (const bf16*)(a.ws + WS_P); const bf16* VT = (const bf16*)(a.ws + WS_VT); const unsigned* BM32 = (const unsigned*)(a.ws + WS_BM);
    bf16* YB = (bf16*)(a.ws + WS_YS) + (size_t)T * 1024;
    const int qg = 15 - (unit >> 5), bh = unit & 31, b = bh >> 3, hd = bh & 7;
    const int q0 = 256 * qg + 32 * wave, cw = 4 * qg + (wave >> 1), nkt = 4 * qg + 4;
    const int r32 = lane & 31, hh = lane >> 5;
    const int tq = b * SEQ + q0 + r32;
    LAS bf16* kbuf = (LAS bf16*)lds;
    LAS bf16* vbuf = kbuf + 2 * 64 * 136;
    const int krow = tid >> 3, kseg = (tid & 7) * 16, vrow = tid >> 2, vseg = (tid & 3) * 16;
    const bf16* ksrc = P + (unsigned)(b * SEQ + krow) * LDP + BK_ + hd * 128 + kseg;
    const bf16* vsrc = VT + (unsigned)((b * 8 + hd) * 128 + vrow) * SEQ + vseg;
    u32x4 kn[2], vn[2];
    kn[0] = *(const u32x4*)ksrc; kn[1] = *(const u32x4*)(ksrc + 8); vn[0] = *(const u32x4*)vsrc; vn[1] = *(const u32x4*)(vsrc + 8);
    bf16x8 Bq[8];
#pragma unroll
    for (int st = 0; st < 8; ++st) Bq[st] = *(const bf16x8*)(P + (unsigned)tq * LDP + BQ + hd * 128 + 16 * st + 8 * hh);
    f32x16 O[4];
#pragma unroll
    for (int dt = 0; dt < 4; ++dt)
#pragma unroll
        for (int r = 0; r < 16; ++r) O[dt][r] = 0.f;
    float m = -1e30f, lsum = 0.f;
    const float sc2 = 0.08838834764831845f * 1.4426950408889634f;
#define ATT_PUT(buf_) do { LAS bf16* kd_ = kbuf + (buf_) * (64 * 136) + krow * 136 + kseg; *(LAS u32x4*)kd_ = kn[0]; *(LAS u32x4*)(kd_ + 8) = kn[1]; \
        LAS u32x2* vd_ = (LAS u32x2*)(vbuf + (buf_) * (128 * 68) + vrow * 68 + vseg); u32x2 t_; t_.x = vn[0].x; t_.y = vn[0].y; vd_[0] = t_; t_.x = vn[0].z; t_.y = vn[0].w; vd_[1] = t_; \
        t_.x = vn[1].x; t_.y = vn[1].y; vd_[2] = t_; t_.x = vn[1].z; t_.y = vn[1].w; vd_[3] = t_; } while (0)
    ATT_PUT(0);
    __syncthreads();
#pragma unroll 1
    for (int kt = 0; kt < nkt; ++kt) {
        { const int kn_i = kt + 1 < nkt ? kt + 1 : kt;
          const bf16* kp = ksrc + (unsigned)(kn_i * 64) * LDP; kn[0] = *(const u32x4*)kp; kn[1] = *(const u32x4*)(kp + 8);
          const bf16* vp = vsrc + kn_i * 64; vn[0] = *(const u32x4*)vp; vn[1] = *(const u32x4*)(vp + 8); }
        if (kt <= cw) {
            const LAS bf16* kb = kbuf + (kt & 1) * (64 * 136); const LAS bf16* vb = vbuf + (kt & 1) * (128 * 68);
            f32x16 s[2];
#pragma unroll
            for (int th = 0; th < 2; ++th) {
#pragma unroll
                for (int r = 0; r < 16; ++r) s[th][r] = 0.f;
#pragma unroll
                for (int st = 0; st < 8; ++st) { const bf16x8 A = *(const LAS bf16x8*)(kb + (32 * th + r32) * 136 + 16 * st + 8 * hh); s[th] = MFMA32(A, Bq[st], s[th]); }
            }
            const u32x2 mw = *(const u32x2*)(BM32 + (unsigned)tq * 128 + 2 * kt);
            const unsigned mlo = mw.x >> (4 * hh), mhi = mw.y >> (4 * hh);
            float tmax = -1e30f;
#pragma unroll
            for (int th = 0; th < 2; ++th)
#pragma unroll
                for (int r = 0; r < 16; ++r) tmax = fmaxf(tmax, s[th][r]);
            tmax = fmaxf(tmax, __shfl_xor(tmax, 32)) * sc2;
            const float mn = fmaxf(m, tmax);
            if (__any(mn != m)) {
                const float alpha = __builtin_amdgcn_exp2f(m - mn); lsum *= alpha;
#pragma unroll
                for (int dt = 0; dt < 4; ++dt)
#pragma unroll
                    for (int r = 0; r < 16; ++r) O[dt][r] *= alpha;
            }
            m = mn;
            float ps = 0.f;
#pragma unroll
            for (int th = 0; th < 2; ++th)
#pragma unroll
                for (int r = 0; r < 16; ++r) { const float p = __builtin_amdgcn_exp2f(s[th][r] * sc2 - mn);
                    const int sel = __builtin_amdgcn_sbfe((int)(th ? mhi : mlo), (r & 3) + 8 * (r >> 2), 1);
                    const float pm = __uint_as_float(__float_as_uint(p) & (unsigned)sel); s[th][r] = pm; ps += pm; }
            lsum += ps;
#pragma unroll
            for (int th = 0; th < 2; ++th)
#pragma unroll
                for (int ss = 0; ss < 2; ++ss) { const bf16x8 Bp = pack_step(s[th], ss);
#pragma unroll
                    for (int dt = 0; dt < 4; ++dt) { const LAS bf16* vp = vb + (32 * dt + r32) * 68 + 32 * th + 16 * ss + 4 * hh;
                        const bf16x8 A = join8(*(const LAS u32x2*)vp, *(const LAS u32x2*)(vp + 8)); O[dt] = MFMA32(A, Bp, O[dt]); } }
        }
        ATT_PUT((kt + 1) & 1);
        __syncthreads();
    }
#undef ATT_PUT
    lsum += __shfl_xor(lsum, 32);
    const float inv = 1.0f / lsum;
    u32x2 gwv[4][4];
#pragma unroll
    for (int dt = 0; dt < 4; ++dt)
#pragma unroll
        for (int g4 = 0; g4 < 4; ++g4) gwv[dt][g4] = *(const u32x2*)(P + (unsigned)tq * LDP + BG + hd * 128 + 32 * dt + 8 * g4 + 4 * hh);
#pragma unroll
    for (int dt = 0; dt < 4; ++dt)
#pragma unroll
        for (int g4 = 0; g4 < 4; ++g4) { const int col = hd * 128 + 32 * dt + 8 * g4 + 4 * hh; const u32x2 gw = gwv[dt][g4];
            u32x2 w; w.x = pk2(O[dt][4 * g4] * inv * siluf_(bflo(gw.x)), O[dt][4 * g4 + 1] * inv * siluf_(bfhi(gw.x))); w.y = pk2(O[dt][4 * g4 + 2] * inv * siluf_(bflo(gw.y)), O[dt][4 * g4 + 3] * inv * siluf_(bfhi(gw.y)));
            *(u32x2*)(YB + (unsigned)tq * 1024 + col) = w; }
}

DI int queue_next(unsigned* head, volatile LAS unsigned* slot, int tid) {
    __syncthreads();
    if (tid == 0) *slot = __hip_atomic_fetch_add(head, 1u, __ATOMIC_RELAXED, __HIP_MEMORY_SCOPE_AGENT);
    __syncthreads();
    return (int)*slot;
}

template <unsigned PMASK> DI void fwd_body(const Args& a) {
    extern __shared__ __attribute__((aligned(16))) unsigned char lds_raw[];
    LAS unsigned char* lds = (LAS unsigned char*)lds_raw;
    volatile LAS unsigned* MISC = (volatile LAS unsigned*)(lds + MISC_OFF);
    const int tid = threadIdx.x, lane = tid & 63, wave = __builtin_amdgcn_readfirstlane(tid >> 6), bid = blockIdx.x, G = gridDim.x;
    unsigned* ctl = (unsigned*)(a.ws + WS_CTL);
    if (tid < 64) MISC[tid] = 0u;
    __syncthreads();
    const bool one_launch = (a.ph_hi - a.ph_lo) > 1;
    XcdBarrier bar; bar.bar = ctl + CW_BAR; bar.x = 0; bar.st = nullptr;
    if (one_launch) bar = xcd_barrier_post(ctl + CW_BAR, MISC + 8);
    const int lo = a.ph_lo, hi = a.ph_hi;
#define IN0 ((PMASK & 1u) && lo <= 0 && 0 < hi)
#define INL(j) (((PMASK >> ((j) + 1)) & 1u) && lo <= pb + (j) && pb + (j) < hi)
#ifndef REPB
#define REPB 1
#endif
#define SEAM(k) do { if (lo <= (k) && (k) + 1 < hi) for (int rb_ = 0; rb_ < REPB; ++rb_) xcd_barrier(bar); } while (0)
    const int NGW = G * 8;
#ifndef REPG
#define REPG 1
#endif
#ifndef REPG1
#define REPG1 REPG
#endif
#ifndef GP_ALIGN
#define GP_ALIGN true
#endif
#ifndef GP_SP2
#define GP_SP2 true
#endif
#ifndef REPT
#define REPT 1
#endif
#ifndef REPP
#define REPP 1
#endif
#define FRESH int tid_ = threadIdx.x; asm volatile("" : "+v"(tid_)); const int lane_ = tid_ & 63, wave_ = __builtin_amdgcn_readfirstlane(tid_ >> 6), gw_ = bid * 8 + wave_; (void)lane_; (void)gw_;

#ifndef REPP_SEL
#define REPP_SEL 15
#endif
    if (IN0) { for (int rp_ = 0; rp_ < REPP; ++rp_) { { FRESH phase_prologue(a, lds, tid_, lane_, wave_, bid, G, rp_ == 0 ? 15 : REPP_SEL); } if (rp_ + 1 < REPP) xcd_barrier(bar); }
               { FRESH phase_prenorm(a.in[0], a.in[2], (bf16*)(a.ws + WS_H), gw_, NGW, lane_); }
               SEAM(0); }

#pragma unroll 1
    for (int l = 0; l < 2; ++l) {
        const int pb = 1 + 10 * l;
        const float* xin = l == 0 ? a.in[0] : a.out;
        if (INL(1)) {
            pg8::Gemm g{(const pg8::bf16_t*)(a.ws + WS_H), (const pg8::bf16_t*)(a.ws + WS_WT1) + (size_t)l * N1 * DM, T, N1, DM, 0, 0};
            pg8::StaticOrder S; S.init(T, N1, G, bid);
            Epi<0> E{a.ws + WS_P, (float*)(a.ws + WS_SM), (const float*)(a.ws + WS_ROPE)};
            for (int rg_ = 0; rg_ < REPG1; ++rg_) { pg8::gemm_phase2<Epi<0>, pg8::StaticOrder, GP_ALIGN, GP_SP2>(lds, g, S, E); if (rg_ + 1 < REPG1) xcd_barrier(bar); }
            SEAM(pb + 1);
        }
        if (INL(2)) {
            { FRESH bf16* Pp = (bf16*)(a.ws + WS_P); float* SMp = (float*)(a.ws + WS_SM);
              for (int t = gw_; t < T; t += NGW) { SguL Ls; RwkvL Lw;
                  sgu_load(Ls, Pp, t, lane_); rwkvp_load(Lw, Pp, t, lane_);
                  rwkvp_finish(Lw, a, l, t, lane_); sgu_finish(Ls, Pp, a.in[18] + l * BW, a.in[19] + l * BW, t, lane_); } }
#ifdef REPW
            for (int rw_ = 0; rw_ < REPW; ++rw_) {
              FRESH bf16* Pp = (bf16*)(a.ws + WS_P); float* SMp = (float*)(a.ws + WS_SM); bf16* Pd = (bf16*)(a.ws + WS_YS); float* SMd = (float*)(a.ws + WS_BM); Args a2 = a; a2.ws = a.ws + (WS_SC - WS_RW);
              for (int t = gw_; t < T; t += NGW) { SguL Ls; RwkvL Lw; const int td = t & 4095;
                  sgu_load(Ls, Pp, t, lane_); rwkvp_load(Lw, Pp, t, lane_);
                  rwkvp_finish(Lw, a2, l, td, lane_); sgu_finish(Ls, Pd, a.in[18] + l * BW, a.in[19] + l * BW, td, lane_); } }
#endif
            { FRESH for (int u = bid; u < T / 32; u += G) prep_lowrank_unit(a, l, u, lds, tid_, lane_, wave_); }
            for (int rt_ = 0; rt_ < REPT; ++rt_) {
#ifndef REPT_SEL
#define REPT_SEL 3
#endif
            if (rt_ == 0 || (REPT_SEL & 1)) { FRESH for (int u = bid; u < 2048; u += G) vt_unit(a, u, lds, tid_); }
            if (rt_ == 0 || (REPT_SEL & 2)) { FRESH for (int u = bid; u < 1024; u += G) gla_kv_unit(a, l, u, lds, tid_, lane_, wave_); }
            if (rt_ + 1 < REPT) xcd_barrier(bar); }
            SEAM(pb + 2);
        }
        if (INL(3)) {
#ifndef REP3
#define REP3 1
#endif
#pragma unroll 1
          for (int rep = 0; rep < REP3; ++rep) {
            if (PMASK & (1u << 11)) { FRESH unsigned* head = ctl + CW_Q + 64 * (8 * l + 0 + 16 * rep); for (;;) { const int u = queue_next(head, MISC + 4, tid_); if (u >= 128) break; rwkv_unit(a, l, u, lds, tid_, lane_, wave_); } }
            if (PMASK & (1u << 12)) { FRESH unsigned* head = ctl + CW_Q + 64 * (8 * l + 1 + 16 * rep); for (;;) { const int u = queue_next(head, MISC + 4, tid_); if (u >= 16) break; gla_scan_unit(a, l, u, lds, tid_, lane_, wave_); } }
            if (PMASK & (1u << 13)) { FRESH unsigned* head = ctl + CW_Q + 64 * (8 * l + 2 + 16 * rep); for (;;) { const int u = queue_next(head, MISC + 4, tid_); if (u >= 256) break; dsa_index_unit(a, u, lds, tid_, lane_, wave_); } }
            if (PMASK & (1u << 14)) { FRESH unsigned* head = ctl + CW_Q + 64 * (8 * l + 3 + 16 * rep); for (;;) { const int u = queue_next(head, MISC + 4, tid_); if (u >= 1024) break; sgu_unit(a, l, u, lds, tid_, lane_, wave_); } }
            if (rep + 1 < REP3) xcd_barrier(bar);
          }
            SEAM(pb + 3);
#ifdef EXTRA
            {
                FRESH unsigned* head = ctl + CW_Q + 64 * (8 * l + 48 + EXTRA);
                if (EXTRA == 0) for (;;) { const int u = queue_next(head, MISC + 4, tid_); if (u >= 128) break; rwkv_unit(a, l, u, lds, tid_, lane_, wave_); }
                if (EXTRA == 1) for (;;) { const int u = queue_next(head, MISC + 4, tid_); if (u >= 16) break; gla_scan_unit(a, l, u, lds, tid_, lane_, wave_); }
                if (EXTRA == 2) for (;;) { const int u = queue_next(head, MISC + 4, tid_); if (u >= 256) break; dsa_index_unit(a, u, lds, tid_, lane_, wave_); }
                if (EXTRA == 3) for (;;) { const int u = queue_next(head, MISC + 4, tid_); if (u >= 1024) break; sgu_unit(a, l, u, lds, tid_, lane_, wave_); }
                xcd_barrier(bar);
            }
#endif
        }
        if (INL(4)) {
#ifndef REP4
#define REP4 1
#endif
#pragma unroll 1
          for (int rep = 0; rep < REP4; ++rep) {
            unsigned* head = ctl + CW_Q + 64 * (8 * l + 4 + 16 * rep);
            FRESH for (;;) { const int u = queue_next(head, MISC + 4, tid_); if (u >= 512) break; dsa_attn_unit(a, u, lds, tid_, lane_, wave_); }
            if (rep + 1 < REP4) xcd_barrier(bar);
          }
            { FRESH for (int t = gw_; t < T; t += NGW) { rwkv_post_token(a, l, t, lane_); } }
            SEAM(pb + 4);
        }
        if (INL(5)) {
            pg8::Gemm g{(const pg8::bf16_t*)(a.ws + WS_YS), (const pg8::bf16_t*)(a.ws + WS_WTP) + ((size_t)l << 23), T, 4 * DM, BW, 8, (size_t)T * BW * 2};
            pg8::StaticOrder S; S.init(T, 4 * DM, G, bid);
            Epi<1> E{a.ws + WS_P, nullptr};
            for (int rg_ = 0; rg_ < REPG; ++rg_) { pg8::gemm_phase2<Epi<1>, pg8::StaticOrder, GP_ALIGN, GP_SP2>(lds, g, S, E); if (rg_ + 1 < REPG) xcd_barrier(bar); }
            SEAM(pb + 5);
        }
        if (INL(6)) {
            pg8::Gemm g{(const pg8::bf16_t*)(a.ws + WS_H), (const pg8::bf16_t*)(a.ws + WS_WTM) + (size_t)l * NM * DM, T, NM, DM, 0, 0};
            pg8::StaticOrder S; S.init(T, NM, G, bid);
            Epi<2> E{a.ws + WS_RW, (float*)(a.ws + WS_P)};
            for (int rg_ = 0; rg_ < REPG; ++rg_) { pg8::gemm_phase2<Epi<2>, pg8::StaticOrder, GP_ALIGN, GP_SP2>(lds, g, S, E); if (rg_ + 1 < REPG) xcd_barrier(bar); }
            SEAM(pb + 6);
        }
        if (INL(8)) {
            pg8::Gemm g{(const pg8::bf16_t*)(a.ws + WS_RW), (const pg8::bf16_t*)(a.ws + WS_WTO) + ((size_t)l << 22), T, DM, DM, 0, 0};
            pg8::StaticOrder S; S.init(T, DM, G, bid);
            Epi<3> E{a.ws + WS_SC, nullptr};
            for (int rg_ = 0; rg_ < REPG; ++rg_) { pg8::gemm_phase2<Epi<3>, pg8::StaticOrder, GP_ALIGN, GP_SP2>(lds, g, S, E); if (rg_ + 1 < REPG) xcd_barrier(bar); }
            SEAM(pb + 8);
        }
        if (INL(9)) { FRESH phase_postnorm(xin, (const float*)(a.ws + WS_SC), a.in[3] + l * DM, a.out, a.in[2] + DM, l == 0 ? (bf16*)(a.ws + WS_H) : (bf16*)nullptr, gw_, NGW, lane_); SEAM(pb + 9); }
    }
#undef IN0
#undef INL
#undef SEAM
}

#if defined(ONE_LAUNCH) || defined(ANALYZE)
__global__ void __launch_bounds__(512, 2) fwd(Args a) { fwd_body<0x7fffu>(a); }
#endif
#if !defined(ONE_LAUNCH)
__global__ void __launch_bounds__(512, 2) fwd_p0(Args a) { fwd_body<1u << 0>(a); }
__global__ void __launch_bounds__(512, 2) fwd_p1(Args a) { fwd_body<1u << 1>(a); }
__global__ void __launch_bounds__(512, 2) fwd_p2(Args a) { fwd_body<1u << 2>(a); }
__global__ void __launch_bounds__(512, 2) fwd_p3(Args a) { fwd_body<1u << 3>(a); }
__global__ void __launch_bounds__(512, 2) fwd_p4a(Args a) { fwd_body<(1u << 4) | (1u << 11)>(a); }
__global__ void __launch_bounds__(512, 2) fwd_p4b(Args a) { fwd_body<(1u << 4) | (1u << 12)>(a); }
__global__ void __launch_bounds__(512, 2) fwd_p4c(Args a) { fwd_body<(1u << 4) | (1u << 13)>(a); }
__global__ void __launch_bounds__(512, 2) fwd_p4d(Args a) { fwd_body<(1u << 4) | (1u << 14)>(a); }
__global__ void __launch_bounds__(512, 2) fwd_p5(Args a) { fwd_body<1u << 5>(a); }
__global__ void __launch_bounds__(512, 2) fwd_p6(Args a) { fwd_body<1u << 6>(a); }
__global__ void __launch_bounds__(512, 2) fwd_p7(Args a) { fwd_body<1u << 7>(a); }
__global__ void __launch_bounds__(512, 2) fwd_p8(Args a) { fwd_body<1u << 8>(a); }
__global__ void __launch_bounds__(512, 2) fwd_p9(Args a) { fwd_body<1u << 9>(a); }
__global__ void __launch_bounds__(512, 2) fwd_p10(Args a) { fwd_body<1u << 10>(a); }
#endif
#ifdef COMBO
#include "combo.inc"
#endif
typedef void (*kern_t)(Args);
extern "C" void kernel_launch(void* const* d_in, const int* in_sizes, int n_in, void* d_out, int out_size, void* d_ws, size_t ws_size, hipStream_t stream) {
    static int grid = 0;
#if defined(ONE_LAUNCH)
    static const kern_t kerns[1] = {fwd};
    constexpr int NK = 1;
#else
    static const kern_t kerns[14] = {fwd_p0, fwd_p1, fwd_p2, fwd_p3, fwd_p4a, fwd_p4b, fwd_p4c, fwd_p4d, fwd_p5, fwd_p6, fwd_p7, fwd_p8, fwd_p9, fwd_p10};
    constexpr int NK = 14;
#endif
    if (grid == 0) {
        if (n_in != 24 || out_size != T * DM || ws_size < WS_END) { fprintf(stderr, "kernel_launch: unexpected shapes (n_in %d out %d ws %zu, need %zu)\n", n_in, out_size, ws_size, (size_t)WS_END); grid = -1; return; }
        int dev = 0, cus = 0, per_cu = 0;
        if (hipGetDevice(&dev) != hipSuccess || hipDeviceGetAttribute(&cus, hipDeviceAttributeMultiprocessorCount, dev) != hipSuccess) { grid = -1; return; }
        for (int k = 0; k < NK; ++k)
            if (hipFuncSetAttribute((const void*)kerns[k], hipFuncAttributeMaxDynamicSharedMemorySize, LDS_BYTES) != hipSuccess) { fprintf(stderr, "kernel_launch: hipFuncSetAttribute failed\n"); grid = -1; return; }
        if (hipOccupancyMaxActiveBlocksPerMultiprocessor(&per_cu, (const void*)kerns[0], 512, LDS_BYTES) != hipSuccess || per_cu < 1) { fprintf(stderr, "kernel_launch: occupancy query says %d\n", per_cu); }
        (void)hipGetLastError();
        grid = cus;
    }
    if (grid < 0) return;
    (void)hipMemsetAsync((char*)d_ws + WS_CTL, 0, CTL_BYTES, stream);
    Args a{};
    for (int i = 0; i < 24; ++i) a.in[i] = (const float*)d_in[i];
    a.pos = (const int*)d_in[1]; a.out = (float*)d_out; a.ws = (unsigned char*)d_ws;
#if defined(ONE_LAUNCH)
    a.ph_lo = 0; a.ph_hi = NPHASE; hipLaunchKernelGGL(fwd, dim3(grid), dim3(512), LDS_BYTES, stream, a);
#else
    a.ph_lo = 0; a.ph_hi = 1; hipLaunchKernelGGL(fwd_p0, dim3(grid), dim3(512), LDS_BYTES, stream, a);
    for (int l = 0; l < 2; ++l) {
        static const int phase_of[13] = {0, 1, 2, 3, 3, 3, 3, 4, 5, 6, 7, 8, 9};
        for (int k = 0; k < 13; ++k) { a.ph_lo = 1 + 10 * l + phase_of[k]; a.ph_hi = a.ph_lo + 1; hipLaunchKernelGGL(kerns[1 + k], dim3(grid), dim3(512), LDS_BYTES, stream, a); }
    }
#endif
}
```

```cpp
#include <hip/hip_runtime.h>
#include <cstdio>
#include <cstdint>
#define ONE_LAUNCH 1


#ifndef PG8_WGM
#define PG8_WGM 8
#endif
namespace pg8 {
#define PG8_LAS __attribute__((address_space(3)))
typedef unsigned short bf16_t;
typedef short bf16x8 __attribute__((ext_vector_type(8)));
typedef float f32x4 __attribute__((ext_vector_type(4)));
typedef unsigned u32x4 __attribute__((ext_vector_type(4)));
constexpr int BM = 256, BK = 64, HALF = 128, HTB = HALF * BK * 2  , STAGE_BYTES = 8 * HTB, NXCD = 8, WGM = PG8_WGM;

__host__ __device__ __forceinline__ int lds_byte(int r, int c) { const int st = (r >> 4) * 2 + (c >> 5), rr = r & 15, cc = c & 31, ob = rr * 64 + cc * 2; return st * 1024 + (ob ^ (((ob >> 9) & 1) << 5)); }
__host__ __device__ __forceinline__ void stage_rc(int b, int& R, int& C) { const int st = b / 1024, sb = b % 1024, swz = sb ^ (((sb >> 9) & 1) << 5); R = (st >> 1) * 16 + swz / 64; C = (st & 1) * 32 + (swz % 64) / 2; }
__host__ __device__ __forceinline__ int perm32(int rho) { const int n = rho >> 4, i = rho & 15; return 8 * (i >> 2) + 4 * n + (i & 3); }

struct Unit { int pm, pn; };
struct Gemm { const bf16_t* A; const bf16_t* Bt; int M, N, K; int npg; size_t a_gstride; };

struct StaticOrder {
    int nM, nN, nwg, G, c;
    __host__ __device__ void init(int M, int N, int G_, int c_) { nM = M / BM; nN = N / BM; nwg = nM * nN; G = G_; c = c_; }
    __host__ __device__ bool next(int i, Unit& u) const {
        const long L = (long)i * G + c; if (L >= nwg) return false;
        int wgid = (int)L; { const int q = nwg / NXCD, r = nwg % NXCD, xcd = wgid % NXCD, off = wgid / NXCD; wgid = (xcd < r ? xcd * (q + 1) : r * (q + 1) + (xcd - r) * q) + off; }
        const int nig = WGM * nN, gid = wgid / nig, fm = gid * WGM, gsz = (nM - fm) < WGM ? (nM - fm) : WGM;
        u.pm = fm + ((wgid % nig) % gsz); u.pn = (wgid % nig) / gsz; return true;
    }
    __device__ __forceinline__ void a_ready(const Unit&) const {}
    __device__ __forceinline__ void done(const Unit&) const {}
};
template <class Epi, class Sched, bool STAMP = false>
__device__ __forceinline__ void gemm_phase(PG8_LAS unsigned char* lds, const Gemm g, const Sched& S, const Epi& E, unsigned long long* stamps) {
    int tid_l = threadIdx.x; asm volatile("" : "+v"(tid_l));
    const int tid = tid_l, wid = __builtin_amdgcn_readfirstlane(tid >> 6), lane = tid & 63, wr = wid >> 2, wc = wid & 3, fr = lane & 15, fq = lane >> 4;
    const int K = g.K, nt = K / BK;
    int ts_lo = 0, ts_hi = 0, nts = 0; const unsigned long long rt_entry = STAMP ? (unsigned long long)wall_clock64() : 0ull;
#define PG8_STAMP() do { if (STAMP && wid == 0 && nts < 64) { const unsigned long long _c = (unsigned long long)clock64(); \
        ts_lo = (lane == nts) ? (int)(unsigned)_c : ts_lo; ts_hi = (lane == nts) ? (int)(unsigned)(_c >> 32) : ts_hi; ++nts; } } while (0)
    PG8_STAMP();
    unsigned voffA[2], voffB[2];
#pragma unroll
    for (int i = 0; i < 2; ++i) { int R, C; stage_rc(tid * 16 + i * 8192, R, C); const int Rb = Epi::PERM ? ((R & ~31) + perm32(R & 31)) : R;
        voffA[i] = (unsigned)(R * K + C) * 2u; voffB[i] = (unsigned)(Rb * K + C) * 2u; }
    const size_t kstep = (size_t)(BK * 2);
    const size_t hstep = (size_t)HALF * K * 2;
    const size_t tstep = 2 * hstep;
    const unsigned ldsw = (unsigned)wid * 1024u;
    const int aoff = lds_byte(wr * 64 + fr, fq * 8), boff = lds_byte(wc * 32 + fr, fq * 8);
#define PG8_SA(b, h) (((b) * 2 + (h)) * HTB)
#define PG8_SB(b, h) ((4 + (b) * 2 + (h)) * HTB)
#define PG8_STAGE(bufoff, gbase, voff) do { _Pragma("unroll") for (int _i = 0; _i < 2; ++_i) \
        __builtin_amdgcn_global_load_lds((const unsigned*)((const char*)(gbase) + (voff)[_i]), (PG8_LAS unsigned*)(lds + (bufoff) + ldsw + _i * 8192), 16, 0, 0); } while (0)
#define PG8_LDA(dst, b, h) do { _Pragma("unroll") for (int m = 0; m < 4; ++m) _Pragma("unroll") for (int k = 0; k < 2; ++k) dst[m][k] = *(const PG8_LAS bf16x8*)(lds + PG8_SA(b, h) + aoff + m * 2048 + k * 1024); } while (0)
#define PG8_LDB(dst, b, h) do { _Pragma("unroll") for (int n = 0; n < 2; ++n) _Pragma("unroll") for (int k = 0; k < 2; ++k) dst[n][k] = *(const PG8_LAS bf16x8*)(lds + PG8_SB(b, h) + boff + n * 2048 + k * 1024); } while (0)
#define PG8_MMA(ai, bj, At, Bt) do { __builtin_amdgcn_s_setprio(1); _Pragma("unroll") for (int m = 0; m < 4; ++m) _Pragma("unroll") for (int n = 0; n < 2; ++n) _Pragma("unroll") for (int k = 0; k < 2; ++k) \
        acc[ai][bj][m][n] = __builtin_amdgcn_mfma_f32_16x16x32_bf16(Bt[n][k], At[m][k], acc[ai][bj][m][n], 0, 0, 0); __builtin_amdgcn_s_setprio(0); } while (0)
#define PG8_WAIT_V(n) asm volatile("s_waitcnt vmcnt(" #n ")" ::: "memory")
#define PG8_WAIT_L(n) asm volatile("s_waitcnt lgkmcnt(" #n ")" ::: "memory")
#define PG8_BAR __builtin_amdgcn_s_barrier()
#define PG8_SCHED __builtin_amdgcn_sched_barrier(0)
    Unit cur, nxt; int ui = 0;
    if (!S.next(0, cur)) return;
    f32x4 acc[2][2][4][2];
#pragma unroll
    for (int a = 0; a < 2; ++a)
#pragma unroll
        for (int b = 0; b < 2; ++b)
#pragma unroll
            for (int m = 0; m < 4; ++m)
#pragma unroll
                for (int n = 0; n < 2; ++n) acc[a][b][m][n] = (f32x4){0.f, 0.f, 0.f, 0.f};
    bf16x8 At[4][2], B0[2][2], B1[2][2];
    const char* cA = (const char*)g.A + (size_t)cur.pm * tstep + (g.npg ? (size_t)(cur.pn / g.npg) * g.a_gstride : (size_t)0); const char* cB = (const char*)g.Bt + (size_t)cur.pn * tstep;
    S.a_ready(cur);
    PG8_STAGE(PG8_SB(0, 0), cB, voffB); PG8_STAGE(PG8_SA(0, 0), cA, voffA); PG8_STAGE(PG8_SB(0, 1), cB + hstep, voffB); PG8_STAGE(PG8_SA(0, 1), cA + hstep, voffA);
    if (wr == 1) PG8_BAR;
    PG8_WAIT_V(4); PG8_BAR;
    PG8_STAGE(PG8_SB(1, 0), cB + kstep, voffB); PG8_STAGE(PG8_SA(1, 0), cA + kstep, voffA); PG8_STAGE(PG8_SB(1, 1), cB + hstep + kstep, voffB);
    PG8_WAIT_V(6); PG8_BAR;
    PG8_STAMP();
    for (;;) {
        const bool has_next = S.next(ui + 1, nxt);
        const char* nA = has_next ? (const char*)g.A + (size_t)nxt.pm * tstep + (g.npg ? (size_t)(nxt.pn / g.npg) * g.a_gstride : (size_t)0) : cA; const char* nB = has_next ? (const char*)g.Bt + (size_t)nxt.pn * tstep : cB;
        for (int t = 0; t < nt; t += 2) {
            const bool last = (t == nt - 2);
            const char* a1 = cA + (size_t)(t + 1) * kstep;
            const char* a2 = last ? nA : cA + (size_t)(t + 2) * kstep; const char* b2 = last ? nB : cB + (size_t)(t + 2) * kstep;
            const char* a3 = a2 + kstep; const char* b3 = b2 + kstep;
            if (last && has_next) S.a_ready(nxt);
            PG8_LDB(B0, 0, 0); PG8_SCHED; PG8_LDA(At, 0, 0); PG8_STAGE(PG8_SA(1, 1), a1 + hstep, voffA);
            PG8_WAIT_L(8); PG8_BAR; PG8_WAIT_L(0); PG8_MMA(0, 0, At, B0); PG8_BAR; PG8_SCHED;
            PG8_LDB(B1, 0, 1); PG8_STAGE(PG8_SB(0, 0), b2, voffB);
            PG8_BAR; PG8_WAIT_L(0); PG8_MMA(0, 1, At, B1); PG8_BAR;
            PG8_LDA(At, 0, 1); PG8_STAGE(PG8_SA(0, 0), a2, voffA);
            PG8_BAR; PG8_WAIT_L(0); PG8_MMA(1, 0, At, B0); PG8_BAR; PG8_SCHED;
            PG8_STAGE(PG8_SB(0, 1), b2 + hstep, voffB);
            PG8_WAIT_V(6); PG8_BAR; PG8_MMA(1, 1, At, B1); PG8_BAR;
            PG8_LDB(B0, 1, 0); PG8_SCHED; PG8_LDA(At, 1, 0); PG8_STAGE(PG8_SA(0, 1), a2 + hstep, voffA);
            PG8_WAIT_L(8); PG8_BAR; PG8_WAIT_L(0); PG8_MMA(0, 0, At, B0); PG8_BAR; PG8_SCHED;
            PG8_LDB(B1, 1, 1); PG8_STAGE(PG8_SB(1, 0), b3, voffB);
            PG8_BAR; PG8_WAIT_L(0); PG8_MMA(0, 1, At, B1); PG8_BAR;
            PG8_LDA(At, 1, 1); PG8_STAGE(PG8_SA(1, 0), a3, voffA);
            PG8_BAR; PG8_WAIT_L(0); PG8_MMA(1, 0, At, B0); PG8_BAR; PG8_SCHED;
            PG8_STAGE(PG8_SB(1, 1), b3 + hstep, voffB);
            PG8_WAIT_V(6); PG8_BAR; PG8_MMA(1, 1, At, B1); PG8_BAR;
        }
        PG8_STAMP();
        if constexpr (!Epi::AFTER_DRAIN) { E(acc, cur, wr, wc, fr, fq); S.done(cur); }
        PG8_STAMP();
        if (!has_next) break;
#pragma unroll
        for (int a = 0; a < 2; ++a)
#pragma unroll
            for (int b = 0; b < 2; ++b)
#pragma unroll
                for (int m = 0; m < 4; ++m)
#pragma unroll
                    for (int n = 0; n < 2; ++n) acc[a][b][m][n] = (f32x4){0.f, 0.f, 0.f, 0.f};
        cur = nxt; cA = nA; cB = nB; ++ui;
    }
    PG8_WAIT_V(0);
    if (wr == 0) PG8_BAR;
    PG8_BAR;
    if constexpr (Epi::AFTER_DRAIN) { E.fused(acc, cur, wr, wc, fr, fq, lds, wid, lane); S.done(cur); }
    PG8_STAMP();
    if (STAMP && wid == 0) { stamps[lane] = lane < nts ? (((unsigned long long)(unsigned)ts_hi << 32) | (unsigned)ts_lo) : 0ull;
        if (lane == 62) stamps[62] = rt_entry; if (lane == 63) stamps[63] = (unsigned long long)wall_clock64(); }
#undef PG8_STAMP
#undef PG8_SA
#undef PG8_SB
#undef PG8_STAGE
#undef PG8_LDA
#undef PG8_LDB
#undef PG8_MMA
#undef PG8_WAIT_V
#undef PG8_WAIT_L
#undef PG8_BAR
#undef PG8_SCHED
}
template <class Epi, class Sched, bool ALIGN_EPI = false, bool SP2 = false>
__device__ __forceinline__ void gemm_phase2(PG8_LAS unsigned char* lds, const Gemm g, const Sched& S, const Epi& E) {
    int tid_l = threadIdx.x; asm volatile("" : "+v"(tid_l));
    const int tid = tid_l, wid = __builtin_amdgcn_readfirstlane(tid >> 6), lane = tid & 63, wr = wid >> 2, wc = wid & 3, fr = lane & 15, fq = lane >> 4;
    const int K = g.K, nt = K / BK;
    unsigned voffA[2], voffB[2];
#pragma unroll
    for (int i = 0; i < 2; ++i) { int R, C; stage_rc(tid * 16 + i * 8192, R, C); const int Rb = Epi::PERM ? ((R & ~31) + perm32(R & 31)) : R;
        voffA[i] = (unsigned)(R * K + C) * 2u; voffB[i] = (unsigned)(Rb * K + C) * 2u; }
    const size_t kstep = (size_t)(BK * 2);
    const size_t hstep = (size_t)HALF * K * 2;
    const size_t tstep = 2 * hstep;
    const unsigned ldsw = (unsigned)wid * 1024u;
    const int aoff = lds_byte(wr * 64 + fr, fq * 8), boff = lds_byte(wc * 32 + fr, fq * 8);
#define PG8_SA(b, h) (((b) * 2 + (h)) * HTB)
#define PG8_SB(b, h) ((4 + (b) * 2 + (h)) * HTB)
#define PG8_STAGE(bufoff, gbase, voff) do { _Pragma("unroll") for (int _i = 0; _i < 2; ++_i) \
        __builtin_amdgcn_global_load_lds((const unsigned*)((const char*)(gbase) + (voff)[_i]), (PG8_LAS unsigned*)(lds + (bufoff) + ldsw + _i * 8192), 16, 0, 0); } while (0)
#define PG8_LDA(dst, b, h) do { _Pragma("unroll") for (int m = 0; m < 4; ++m) _Pragma("unroll") for (int k = 0; k < 2; ++k) dst[m][k] = *(const PG8_LAS bf16x8*)(lds + PG8_SA(b, h) + aoff + m * 2048 + k * 1024); } while (0)
#define PG8_LDB(dst, b, h) do { _Pragma("unroll") for (int n = 0; n < 2; ++n) _Pragma("unroll") for (int k = 0; k < 2; ++k) dst[n][k] = *(const PG8_LAS bf16x8*)(lds + PG8_SB(b, h) + boff + n * 2048 + k * 1024); } while (0)
#define PG8_MMA(ai, bj, At, Bt) do { __builtin_amdgcn_s_setprio(1); _Pragma("unroll") for (int m = 0; m < 4; ++m) _Pragma("unroll") for (int n = 0; n < 2; ++n) _Pragma("unroll") for (int k = 0; k < 2; ++k) \
        acc[ai][bj][m][n] = __builtin_amdgcn_mfma_f32_16x16x32_bf16(Bt[n][k], At[m][k], acc[ai][bj][m][n], 0, 0, 0); __builtin_amdgcn_s_setprio(0); } while (0)
#define PG8_WAIT_V(n) asm volatile("s_waitcnt vmcnt(" #n ")" ::: "memory")
#define PG8_WAIT_L(n) asm volatile("s_waitcnt lgkmcnt(" #n ")" ::: "memory")
#define PG8_BAR __builtin_amdgcn_s_barrier()
#define PG8_SCHED __builtin_amdgcn_sched_barrier(0)
    Unit cur, nxt; int ui = 0;
    if (!S.next(0, cur)) return;
    f32x4 acc[2][2][4][2];
#pragma unroll
    for (int a = 0; a < 2; ++a)
#pragma unroll
        for (int b = 0; b < 2; ++b)
#pragma unroll
            for (int m = 0; m < 4; ++m)
#pragma unroll
                for (int n = 0; n < 2; ++n) acc[a][b][m][n] = (f32x4){0.f, 0.f, 0.f, 0.f};
    bf16x8 At[4][2], B0[2][2], B1[2][2];
    const char* cA = (const char*)g.A + (size_t)cur.pm * tstep + (g.npg ? (size_t)(cur.pn / g.npg) * g.a_gstride : (size_t)0); const char* cB = (const char*)g.Bt + (size_t)cur.pn * tstep;
    S.a_ready(cur);
    if constexpr (SP2) {
        PG8_STAGE(PG8_SB(0, 0), cB, voffB); PG8_STAGE(PG8_SB(0, 1), cB + hstep, voffB); PG8_STAGE(PG8_SA(0, 0), cA, voffA); PG8_STAGE(PG8_SA(0, 1), cA + hstep, voffA);
        if (wr == 1) PG8_BAR;
        PG8_WAIT_V(2); PG8_BAR;
        PG8_STAGE(PG8_SB(1, 0), cB + kstep, voffB); PG8_STAGE(PG8_SA(1, 0), cA + kstep, voffA); PG8_STAGE(PG8_SB(1, 1), cB + hstep + kstep, voffB);
        PG8_WAIT_V(6); PG8_BAR;
    } else {
        PG8_STAGE(PG8_SB(0, 0), cB, voffB); PG8_STAGE(PG8_SA(0, 0), cA, voffA); PG8_STAGE(PG8_SB(0, 1), cB + hstep, voffB); PG8_STAGE(PG8_SA(0, 1), cA + hstep, voffA);
        if (wr == 1) PG8_BAR;
        PG8_WAIT_V(4); PG8_BAR;
        PG8_STAGE(PG8_SB(1, 0), cB + kstep, voffB); PG8_STAGE(PG8_SA(1, 0), cA + kstep, voffA); PG8_STAGE(PG8_SB(1, 1), cB + hstep + kstep, voffB);
        PG8_WAIT_V(6); PG8_BAR;
    }
    for (;;) {
        const bool has_next = S.next(ui + 1, nxt);
        const char* nA = has_next ? (const char*)g.A + (size_t)nxt.pm * tstep + (g.npg ? (size_t)(nxt.pn / g.npg) * g.a_gstride : (size_t)0) : cA; const char* nB = has_next ? (const char*)g.Bt + (size_t)nxt.pn * tstep : cB;
        for (int t = 0; t < nt; t += 2) {
            const bool last = (t == nt - 2);
            const char* a1 = cA + (size_t)(t + 1) * kstep;
            const char* a2 = last ? nA : cA + (size_t)(t + 2) * kstep; const char* b2 = last ? nB : cB + (size_t)(t + 2) * kstep;
            const char* a3 = a2 + kstep; const char* b3 = b2 + kstep;
            if (last && has_next) S.a_ready(nxt);
            if constexpr (SP2) {
            PG8_LDB(B0, 0, 0); PG8_LDB(B1, 0, 1); PG8_SCHED; PG8_LDA(At, 0, 0); PG8_STAGE(PG8_SA(1, 1), a1 + hstep, voffA);
            PG8_WAIT_V(8); PG8_WAIT_L(0); PG8_BAR; PG8_MMA(0, 0, At, B0); PG8_MMA(0, 1, At, B1); PG8_BAR; PG8_SCHED;
            PG8_LDA(At, 0, 1); PG8_STAGE(PG8_SB(0, 0), b2, voffB); PG8_STAGE(PG8_SB(0, 1), b2 + hstep, voffB); PG8_STAGE(PG8_SA(0, 0), a2, voffA);
            PG8_WAIT_V(8); PG8_WAIT_L(0); PG8_BAR; PG8_MMA(1, 0, At, B0); PG8_MMA(1, 1, At, B1); PG8_BAR; PG8_SCHED;
            PG8_LDB(B0, 1, 0); PG8_LDB(B1, 1, 1); PG8_SCHED; PG8_LDA(At, 1, 0); PG8_STAGE(PG8_SA(0, 1), a2 + hstep, voffA);
            PG8_WAIT_V(8); PG8_WAIT_L(0); PG8_BAR; PG8_MMA(0, 0, At, B0); PG8_MMA(0, 1, At, B1); PG8_BAR; PG8_SCHED;
            PG8_LDA(At, 1, 1); PG8_STAGE(PG8_SB(1, 0), b3, voffB); PG8_STAGE(PG8_SB(1, 1), b3 + hstep, voffB); PG8_STAGE(PG8_SA(1, 0), a3, voffA);
            PG8_WAIT_V(8); PG8_WAIT_L(0); PG8_BAR; PG8_MMA(1, 0, At, B0); PG8_MMA(1, 1, At, B1); PG8_BAR; PG8_SCHED;
            } else {
            PG8_LDB(B0, 0, 0); PG8_SCHED; PG8_LDA(At, 0, 0); PG8_STAGE(PG8_SA(1, 1), a1 + hstep, voffA);
            PG8_WAIT_L(8); PG8_BAR; PG8_WAIT_L(0); PG8_MMA(0, 0, At, B0); PG8_BAR; PG8_SCHED;
            PG8_LDB(B1, 0, 1); PG8_STAGE(PG8_SB(0, 0), b2, voffB);
            PG8_BAR; PG8_WAIT_L(0); PG8_MMA(0, 1, At, B1); PG8_BAR;
            PG8_LDA(At, 0, 1); PG8_STAGE(PG8_SA(0, 0), a2, voffA);
            PG8_BAR; PG8_WAIT_L(0); PG8_MMA(1, 0, At, B0); PG8_BAR; PG8_SCHED;
            PG8_STAGE(PG8_SB(0, 1), b2 + hstep, voffB);
            PG8_WAIT_V(6); PG8_BAR; PG8_MMA(1, 1, At, B1); PG8_BAR;
            PG8_LDB(B0, 1, 0); PG8_SCHED; PG8_LDA(At, 1, 0); PG8_STAGE(PG8_SA(0, 1), a2 + hstep, voffA);
            PG8_WAIT_L(8); PG8_BAR; PG8_WAIT_L(0); PG8_MMA(0, 0, At, B0); PG8_BAR; PG8_SCHED;
            PG8_LDB(B1, 1, 1); PG8_STAGE(PG8_SB(1, 0), b3, voffB);
            PG8_BAR; PG8_WAIT_L(0); PG8_MMA(0, 1, At, B1); PG8_BAR;
            PG8_LDA(At, 1, 1); PG8_STAGE(PG8_SA(1, 0), a3, voffA);
            PG8_BAR; PG8_WAIT_L(0); PG8_MMA(1, 0, At, B0); PG8_BAR; PG8_SCHED;
            PG8_STAGE(PG8_SB(1, 1), b3 + hstep, voffB);
            PG8_WAIT_V(6); PG8_BAR; PG8_MMA(1, 1, At, B1); PG8_BAR;
            }
        }
        if constexpr (ALIGN_EPI) { if (wr == 0) PG8_BAR; }
        if constexpr (!Epi::AFTER_DRAIN) { E(acc, cur, wr, wc, fr, fq); S.done(cur); }
        if (!has_next) break;
#pragma unroll
        for (int a = 0; a < 2; ++a)
#pragma unroll
            for (int b = 0; b < 2; ++b)
#pragma unroll
                for (int m = 0; m < 4; ++m)
#pragma unroll
                    for (int n = 0; n < 2; ++n) acc[a][b][m][n] = (f32x4){0.f, 0.f, 0.f, 0.f};
        cur = nxt; cA = nA; cB = nB; ++ui;
        if constexpr (ALIGN_EPI) { if (wr == 1) PG8_BAR; }
    }
    PG8_WAIT_V(0);
    if constexpr (!ALIGN_EPI) { if (wr == 0) PG8_BAR; }
    PG8_BAR;
    if constexpr (Epi::AFTER_DRAIN) { E.fused(acc, cur, wr, wc, fr, fq, lds, wid, lane); S.done(cur); }
#undef PG8_SA
#undef PG8_SB
#undef PG8_STAGE
#undef PG8_LDA
#undef PG8_LDB
#undef PG8_MMA
#undef PG8_WAIT_V
#undef PG8_WAIT_L
#undef PG8_BAR
#undef PG8_SCHED
}

}

#define LAS __attribute__((address_space(3)))
typedef unsigned short bf16;
typedef short bf16x8 __attribute__((ext_vector_type(8)));
typedef float f32x4 __attribute__((ext_vector_type(4)));
typedef float f32x2 __attribute__((ext_vector_type(2)));
typedef float f32x16 __attribute__((ext_vector_type(16)));
typedef unsigned u32x4 __attribute__((ext_vector_type(4)));
typedef unsigned u32x2 __attribute__((ext_vector_type(2)));
typedef __bf16 bf16x2_t __attribute__((ext_vector_type(2)));
#define DI __device__ __forceinline__
#define MFMA32(a, b, c) __builtin_amdgcn_mfma_f32_32x32x16_bf16((a), (b), (c), 0, 0, 0)

DI float bf2f(unsigned short b) { return __uint_as_float(((unsigned)b) << 16); }
DI float bflo(unsigned w) { return __uint_as_float(w << 16); }
DI float bfhi(unsigned w) { return __uint_as_float(w & 0xffff0000u); }
DI unsigned pk2(float lo, float hi) { f32x2 v; v.x = lo; v.y = hi; return __builtin_bit_cast(unsigned, __builtin_convertvector(v, bf16x2_t)); }
DI unsigned short f2bf(float f) { return (unsigned short)(pk2(f, 0.f) & 0xffffu); }
DI int crow(int reg, int h) { return (reg & 3) + 8 * (reg >> 2) + 4 * h; }
DI bf16x8 pack_step(const f32x16& x, int s) {
    u32x4 p; p.x = pk2(x[8 * s], x[8 * s + 1]); p.y = pk2(x[8 * s + 2], x[8 * s + 3]); p.z = pk2(x[8 * s + 4], x[8 * s + 5]); p.w = pk2(x[8 * s + 6], x[8 * s + 7]);
    return __builtin_bit_cast(bf16x8, p);
}
DI bf16x8 pack8f(f32x4 a, f32x4 b) { u32x4 p; p.x = pk2(a.x, a.y); p.y = pk2(a.z, a.w); p.z = pk2(b.x, b.y); p.w = pk2(b.z, b.w); return __builtin_bit_cast(bf16x8, p); }
DI bf16x8 join8(u32x2 lo, u32x2 hi) { u32x4 p; p.x = lo.x; p.y = lo.y; p.z = hi.x; p.w = hi.y; return __builtin_bit_cast(bf16x8, p); }
DI float wave_sum(float v) {
#pragma unroll
    for (int o = 1; o < 64; o <<= 1) v += __shfl_xor(v, o);
    return v;
}
DI float half_sum(float v) {
#pragma unroll
    for (int o = 1; o < 32; o <<= 1) v += __shfl_xor(v, o);
    return v;
}
#define DPP_ROR(x, n) __builtin_bit_cast(float, __builtin_amdgcn_update_dpp(0, __builtin_bit_cast(int, (x)), 0x120 + (n), 0xf, 0xf, false))
DI float row16_sum(float x) { x += DPP_ROR(x, 8); x += DPP_ROR(x, 4); x += DPP_ROR(x, 2); x += DPP_ROR(x, 1); return x; }
DI float sigmoidf_(float x) { return __builtin_amdgcn_rcpf(1.0f + __expf(-x)); }
DI float siluf_(float x) { return x * __builtin_amdgcn_rcpf(1.0f + __expf(-x)); }
DI float gelu_erf(float v) {
    const float t = __builtin_amdgcn_rcpf(fabsf(v) * 0.2316418882f + 1.0f);
    float q = t * 0.5307027145f + (-0.7265760135f); q = q * t + 0.7107068705f; q = q * t + (-0.142248368f); q = q * t + 0.127414796f; q = q * t;
    const float e = __builtin_amdgcn_exp2f((v * v) * (-0.72134752044f));
    const float m = v * (q * e);
    return v < 0.f ? m : v - m;
}
DI float logsigmoidf_(float x) { return fminf(x, 0.f) - log1pf(__expf(-fabsf(x))); }

#define XB_TMO      128
#define XB_XCNT(j)  (256  + 64 * (j))
#define XB_XSUB(j)  (1280 + 64 * (j))
#define XB_XGEN(j)  (2304 + 64 * (j))
#define XB_TOP      3328
#define XB_TOPGEN   3392
#define XCD_BAR_WORDS 3456
#define XB_SPIN_CAP (1u << 18)
__device__ __forceinline__ unsigned xb_ld(unsigned* p)              { return __hip_atomic_load(p, __ATOMIC_RELAXED, __HIP_MEMORY_SCOPE_AGENT); }
__device__ __forceinline__ unsigned xb_add(unsigned* p, unsigned v) { return __hip_atomic_fetch_add(p, v, __ATOMIC_RELAXED, __HIP_MEMORY_SCOPE_AGENT); }
__device__ __forceinline__ unsigned xb_xcc_id() { return (unsigned)__builtin_amdgcn_s_getreg((3 << 11) | 20) & 0xFu; }
#define XB_SPIN(cond, bar) do { unsigned _sp = 0; while (cond) { __builtin_amdgcn_s_sleep(1); \
    if ((++_sp & 255u) == 0u) { if (xb_ld(&(bar)[XB_TMO])) break; if (_sp > XB_SPIN_CAP) { atomicAdd(&(bar)[XB_TMO], 1u); break; } } } } while (0)
struct XcdBarrier { unsigned* bar; unsigned x; volatile LAS unsigned* st; };
__device__ __forceinline__ XcdBarrier xcd_barrier_post(unsigned* bar, volatile LAS unsigned* st) {
    XcdBarrier b; b.bar = bar; b.x = xb_xcc_id(); b.st = st;
    if (threadIdx.x == 0) (void)xb_add(&bar[XB_XCNT(b.x)], 1u);
    return b;
}
__device__ __forceinline__ void xcd_barrier_complete(unsigned* bar, unsigned x, unsigned& nloc, unsigned& nx) {
    const unsigned G = gridDim.x * gridDim.y * gridDim.z;
    unsigned sum, cnt, mine, sp = 0u;
    for (;;) {
        sum = 0u; cnt = 0u; mine = 0u;
#pragma unroll
        for (unsigned j = 0; j < 16; ++j) { const unsigned c = xb_ld(&bar[XB_XCNT(j)]); sum += c; cnt += (c > 0u) ? 1u : 0u; mine = (j == x) ? c : mine; }
        if (sum == G) break;
        __builtin_amdgcn_s_sleep(1);
        if ((++sp & 255u) == 0u) { if (xb_ld(&bar[XB_TMO])) break; if (sp > XB_SPIN_CAP) { atomicAdd(&bar[XB_TMO], 1u); break; } }
    }
    nloc = mine > 0u ? mine : 1u; nx = cnt > 0u ? cnt : 1u;
}
__device__ __forceinline__ void xcd_barrier(const XcdBarrier& b) {
    asm volatile("s_waitcnt vmcnt(0)" ::: "memory");
    __syncthreads();
    if (threadIdx.x == 0) {
        unsigned* bar = b.bar;
        __builtin_amdgcn_s_waitcnt(0);
        unsigned nloc = b.st[0], nx = b.st[1];
        if (nloc == 0u) { xcd_barrier_complete(bar, b.x, nloc, nx); b.st[0] = nloc; b.st[1] = nx; }
        const unsigned old = xb_add(&bar[XB_XSUB(b.x)], 1u);
        const unsigned gen = old / nloc;
        if (old + 1u == (gen + 1u) * nloc) {
            __builtin_amdgcn_fence(__ATOMIC_RELEASE, "agent");
            asm volatile("s_waitcnt vmcnt(0)" ::: "memory");
            const unsigned og = xb_add(&bar[XB_TOP], 1u);
            const unsigned tg = og / nx;
            if (og + 1u == (tg + 1u) * nx) xb_add(&bar[XB_TOPGEN], 1u);
            else XB_SPIN(xb_ld(&bar[XB_TOPGEN]) == tg, bar);
            __builtin_amdgcn_fence(__ATOMIC_ACQUIRE, "agent");
            xb_add(&bar[XB_XGEN(b.x)], 1u);
            asm volatile("s_waitcnt vmcnt(0)" ::: "memory");
        } else {
            XB_SPIN(xb_ld(&bar[XB_XGEN(b.x)]) == gen, bar);
            __builtin_amdgcn_fence(__ATOMIC_ACQUIRE, "agent");
            asm volatile("s_waitcnt vmcnt(0)" ::: "memory");
        }
    }
    __syncthreads();
}

constexpr int NB = 4, SEQ = 4096, T = NB * SEQ, DM = 2048, BW = 1024, NIN = 23320;
constexpr int N1 = 15360, LDP = 14848, N1BF_TILES = 58, NM = 8192;
constexpr int AQ = 0, AK = 512, AV = 1024, AG = 2048, BQ = 3072, BK_ = 4096, BV = 5120, BIQ = 6144, BG = 6656, CR = 7680, CK = 8704, CV = 9728, CG = 10752, DU = 11776, DV = 12800, DG = 13824;
constexpr int GLR = 0, IK = 16, IW = 80, WLR = 96, ALR = 192;
constexpr size_t MiB = 1u << 20;
constexpr size_t WS_CTL = 0, CTL_BYTES = 64 * 1024;
constexpr size_t WS_WT1 = 1 * MiB;
constexpr size_t WS_WTM = 121 * MiB;
constexpr size_t WS_WTP = 185 * MiB;
constexpr size_t WS_WTO = 217 * MiB;
constexpr size_t WS_WSB = 233 * MiB;
constexpr size_t WS_H   = 234 * MiB;
constexpr size_t WS_P   = 298 * MiB;
constexpr size_t WS_SM  = 762 * MiB;
constexpr size_t WS_RW  = 794 * MiB;
constexpr size_t WS_VT  = 1050 * MiB;
constexpr size_t WS_SC  = 1082 * MiB;
constexpr size_t WS_BM  = 1212 * MiB;
constexpr size_t WS_YS  = 1220 * MiB;
constexpr size_t WS_ROPE = 1348 * MiB;
constexpr size_t WS_KV = 1351 * MiB;
constexpr size_t WS_ET = 1415 * MiB;
constexpr size_t WS_WLR = 1416 * MiB;
constexpr size_t WS_END = 1418 * MiB;
constexpr size_t RW_ARR = (size_t)T * 1024 * 2;
constexpr int CW_BAR = 64, CW_Q = 4096, CW_F = 8192;
constexpr int CW_UNUSED_ = 0;
constexpr int LDS_BYTES = 147456, MISC_OFF = LDS_BYTES - 256;
constexpr int NPHASE = 21;

struct Args { const float* in[24]; const int* pos; float* out; unsigned char* ws; int ph_lo, ph_hi; };

template <int MODE> struct Epi {
    static constexpr bool PERM = true, AFTER_DRAIN = false;
    unsigned char* O; float* O2;
    __device__ __forceinline__ void operator()(const pg8::f32x4 (&acc)[2][2][4][2], const pg8::Unit& u, int wr, int wc, int fr, int fq) const {
        const int row0 = u.pm * 256 + wr * 64 + fr, cl = wc * 32 + 8 * fq;
        if (MODE == 2) {
            const bf16* proj = (const bf16*)O2; bf16* merged = (bf16*)O;
            const unsigned d0 = u.pn * 64 + wc * 16 + 4 * fq;
            u32x2 pv[2][4][4];
#pragma unroll
            for (int ai = 0; ai < 2; ++ai)
#pragma unroll
                for (int m = 0; m < 4; ++m)
#pragma unroll
                    for (int g = 0; g < 4; ++g) pv[ai][m][g] = *(const u32x2*)(proj + ((unsigned)(g * T + row0 + ai * 128 + m * 16) * (unsigned)DM + d0));
#pragma unroll
            for (int ai = 0; ai < 2; ++ai)
#pragma unroll
                for (int m = 0; m < 4; ++m) { float o0 = 0.f, o1 = 0.f, o2 = 0.f, o3 = 0.f;
#pragma unroll
                    for (int g = 0; g < 4; ++g) { const pg8::f32x4 v = acc[ai][g >> 1][m][g & 1]; const u32x2 p = pv[ai][m][g];
                        o0 += sigmoidf_(v[0]) * bflo(p.x); o1 += sigmoidf_(v[1]) * bfhi(p.x); o2 += sigmoidf_(v[2]) * bflo(p.y); o3 += sigmoidf_(v[3]) * bfhi(p.y); }
                    u32x2 w; w.x = pk2(o0, o1); w.y = pk2(o2, o3);
                    *(u32x2*)(merged + ((unsigned)(row0 + ai * 128 + m * 16) * (unsigned)DM + d0)) = w; }
        } else if ((MODE == 0 && u.pn >= N1BF_TILES) || MODE == 3) {
            float* base; int ldc;
            if (MODE == 0) { base = O2 + (u.pn - N1BF_TILES) * 256 + cl; ldc = 512; } else { base = (float*)O + u.pn * 256 + cl; ldc = DM; }
#pragma unroll
            for (int ai = 0; ai < 2; ++ai)
#pragma unroll
                for (int m = 0; m < 4; ++m) { float* rowp = base + (size_t)(row0 + ai * 128 + m * 16) * ldc;
#pragma unroll
                    for (int bj = 0; bj < 2; ++bj) { *(pg8::f32x4*)(rowp + bj * 128) = acc[ai][bj][m][0]; *(pg8::f32x4*)(rowp + bj * 128 + 4) = acc[ai][bj][m][1]; } }
        } else {
            bf16* base; int ldc;
            if (MODE == 0) { base = (bf16*)O + u.pn * 256 + cl; ldc = LDP; }
            else if (MODE == 1) { const int g = u.pn >> 3; base = (bf16*)O + (size_t)g * T * DM + (u.pn & 7) * 256 + cl; ldc = DM; }
            else { base = (bf16*)O + u.pn * 256 + cl; ldc = NM; }
#pragma unroll
            for (int ai = 0; ai < 2; ++ai)
#pragma unroll
                for (int m = 0; m < 4; ++m) { bf16* rowp = base + (size_t)(row0 + ai * 128 + m * 16) * ldc;
#pragma unroll
                    for (int bj = 0; bj < 2; ++bj) { pg8::f32x4 v0 = acc[ai][bj][m][0], v1 = acc[ai][bj][m][1];
                        if (MODE == 0 && u.pn >= DU / 256 && u.pn < DG / 256) {
#pragma unroll
                            for (int e = 0; e < 4; ++e) { v0[e] = gelu_erf(v0[e]); v1[e] = gelu_erf(v1[e]); } }
                        u32x4 w; w.x = pk2(v0[0], v0[1]); w.y = pk2(v0[2], v0[3]); w.z = pk2(v1[0], v1[1]); w.w = pk2(v1[2], v1[3]);
                        *(u32x4*)(rowp + bj * 128) = w; } }
        }
    }
};

DI int map1(int n) {
    if (n < 2048) return n;
    if (n < 6656) return n + 16;
    if (n < 10752) return n + 88;
    if (n < LDP) return n + 280;
    const int m = n - LDP;
    if (m < 16) return 2048 + m;
    if (m < 80) return 6672 + (m - 16);
    if (m < 88) return 6736 + (m - 80);
    if (m < 96) return -1;
    if (m < 192) return 10840 + (m - 96);
    if (m < 288) return 10936 + (m - 192);
    return -1;
}
DI void tr_item(const float* W, size_t ldw, int K, bf16* WT, int k0, int sc, int nd, LAS float* scr, int lane) {
#pragma unroll 8
    for (int i = 0; i < 32; ++i) { const int kk = 2 * i + (lane >> 5); const float v = sc >= 0 ? W[(size_t)(k0 + kk) * ldw + sc] : 0.f; scr[kk * 33 + (lane & 31)] = v; }
    asm volatile("s_waitcnt lgkmcnt(0)" ::: "memory");
    const int c = lane & 7;
#pragma unroll
    for (int jj = 0; jj < 4; ++jj) { const int n = (lane >> 3) + 8 * jj; const LAS float* s = scr + (8 * c) * 33 + n;
        u32x4 o; o.x = pk2(s[0 * 33], s[1 * 33]); o.y = pk2(s[2 * 33], s[3 * 33]); o.z = pk2(s[4 * 33], s[5 * 33]); o.w = pk2(s[6 * 33], s[7 * 33]);
        *(u32x4*)(WT + (size_t)(nd + n) * K + k0 + 8 * c) = o; }
    asm volatile("s_waitcnt lgkmcnt(0)" ::: "memory");
}
DI void tr_item64(const float* W, size_t ldw, int K, bf16* WT, int k0, int sc0, int nd, LAS float* scr, int lane, int gsel = -1) {
    const int kr = lane >> 4, c4 = 4 * (lane & 15);
    f32x4 v[16];
#pragma unroll
    for (int i = 0; i < 16; ++i) v[i] = *(const f32x4*)(W + (size_t)(k0 + 4 * i + kr) * ldw + sc0 + c4);
#pragma unroll
    for (int i = 0; i < 16; ++i) { LAS float* d = scr + (4 * i + kr) * 65 + c4; d[0] = v[i].x; d[1] = v[i].y; d[2] = v[i].z; d[3] = v[i].w; }
    asm volatile("s_waitcnt lgkmcnt(0)" ::: "memory");
    const int c = lane & 7;
#pragma unroll
    for (int jj = 0; jj < 8; ++jj) { const int n = (lane >> 3) + 8 * jj; const LAS float* s = scr + (8 * c) * 65 + n;
        u32x4 o; o.x = pk2(s[0 * 65], s[1 * 65]); o.y = pk2(s[2 * 65], s[3 * 65]); o.z = pk2(s[4 * 65], s[5 * 65]); o.w = pk2(s[6 * 65], s[7 * 65]);
        const int nr = gsel < 0 ? n : 128 * (gsel >> 1) + 32 * (n >> 4) + 8 * ((n >> 2) & 3) + 4 * (gsel & 1) + (n & 3);
        *(u32x4*)(WT + (size_t)(nd + nr) * K + k0 + 8 * c) = o; }
    asm volatile("s_waitcnt lgkmcnt(0)" ::: "memory");
}
DI int map1_base(int n0) { return n0 < 2048 ? n0 : (n0 < 6656 ? n0 + 16 : (n0 < 10752 ? n0 + 88 : n0 + 280)); }
DI void phase_prologue(const Args& a, LAS unsigned char* lds, int tid, int lane, int wave, int bid, int G, int sel = 15) {
    LAS float* scr = (LAS float*)(lds + wave * 16640);
    const int gw = bid * 8 + wave, NGW = G * 8;
    constexpr int I1 = 32 * 232, IS = 32 * 16, IM = 32 * 128, IP = 4 * 16 * 32, IO = 32 * 32, IL = I1 + IS + IM + IP + IO;
    if (sel & 1) for (int it = gw; it < 2 * IL; it += NGW) {
        const int l = it / IL; int r = it - l * IL;
        const float* win = a.in[4] + (size_t)l * DM * NIN;
        if (r < I1) { const int kb = r % 32, nb = r / 32; tr_item64(win, NIN, DM, (bf16*)(a.ws + WS_WT1) + (size_t)l * N1 * DM, 64 * kb, map1_base(64 * nb), 64 * nb, scr, lane); continue; } r -= I1;
        if (r < IS) { const int kb = r % 32, nb = 464 + r / 32; tr_item(win, NIN, DM, (bf16*)(a.ws + WS_WT1) + (size_t)l * N1 * DM, 64 * kb, map1(32 * nb + (lane & 31)), 32 * nb, scr, lane); continue; } r -= IS;
        if (r < IM) { const int kb = r % 32, nb = r / 32; tr_item64(win, NIN, DM, (bf16*)(a.ws + WS_WTM) + (size_t)l * NM * DM, 64 * kb, 15128 + 64 * nb, 256 * (nb & 31), scr, lane, nb >> 5); continue; } r -= IM;
        if (r < IP) { const int g = r / 512, q = r % 512, kb = q % 16, nb = q / 16;
            tr_item64(a.in[22] + ((size_t)(l * 4 + g) << 21), DM, BW, (bf16*)(a.ws + WS_WTP) + ((size_t)(l * 4 + g) << 21), 64 * kb, 64 * nb, 64 * nb, scr, lane); continue; } r -= IP;
        { const int kb = r % 32, nb = r / 32; tr_item64(a.in[23] + ((size_t)l << 22), DM, DM, (bf16*)(a.ws + WS_WTO) + ((size_t)l << 22), 64 * kb, 64 * nb, 64 * nb, scr, lane); }
    }
    if (sel & 2) { f32x2* rope = (f32x2*)(a.ws + WS_ROPE);
      for (int e = bid * 512 + tid; e < T * 24; e += G * 512) { const int t = e / 24, i = e - t * 24;
          const float inv = i < 16 ? (float)pow(500000.0, -(double)(2 * i) / 32.0) : (float)pow(500000.0, -(double)(2 * (i - 16)) / 16.0);
          const float ang = (float)a.pos[t] * inv; double sd, cd; sincos((double)ang, &sd, &cd); f32x2 o; o.x = (float)cd; o.y = (float)sd; rope[e] = o; } }
    if (sel & 4) { bf16* wl = (bf16*)(a.ws + WS_WLR);
      for (int e = bid * 512 + tid; e < 2 * 2 * 96 * 1024; e += G * 512) { const int n = e & 1023, k = (e >> 10) % 96, lm = (e >> 10) / 96, l = lm >> 1, m = lm & 1;
          const float x = a.in[m ? 12 : 10][(size_t)l * 96 * BW + k * BW + n]; const bf16 hi = f2bf(x); const bf16 lo = f2bf(x - bf2f(hi));
          wl[((size_t)(lm * 2 + 0) * 1024 + n) * 96 + k] = hi; wl[((size_t)(lm * 2 + 1) * 1024 + n) * 96 + k] = lo; } }
    bf16* wsb = (bf16*)(a.ws + WS_WSB);
    if (sel & 8) for (int e = bid * 512 + tid; e < 2 * 8 * 128 * 128; e += G * 512) { const int j = e & 127, i = (e >> 7) & 127; wsb[e] = (i < 64 && j >= 64) ? (bf16)0 : f2bf(a.in[20][e]); }
}

DI void phase_prenorm(const float* x, const float* g, bf16* h, int gw, int NGW, int lane) {
    for (int m = gw; m < T; m += NGW) {
        const f32x4* xr = (const f32x4*)(x + (size_t)m * DM) + lane; f32x4 v[8]; float s = 0.f;
#pragma unroll
        for (int j = 0; j < 8; ++j) { v[j] = xr[64 * j]; s += (v[j].x * v[j].x + v[j].y * v[j].y) + (v[j].z * v[j].z + v[j].w * v[j].w); }
        const float rs = 1.0f / sqrtf(wave_sum(s) * (1.0f / DM) + 1e-6f);
        u32x2* o = (u32x2*)(h + (size_t)m * DM) + lane;
#pragma unroll
        for (int j = 0; j < 8; ++j) { const f32x4 gv = ((const f32x4*)g)[lane + 64 * j]; u32x2 w; w.x = pk2(v[j].x * rs * gv.x, v[j].y * rs * gv.y); w.y = pk2(v[j].z * rs * gv.z, v[j].w * rs * gv.w); o[64 * j] = w; }
    }
}
DI void phase_postnorm(const float* x, const float* y, const float* g, float* out, const float* gnext, bf16* hnext, int gw, int NGW, int lane) {
    for (int m = gw; m < T; m += NGW) {
        const f32x4* yr = (const f32x4*)(y + (size_t)m * DM) + lane; const f32x4* xr = (const f32x4*)(x + (size_t)m * DM) + lane; f32x4 v[8], xv[8]; float s = 0.f;
#pragma unroll
        for (int j = 0; j < 8; ++j) { v[j] = yr[64 * j]; xv[j] = xr[64 * j]; s += (v[j].x * v[j].x + v[j].y * v[j].y) + (v[j].z * v[j].z + v[j].w * v[j].w); }
        const float rs = 1.0f / sqrtf(wave_sum(s) * (1.0f / DM) + 1e-6f);
        f32x4* o = (f32x4*)(out + (size_t)m * DM) + lane; float s2 = 0.f;
#pragma unroll
        for (int j = 0; j < 8; ++j) { const f32x4 gv = ((const f32x4*)g)[lane + 64 * j]; const f32x4 r = xv[j] + v[j] * rs * gv; o[64 * j] = r; v[j] = r; s2 += (r.x * r.x + r.y * r.y) + (r.z * r.z + r.w * r.w); }
        if (hnext) {
            const float rs2 = 1.0f / sqrtf(wave_sum(s2) * (1.0f / DM) + 1e-6f);
            u32x2* ho = (u32x2*)(hnext + (size_t)m * DM) + lane;
#pragma unroll
            for (int j = 0; j < 8; ++j) { const f32x4 gv = ((const f32x4*)gnext)[lane + 64 * j]; u32x2 w; w.x = pk2(v[j].x * rs2 * gv.x, v[j].y * rs2 * gv.y); w.y = pk2(v[j].z * rs2 * gv.z, v[j].w * rs2 * gv.w); ho[64 * j] = w; }
        }
    }
}
DI void phase_merge(const bf16* gates, const bf16* proj, bf16* merged, int gtid, int NT) {
    for (int it = gtid; it < T * (DM / 8); it += NT) {
        const int t = it >> 8, d = (it & 255) * 8;
        float acc[8];
#pragma unroll
        for (int e = 0; e < 8; ++e) acc[e] = 0.f;
#pragma unroll
        for (int g = 0; g < 4; ++g) { const u32x4 gv = *(const u32x4*)(gates + (size_t)t * NM + g * DM + d); const u32x4 pv = *(const u32x4*)(proj + ((size_t)g * T + t) * DM + d);
#pragma unroll
            for (int e = 0; e < 4; ++e) { acc[2 * e] += bflo(gv[e]) * bflo(pv[e]); acc[2 * e + 1] += bfhi(gv[e]) * bfhi(pv[e]); } }
        u32x4 o; o.x = pk2(acc[0], acc[1]); o.y = pk2(acc[2], acc[3]); o.z = pk2(acc[4], acc[5]); o.w = pk2(acc[6], acc[7]);
        *(u32x4*)(merged + (size_t)t * DM + d) = o;
    }
}

struct RopeL { unsigned short q[2][2][2]; unsigned short iq[2]; float ik[2]; f32x2 csa, csi; };
DI void rope_load(RopeL& L, const bf16* P, const float* SM, const f32x2* rope, int t, int lane) {
    const int i = lane & 15, i8 = lane & 7;
    L.csa = rope[(unsigned)t * 24 + i]; L.csi = rope[(unsigned)t * 24 + 16 + i8];
#pragma unroll
    for (int r = 0; r < 2; ++r)
#pragma unroll
        for (int w = 0; w < 2; ++w) { const bf16* q = P + (unsigned)t * LDP + (w ? BK_ : BQ) + ((lane + 64 * r) >> 4) * 128 + i; L.q[r][w][0] = q[0]; L.q[r][w][1] = q[16]; }
    { const bf16* q = P + (unsigned)t * LDP + BIQ + (lane >> 3) * 64 + i8; L.iq[0] = q[0]; L.iq[1] = q[8]; }
    { const float* q = SM + (unsigned)t * 512 + IK + i8; L.ik[0] = q[0]; L.ik[1] = q[8]; }
}
DI void rope_finish(const RopeL& L, bf16* P, float* SM, int t, int lane) {
    const int i = lane & 15, i8 = lane & 7;
#pragma unroll
    for (int r = 0; r < 2; ++r)
#pragma unroll
        for (int w = 0; w < 2; ++w) { bf16* q = P + (unsigned)t * LDP + (w ? BK_ : BQ) + ((lane + 64 * r) >> 4) * 128 + i; const float x1 = bf2f(L.q[r][w][0]), x2 = bf2f(L.q[r][w][1]);
            q[0] = f2bf(x1 * L.csa.x - x2 * L.csa.y); q[16] = f2bf(x2 * L.csa.x + x1 * L.csa.y); }
    { bf16* q = P + (unsigned)t * LDP + BIQ + (lane >> 3) * 64 + i8; const float x1 = bf2f(L.iq[0]), x2 = bf2f(L.iq[1]); q[0] = f2bf(x1 * L.csi.x - x2 * L.csi.y); q[8] = f2bf(x2 * L.csi.x + x1 * L.csi.y); }
    if (lane < 8) { float* q = SM + (unsigned)t * 512 + IK + i8; q[0] = L.ik[0] * L.csi.x - L.ik[1] * L.csi.y; q[8] = L.ik[1] * L.csi.x + L.ik[0] * L.csi.y; }
}
struct SguL { u32x4 v[2]; };
DI void sgu_load(SguL& L, const bf16* P, int t, int lane) {
#pragma unroll
    for (int r = 0; r < 2; ++r) L.v[r] = *(const u32x4*)(P + (unsigned)t * LDP + DV + 8 * lane + 512 * r);
}
DI void sgu_finish(const SguL& L, bf16* P, const float* lng, const float* lnb, int t, int lane) {
    bf16* vrow = P + (unsigned)t * LDP + DV;
    float x[16]; float s = 0.f;
#pragma unroll
    for (int r = 0; r < 2; ++r)
#pragma unroll
        for (int e = 0; e < 4; ++e) { x[8 * r + 2 * e] = bflo(L.v[r][e]); x[8 * r + 2 * e + 1] = bfhi(L.v[r][e]); }
#pragma unroll
    for (int e = 0; e < 16; ++e) s += x[e];
    const float mean = wave_sum(s) * (1.0f / 1024.0f); float s2 = 0.f;
#pragma unroll
    for (int e = 0; e < 16; ++e) { x[e] -= mean; s2 += x[e] * x[e]; }
    const float rstd = 1.0f / sqrtf(wave_sum(s2) * (1.0f / 1024.0f) + 1e-5f);
#pragma unroll
    for (int r = 0; r < 2; ++r) { const int c0 = 8 * lane + 512 * r; const f32x4 g0 = *(const f32x4*)(lng + c0), g1 = *(const f32x4*)(lng + c0 + 4), b0 = *(const f32x4*)(lnb + c0), b1 = *(const f32x4*)(lnb + c0 + 4);
        u32x4 o; o.x = pk2(x[8 * r + 0] * rstd * g0.x + b0.x, x[8 * r + 1] * rstd * g0.y + b0.y); o.y = pk2(x[8 * r + 2] * rstd * g0.z + b0.z, x[8 * r + 3] * rstd * g0.w + b0.w);
        o.z = pk2(x[8 * r + 4] * rstd * g1.x + b1.x, x[8 * r + 5] * rstd * g1.y + b1.y); o.w = pk2(x[8 * r + 6] * rstd * g1.z + b1.z, x[8 * r + 7] * rstd * g1.w + b1.w);
        *(u32x4*)(vrow + c0) = o; }
}
DI float quad_sum(float x) {
    x += __builtin_bit_cast(float, __builtin_amdgcn_update_dpp(0, __builtin_bit_cast(int, x), 0xB1, 0xf, 0xf, false));
    x += __builtin_bit_cast(float, __builtin_amdgcn_update_dpp(0, __builtin_bit_cast(int, x), 0x4E, 0xf, 0xf, false));
    return x;
}
struct RwkvL { u32x4 c[3][2], p[3][2]; };
DI void rwkvp_load(RwkvL& L, const bf16* P, int t, int lane) {
    const bool hp = (t & (SEQ - 1)) > 0; const int j = 16 * lane;
    const bf16* pc = P + (unsigned)t * LDP + j; const bf16* pp = hp ? pc - LDP : pc;
#pragma unroll
    for (int w = 0; w < 3; ++w) { const int off = w == 0 ? CR : (w == 1 ? CK : CV);
#pragma unroll
        for (int q = 0; q < 2; ++q) { L.c[w][q] = *(const u32x4*)(pc + off + 8 * q); u32x4 p = *(const u32x4*)(pp + off + 8 * q); if (!hp) { p.x = 0u; p.y = 0u; p.z = 0u; p.w = 0u; } L.p[w][q] = p; } }
}
DI void rwkvp_finish(const RwkvL& L, const Args& a, int l, int t, int lane) {
    bf16* RWr = (bf16*)(a.ws + WS_RW); bf16* RWk = RWr + (size_t)T * 1024; bf16* RWv = RWk + (size_t)T * 1024; bf16* RWkk = RWv + (size_t)T * 1024;
    const float* mu = a.in[8] + l * 4288; const float* kkc = a.in[13] + l * BW;
    const int j = 16 * lane;
    float kl[16]; float ss = 0.f;
#pragma unroll
    for (int w = 0; w < 3; ++w) {
        bf16* dst = (w == 0 ? RWr : (w == 1 ? RWk : RWv)) + (unsigned)t * 1024 + j;
#pragma unroll
        for (int q = 0; q < 2; ++q) { const u32x4 c = L.c[w][q], p = L.p[w][q];
            const f32x4 m0 = *(const f32x4*)(mu + 1024 * w + j + 8 * q), m1 = *(const f32x4*)(mu + 1024 * w + j + 8 * q + 4);
            float x[8];
#pragma unroll
            for (int e = 0; e < 4; ++e) { const float c0 = bflo(c[e]), c1 = bfhi(c[e]), p0 = bflo(p[e]), p1 = bfhi(p[e]); const float ma = e < 2 ? m0[2 * e] : m1[2 * e - 4], mb = e < 2 ? m0[2 * e + 1] : m1[2 * e - 3];
                x[2 * e] = c0 + (p0 - c0) * ma; x[2 * e + 1] = c1 + (p1 - c1) * mb; }
            u32x4 o; o.x = pk2(x[0], x[1]); o.y = pk2(x[2], x[3]); o.z = pk2(x[4], x[5]); o.w = pk2(x[6], x[7]);
            *(u32x4*)(dst + 8 * q) = o;
            if (w == 1) { const f32x4 k0 = *(const f32x4*)(kkc + j + 8 * q), k1 = *(const f32x4*)(kkc + j + 8 * q + 4);
#pragma unroll
                for (int e = 0; e < 8; ++e) { const float kk = x[e] * (e < 4 ? k0[e & 3] : k1[e & 3]); kl[8 * q + e] = kk; ss += kk * kk; } }
        }
    }
    const float rn = 1.0f / sqrtf(quad_sum(ss) + 1e-12f);
    u32x4 o0, o1; o0.x = pk2(kl[0] * rn, kl[1] * rn); o0.y = pk2(kl[2] * rn, kl[3] * rn); o0.z = pk2(kl[4] * rn, kl[5] * rn); o0.w = pk2(kl[6] * rn, kl[7] * rn);
    o1.x = pk2(kl[8] * rn, kl[9] * rn); o1.y = pk2(kl[10] * rn, kl[11] * rn); o1.z = pk2(kl[12] * rn, kl[13] * rn); o1.w = pk2(kl[14] * rn, kl[15] * rn);
    *(u32x4*)(RWkk + (unsigned)t * 1024 + j) = o0; *(u32x4*)(RWkk + (unsigned)t * 1024 + j + 8) = o1;
}
DI void prep_lowrank_unit(const Args& a, int l, int unit, LAS unsigned char* lds, int tid, int lane, int wave) {
    const float* SM = (const float*)(a.ws + WS_SM);
    bf16* RWa = (bf16*)(a.ws + WS_RW) + (size_t)4 * T * 1024; float* RWw = (float*)(a.ws + WS_RW + 6 * RW_ARR);
    const float* mu = a.in[8] + l * 4288;
    const int t0 = unit * 32, s0 = t0 & (SEQ - 1);
    LAS bf16* AH = (LAS bf16*)lds;
    for (int e = tid; e < 32 * 96; e += 512) { const int tok = e / 96, i = e - tok * 96; const int t = t0 + tok; const bool hp = (s0 + tok) > 0;
        const float cw = SM[(unsigned)t * 512 + WLR + i], pw = hp ? SM[(unsigned)(t - 1) * 512 + WLR + i] : 0.f; const float xw = tanhf(cw + (pw - cw) * mu[3072 + i]);
        const float ca = SM[(unsigned)t * 512 + ALR + i], pa = hp ? SM[(unsigned)(t - 1) * 512 + ALR + i] : 0.f; const float xa = ca + (pa - ca) * mu[3168 + i];
        const bf16 hw = f2bf(xw), ha = f2bf(xa);
        AH[(0 * 32 + tok) * 104 + i] = hw; AH[(1 * 32 + tok) * 104 + i] = f2bf(xw - bf2f(hw)); AH[(2 * 32 + tok) * 104 + i] = ha; AH[(3 * 32 + tok) * 104 + i] = f2bf(xa - bf2f(ha)); }
    __syncthreads();
    const int r32 = lane & 31, hh = lane >> 5;
    const bf16* WL = (const bf16*)(a.ws + WS_WLR) + (size_t)l * (2 * 2 * 1024 * 96);
#pragma unroll 1
    for (int c = 0; c < 4; ++c) {
        const int n = 128 * wave + 32 * c + r32;
        f32x16 aw, aa;
#pragma unroll
        for (int r = 0; r < 16; ++r) { aw[r] = 0.f; aa[r] = 0.f; }
        bf16x8 Bf[3][4];
#define LR_LD(slot_, s_) do { _Pragma("unroll") for (int mp_ = 0; mp_ < 4; ++mp_) Bf[slot_][mp_] = *(const bf16x8*)(WL + ((unsigned)(mp_ * 1024 + n)) * 96 + 16 * (s_) + 8 * hh); } while (0)
        LR_LD(0, 0); LR_LD(1, 1);
#pragma unroll
        for (int st = 0; st < 6; ++st) {
            if (st + 2 < 6) LR_LD((st + 2) % 3, st + 2);
            __builtin_amdgcn_sched_barrier(0);
            const bf16x8 Ahw = *(const LAS bf16x8*)(AH + (0 * 32 + r32) * 104 + 16 * st + 8 * hh), Alw = *(const LAS bf16x8*)(AH + (1 * 32 + r32) * 104 + 16 * st + 8 * hh);
            const bf16x8 Aha = *(const LAS bf16x8*)(AH + (2 * 32 + r32) * 104 + 16 * st + 8 * hh), Ala = *(const LAS bf16x8*)(AH + (3 * 32 + r32) * 104 + 16 * st + 8 * hh);
            aw = MFMA32(Ahw, Bf[st % 3][0], aw); aw = MFMA32(Ahw, Bf[st % 3][1], aw); aw = MFMA32(Alw, Bf[st % 3][0], aw);
            aa = MFMA32(Aha, Bf[st % 3][2], aa); aa = MFMA32(Aha, Bf[st % 3][3], aa); aa = MFMA32(Ala, Bf[st % 3][2], aa);
        }
#undef LR_LD
        const float w0 = a.in[9][l * BW + n], a0 = a.in[11][l * BW + n];
#pragma unroll
        for (int r = 0; r < 16; ++r) { const unsigned o = (unsigned)(t0 + crow(r, hh)) * 1024 + n;
            RWw[o] = __expf(-0.606531f * sigmoidf_(w0 + aw[r])); RWa[o] = f2bf(sigmoidf_(a0 + aa[r])); }
    }
    __syncthreads();
}
DI void vt_unit(const Args& a, int unit, LAS unsigned char* lds, int tid) {
    const bf16* P = (const bf16*)(a.ws + WS_P); bf16* VT = (bf16*)(a.ws + WS_VT);
    const int hd = unit & 7, st = (unit >> 3) & 63, b = unit >> 9;
    LAS bf16* tile = (LAS bf16*)lds;
#pragma unroll
    for (int r = 0; r < 2; ++r) { const int ch = tid + 512 * r, s = ch >> 4, c = ch & 15;
        *(LAS u32x4*)(tile + s * 136 + 8 * c) = *(const u32x4*)(P + (unsigned)(b * SEQ + st * 64 + s) * LDP + BV + hd * 128 + 8 * c); }
    __syncthreads();
    { const int d = tid & 127, sq = tid >> 7; unsigned w[8];
#pragma unroll
      for (int i = 0; i < 8; ++i) w[i] = (unsigned)tile[(16 * sq + 2 * i) * 136 + d] | ((unsigned)tile[(16 * sq + 2 * i + 1) * 136 + d] << 16);
      bf16* o = VT + ((unsigned)((b * 8 + hd) * 128 + d)) * SEQ + st * 64 + 16 * sq;
      u32x4 o0, o1; o0.x = w[0]; o0.y = w[1]; o0.z = w[2]; o0.w = w[3]; o1.x = w[4]; o1.y = w[5]; o1.z = w[6]; o1.w = w[7];
      *(u32x4*)o = o0; *(u32x4*)(o + 8) = o1; }
    __syncthreads();
}

typedef short s16x4 __attribute__((ext_vector_type(4)));
DI bf16x8 tr_frag(const LAS unsigned char* p, int rs4) {
    const s16x4 lo = __builtin_bit_cast(s16x4, __builtin_amdgcn_ds_read_tr16_b64_v4i16((LAS s16x4*)p));
    const s16x4 hi = __builtin_bit_cast(s16x4, __builtin_amdgcn_ds_read_tr16_b64_v4i16((LAS s16x4*)(p + rs4)));
    return __builtin_shufflevector(lo, hi, 0, 1, 2, 3, 4, 5, 6, 7);
}
DI void gla_kv_unit(const Args& a, int l, int unit, LAS unsigned char* lds, int tid, int lane, int wave) {
    const bf16* P = (const bf16*)(a.ws + WS_P); const float* SM = (const float*)(a.ws + WS_SM);
    const int hd = unit & 3, c = (unit >> 2) & 63, b = unit >> 8;
    LAS float* la = (LAS float*)lds;
    LAS float* ptot = la + 64 * 128;
    LAS float* glr = ptot + 4 * 128;
    LAS float* wgl = glr + 64 * 16;
    const int k2 = tid & 127, cg = tid >> 7;
    const int t0 = b * SEQ + c * 64;
    u32x4 kr[2]; float wv[4];
#pragma unroll
    for (int r = 0; r < 2; ++r) { const int pc = tid + 512 * r; kr[r] = *(const u32x4*)(P + (unsigned)(t0 + (pc >> 4)) * LDP + AK + hd * 128 + (pc & 15) * 8); }
#pragma unroll
    for (int r = 0; r < 4; ++r) { const int e = tid + 512 * r; wv[r] = a.in[5][(unsigned)(l * 16 * 512 + (e >> 7) * 512 + hd * 128 + (e & 127))]; }
    const float bg = a.in[6][l * 512 + hd * 128 + k2];
    const f32x4 gl = *(const f32x4*)(SM + (unsigned)(t0 + ((tid & 255) >> 2)) * 512 + GLR + (tid & 3) * 4);
    __builtin_amdgcn_sched_barrier(0);
#pragma unroll
    for (int r = 0; r < 4; ++r) wgl[tid + 512 * r] = wv[r];
    if (tid < 256) *(LAS f32x4*)(glr + (tid >> 2) * 16 + (tid & 3) * 4) = gl;
    __syncthreads();
    float pre[16]; float run = 0.f;
    { float wr[16];
#pragma unroll
      for (int q = 0; q < 16; ++q) wr[q] = wgl[q * 128 + k2];
#pragma unroll
      for (int i = 0; i < 16; ++i) { const int tok = cg * 16 + i; float x = bg;
#pragma unroll
          for (int q = 0; q < 4; ++q) { const f32x4 gv = *(const LAS f32x4*)(glr + tok * 16 + 4 * q); x += gv.x * wr[4 * q] + gv.y * wr[4 * q + 1] + gv.z * wr[4 * q + 2] + gv.w * wr[4 * q + 3]; }
          run += logsigmoidf_(x) * (1.0f / 16.0f); pre[i] = run; } }
    ptot[cg * 128 + k2] = run;
    __syncthreads();
    { const float p0 = ptot[k2], p1 = ptot[128 + k2], p2 = ptot[256 + k2], p3 = ptot[384 + k2];
      const float tot = ((p0 + p1) + p2) + p3;
      const float off = cg == 0 ? 0.f : cg == 1 ? p0 : cg == 2 ? p0 + p1 : (p0 + p1) + p2;
      const float base = tot - off;
#pragma unroll
      for (int i = 0; i < 16; ++i) la[(cg * 16 + i) * 128 + k2] = __expf(base - pre[i]);
      if (cg == 0) ((float*)(a.ws + WS_ET))[(unsigned)unit * 128 + k2] = __expf(tot); }
    __syncthreads();
    bf16* KD = (bf16*)(a.ws + WS_KV) + (unsigned)unit * (64 * 128);
#pragma unroll
    for (int r = 0; r < 2; ++r) { const int pc = tid + 512 * r, tok = pc >> 4, kg = pc & 15;
        const f32x4 d0 = *(const LAS f32x4*)(la + tok * 128 + kg * 8), d1 = *(const LAS f32x4*)(la + tok * 128 + kg * 8 + 4);
        u32x4 o; o.x = pk2(bflo(kr[r].x) * d0.x, bfhi(kr[r].x) * d0.y); o.y = pk2(bflo(kr[r].y) * d0.z, bfhi(kr[r].y) * d0.w);
        o.z = pk2(bflo(kr[r].z) * d1.x, bfhi(kr[r].z) * d1.y); o.w = pk2(bflo(kr[r].w) * d1.z, bfhi(kr[r].w) * d1.w);
        *(u32x4*)(KD + pc * 8) = o; }
    __syncthreads();
}
DI void gla_scan_unit(const Args& a, int l, int unit, LAS unsigned char* lds, int tid, int lane, int wave) {
    const bf16* P = (const bf16*)(a.ws + WS_P); bf16* YA = (bf16*)(a.ws + WS_YS);
    const int b = unit >> 2, hd = unit & 3, r32 = lane & 31, hh = lane >> 5;
    LAS float* etl = (LAS float*)lds;
    LAS float* ssq = etl + 64 * 128;
    LAS float* hgl = ssq + 64 * 16;
    LAS bf16* qbuf = (LAS bf16*)(hgl + 256);
    LAS unsigned char* kimg = (LAS unsigned char*)(qbuf + 64 * 132);
    LAS unsigned char* vimg = kimg + 64 * 320;
    { const float* ET = (const float*)(a.ws + WS_ET);
      for (int e = tid; e < 64 * 128; e += 512) { const int c = e >> 7, k = e & 127; etl[e] = ET[(unsigned)(((b * 64 + c) * 4 + hd) * 128 + k)]; }
      if (tid < 256) hgl[tid] = a.in[7][l * 256 + tid]; }
    const int qrow = tid >> 3, qseg = tid & 7;
    const bf16* KDb = (const bf16*)(a.ws + WS_KV) + (unsigned)((b * 64) * 4 + hd) * (64 * 128);
    u32x4 Kn[2], Vn[4], Qn[2]; u32x2 Gt[2][4];
#define GS_LOAD(c_) do { const int cc_ = (c_) < 64 ? (c_) : 63; int tl_ = tid; asm volatile("" : "+v"(tl_)); \
        const bf16* Pc_ = P + (size_t)(b * SEQ + cc_ * 64) * LDP; const bf16* Kc_ = KDb + (size_t)cc_ * (4 * 8192); \
        _Pragma("unroll") for (int r = 0; r < 2; ++r) Kn[r] = *(const u32x4*)(Kc_ + (unsigned)(tl_ * 8 + 4096 * r)); \
        _Pragma("unroll") for (int r = 0; r < 4; ++r) Vn[r] = *(const u32x4*)(Pc_ + (unsigned)(((tl_ >> 5) + 16 * r) * LDP + AV + hd * 256 + (tl_ & 31) * 8)); \
        Qn[0] = *(const u32x4*)(Pc_ + (unsigned)((tl_ >> 3) * LDP + AQ + hd * 128 + 16 * (tl_ & 7))); Qn[1] = *(const u32x4*)(Pc_ + (unsigned)((tl_ >> 3) * LDP + AQ + hd * 128 + 16 * (tl_ & 7) + 8)); } while (0)
#define GS_PUT() do { \
        _Pragma("unroll") for (int r = 0; r < 2; ++r) { const int pc = tid + 512 * r; *(LAS u32x4*)(kimg + (pc >> 4) * 320 + (pc & 15) * 16) = Kn[r]; } \
        _Pragma("unroll") for (int r = 0; r < 4; ++r) { const int pc = tid + 512 * r; *(LAS u32x4*)(vimg + (pc >> 5) * 576 + (pc & 31) * 16) = Vn[r]; } \
        { LAS u32x2* d = (LAS u32x2*)(qbuf + qrow * 132 + 16 * qseg); u32x2 t; t.x = Qn[0].x; t.y = Qn[0].y; d[0] = t; t.x = Qn[0].z; t.y = Qn[0].w; d[1] = t; t.x = Qn[1].x; t.y = Qn[1].y; d[2] = t; t.x = Qn[1].z; t.y = Qn[1].w; d[3] = t; } } while (0)
#define GS_GATE(c_) do { const int cc_ = (c_) < 64 ? (c_) : 63; int tl_ = tid; asm volatile("" : "+v"(tl_)); \
        const bf16* Pc_ = P + (size_t)(b * SEQ + cc_ * 64) * LDP; \
        _Pragma("unroll") for (int ct = 0; ct < 2; ++ct) _Pragma("unroll") for (int g = 0; g < 4; ++g) \
            Gt[ct][g] = *(const u32x2*)(Pc_ + (unsigned)((32 * ct + (tl_ & 31)) * LDP + AG + hd * 256 + 32 * wave + 4 * ((tl_ >> 5) & 1) + 8 * g)); } while (0)
    GS_LOAD(0); GS_GATE(0);
    __builtin_amdgcn_sched_barrier(0);
    GS_PUT();
    GS_LOAD(1);
    f32x16 S[4];
#pragma unroll
    for (int kt = 0; kt < 4; ++kt)
#pragma unroll
        for (int r = 0; r < 16; ++r) S[kt][r] = 0.f;
    const int rhalf = (lane >> 4) & 1, qi = (lane >> 2) & 3, pi = lane & 3;
    const LAS unsigned char* vb = vimg + (8 * hh + qi) * 576 + (32 * wave + 16 * rhalf + 4 * pi) * 2;
    const LAS unsigned char* kb = kimg + (8 * hh + qi) * 320 + (16 * rhalf + 4 * pi) * 2;
    __syncthreads();
#pragma unroll 1
    for (int c = 0; c < 64; ++c) {
        const int t0 = b * SEQ + c * 64;
#pragma unroll
        for (int kt = 0; kt < 4; ++kt) {
#pragma unroll
            for (int g4 = 0; g4 < 4; ++g4) { const f32x4 e = *(const LAS f32x4*)(etl + c * 128 + 32 * kt + 8 * g4 + 4 * hh);
                S[kt][4 * g4] *= e.x; S[kt][4 * g4 + 1] *= e.y; S[kt][4 * g4 + 2] *= e.z; S[kt][4 * g4 + 3] *= e.w; }
#pragma unroll
            for (int st = 0; st < 4; ++st) { const bf16x8 A = tr_frag(kb + 16 * st * 320 + 64 * kt, 4 * 320), Bv = tr_frag(vb + 16 * st * 576, 4 * 576); S[kt] = MFMA32(A, Bv, S[kt]); }
            __builtin_amdgcn_sched_barrier(0); }
        f32x16 O[2];
#pragma unroll
        for (int ct = 0; ct < 2; ++ct) {
#pragma unroll
            for (int r = 0; r < 16; ++r) O[ct][r] = 0.f;
#pragma unroll
            for (int kt = 0; kt < 4; ++kt)
#pragma unroll
                for (int s2 = 0; s2 < 2; ++s2) { const bf16x8 Sf = pack_step(S[kt], s2);
                    const LAS bf16* qp = qbuf + (32 * ct + r32) * 132 + 32 * kt + 16 * s2 + 4 * hh;
                    const bf16x8 Qf = join8(*(const LAS u32x2*)qp, *(const LAS u32x2*)(qp + 8)); O[ct] = MFMA32(Sf, Qf, O[ct]); }
            __builtin_amdgcn_sched_barrier(0);
            float ss = 0.f;
#pragma unroll
            for (int r = 0; r < 16; ++r) { O[ct][r] *= 0.08838834764831845f; ss += O[ct][r] * O[ct][r]; }
            ssq[(32 * ct + r32) * 16 + 2 * wave + hh] = ss;
        }
        __syncthreads();
        GS_PUT();
        GS_LOAD(c + 2);
        __builtin_amdgcn_sched_barrier(0);
#pragma unroll
        for (int ct = 0; ct < 2; ++ct) { const LAS f32x4* sp = (const LAS f32x4*)(ssq + (32 * ct + r32) * 16);
            const f32x4 s0 = sp[0], s1 = sp[1], s2 = sp[2], s3 = sp[3];
            const float tot = ((s0.x + s0.y) + (s0.z + s0.w)) + ((s1.x + s1.y) + (s1.z + s1.w)) + ((s2.x + s2.y) + (s2.z + s2.w)) + ((s3.x + s3.y) + (s3.z + s3.w));
            const float rs = 1.0f / sqrtf(tot * (1.0f / 256.0f) + 1e-6f);
            int tl_ = tid; asm volatile("" : "+v"(tl_));
            bf16* yp = YA + (size_t)t0 * 1024 + (unsigned)((32 * ct + (tl_ & 31)) * 1024 + hd * 256 + 32 * wave + 4 * ((tl_ >> 5) & 1));
#pragma unroll
            for (int g = 0; g < 4; ++g) { const f32x4 hg = *(const LAS f32x4*)(hgl + 32 * wave + 8 * g + 4 * hh); const u32x2 gt = Gt[ct][g];
                u32x2 w; w.x = pk2(O[ct][4 * g] * rs * hg.x * siluf_(bflo(gt.x)), O[ct][4 * g + 1] * rs * hg.y * siluf_(bfhi(gt.x)));
                w.y = pk2(O[ct][4 * g + 2] * rs * hg.z * siluf_(bflo(gt.y)), O[ct][4 * g + 3] * rs * hg.w * siluf_(bfhi(gt.y)));
                *(u32x2*)(yp + 8 * g) = w; } }
        GS_GATE(c + 1);
        __syncthreads();
    }
#undef GS_LOAD
#undef GS_PUT
#undef GS_GATE
}

DI void mm16x8(f32x4& acc0, f32x4& acc1, const LAS float* ap, const LAS float* bp, int bstep) {
    float av[8], bv[8];
#pragma unroll
    for (int j = 0; j < 8; ++j) { av[j] = ap[4 * j]; bv[j] = bp[j * bstep]; }
#pragma unroll
    for (int j = 0; j < 8; j += 2) { acc0 = __builtin_amdgcn_mfma_f32_16x16x4f32(av[j], bv[j], acc0, 0, 0, 0); acc1 = __builtin_amdgcn_mfma_f32_16x16x4f32(av[j + 1], bv[j + 1], acc1, 0, 0, 0); }
}
DI void helper_sync(volatile LAS unsigned* hs, unsigned& epoch, int lane) {
    asm volatile("s_waitcnt lgkmcnt(0)" ::: "memory");
    epoch += 4u;
    if (lane == 0) __hip_atomic_fetch_add((LAS unsigned*)hs, 1u, __ATOMIC_RELAXED, __HIP_MEMORY_SCOPE_WORKGROUP);
    while (*hs < epoch) __builtin_amdgcn_s_sleep(1);
    asm volatile("" ::: "memory");
}
DI void rwkv_unit(const Args& a, int l, int unit, LAS unsigned char* lds, int tid, int lane, int wave) {
    constexpr int TB = 32, NBLK = SEQ / TB, OPS = 256, BUF = TB * OPS;
    const bf16* RWr = (const bf16*)(a.ws + WS_RW); const bf16* RWk = RWr + (size_t)T * 1024; const bf16* RWv = RWk + (size_t)T * 1024; const bf16* RWkk = RWv + (size_t)T * 1024; const bf16* RWa = RWkk + (size_t)T * 1024;
    const float* RWw = (const float*)(a.ws + WS_RW + 6 * RW_ARR);
    bf16* YC = (bf16*)(a.ws + WS_YS) + (size_t)2 * T * 1024;
    const int half = unit & 1, hd = (unit >> 1) & 15, b = unit >> 5;
    LAS float* ob = (LAS float*)lds;
    LAS float* RT = ob + 2 * BUF;
    LAS float* BT = RT + 32 * 65;
    LAS float* KT = BT + 32 * 65;
    LAS float* NRB = KT + 32 * 65;
    LAS float* NRK = NRB + 32 * 33;
    LAS float* UU = NRK + 32 * 33;
    LAS float* S0 = UU + 2 * 1024;
    LAS float* VB = S0 + 2 * 32 * 65;
    LAS bf16* RB = (LAS bf16*)(VB + 3 * 1024);
    volatile LAS unsigned* hs = (volatile LAS unsigned*)(VB + 3 * 1024 + 2048);
    if (tid == 0) *hs = 0u;
    unsigned epoch = 0u;
    const int rg = lane >> 4, ks = lane & 15, row0 = 8 * (wave & 3) + 2 * rg;
    f32x2 S0a = {0.f, 0.f}, S0b = {0.f, 0.f}, S1a = {0.f, 0.f}, S1b = {0.f, 0.f};
    const int hid = wave - 4, htid = tid - 256;
    u32x2 gk[2], gkk[2], ga[2], gr[2], gv[2]; f32x4 gw[2];
    const f32x4 kav = *(const f32x4*)(a.in[14] + l * BW + hd * 64 + (htid & 15) * 4);
#define RW_SLOAD(blk_) do { const int tb_ = b * SEQ + (blk_) * TB; _Pragma("unroll") for (int j_ = 0; j_ < 2; ++j_) { const int pt_ = (htid >> 4) + 16 * j_, p4_ = (htid & 15) * 4; \
            const unsigned g_ = (unsigned)(tb_ + pt_) * 1024 + hd * 64 + p4_; \
            gk[j_] = *(const u32x2*)(RWk + g_); gkk[j_] = *(const u32x2*)(RWkk + g_); ga[j_] = *(const u32x2*)(RWa + g_); gr[j_] = *(const u32x2*)(RWr + g_); gw[j_] = *(const f32x4*)(RWw + g_); \
            gv[j_] = *(const u32x2*)(RWv + (unsigned)(tb_ + pt_) * 1024 + hd * 64 + 32 * half + (p4_ & 31)); } } while (0)
#define RW_SPUT(blk_) do { LAS float* d_ = ob + ((blk_) & 1) * BUF; LAS float* vd_ = VB + ((blk_) % 3) * 1024; _Pragma("unroll") for (int j_ = 0; j_ < 2; ++j_) { const int pt_ = (htid >> 4) + 16 * j_, p4_ = (htid & 15) * 4; \
            LAS float* q_ = d_ + pt_ * OPS + p4_; *(LAS u32x2*)(RB + ((blk_) & 1) * 2048 + pt_ * 64 + p4_) = gr[j_]; \
            f32x4 kk_, aa_, kl_; kk_.x = bflo(gkk[j_].x); kk_.y = bfhi(gkk[j_].x); kk_.z = bflo(gkk[j_].y); kk_.w = bfhi(gkk[j_].y); aa_.x = bflo(ga[j_].x); aa_.y = bfhi(ga[j_].x); aa_.z = bflo(ga[j_].y); aa_.w = bfhi(ga[j_].y); \
            kl_.x = bflo(gk[j_].x); kl_.y = bfhi(gk[j_].x); kl_.z = bflo(gk[j_].y); kl_.w = bfhi(gk[j_].y); \
            *(LAS f32x4*)(q_) = -kk_; *(LAS f32x4*)(q_ + 64) = gw[j_]; *(LAS f32x4*)(q_ + 128) = kk_ * aa_; *(LAS f32x4*)(q_ + 192) = kl_ * (1.0f + (aa_ - 1.0f) * kav); \
            if ((htid & 15) < 8) { f32x4 o_; o_.x = bflo(gv[j_].x); o_.y = bfhi(gv[j_].x); o_.z = bflo(gv[j_].y); o_.w = bfhi(gv[j_].y); *(LAS f32x4*)(vd_ + pt_ * 32 + p4_) = o_; } } } while (0)
    if (wave >= 4) { RW_SLOAD(0); RW_SPUT(0); RW_SLOAD(1); }
    __syncthreads();
#pragma unroll 1
    for (int blk = 0; blk <= NBLK; ++blk) {
        if (wave < 4) {
            if (blk < NBLK) {
                __builtin_amdgcn_s_setprio(2);
                const LAS float* cur = ob + (blk & 1) * BUF; const LAS float* vcur = VB + (blk % 3) * 1024;
                { LAS float* s0 = S0 + (blk & 1) * (32 * 65) + row0 * 65 + 4 * ks;
                  s0[0] = S0a.x; s0[1] = S0a.y; s0[2] = S0b.x; s0[3] = S0b.y; s0[65] = S1a.x; s0[66] = S1a.y; s0[67] = S1b.x; s0[68] = S1b.y; }
                LAS float* ub = UU + (blk & 1) * 1024 + row0;
                f32x4 onk[3], ow[3], oka[3], okk[3]; f32x2 ov[3];
#define RW_LD(slot_, t_) do { const LAS float* o_ = cur + (t_) * OPS + 4 * ks; onk[slot_] = *(const LAS f32x4*)(o_); ow[slot_] = *(const LAS f32x4*)(o_ + 64); oka[slot_] = *(const LAS f32x4*)(o_ + 128); \
        okk[slot_] = *(const LAS f32x4*)(o_ + 192); ov[slot_] = *(const LAS f32x2*)(vcur + (t_) * 32 + row0); } while (0)
                RW_LD(0, 0); RW_LD(1, 1);
#pragma unroll
                for (int t = 0; t < TB; ++t) {
                    if (t + 2 < TB) RW_LD((t + 2) % 3, t + 2);
                    __builtin_amdgcn_sched_barrier(0);
                    const f32x4 nk = onk[t % 3], w = ow[t % 3], ka = oka[t % 3], kk = okk[t % 3]; const f32x2 v2 = ov[t % 3];
                    const f32x2 nka = {nk.x, nk.y}, nkb = {nk.z, nk.w}, wa = {w.x, w.y}, wb = {w.z, w.w}, kaa = {ka.x, ka.y}, kab = {ka.z, ka.w}, kka = {kk.x, kk.y}, kkb = {kk.z, kk.w};
                    f32x2 p0 = S0a * nka + S0b * nkb, p1 = S1a * nka + S1b * nkb;
                    const float sa0 = row16_sum(p0.x + p0.y), sa1 = row16_sum(p1.x + p1.y);
                    const f32x2 sa0v = {sa0, sa0}, sa1v = {sa1, sa1}, v0v = {v2.x, v2.x}, v1v = {v2.y, v2.y};
                    S0a = S0a * wa + sa0v * kaa + v0v * kka; S0b = S0b * wb + sa0v * kab + v0v * kkb;
                    S1a = S1a * wa + sa1v * kaa + v1v * kka; S1b = S1b * wb + sa1v * kab + v1v * kkb;
                    { f32x2 uv = {sa0, sa1}; *(LAS f32x2*)(ub + t * 32) = uv; }
                }
#undef RW_LD
                __builtin_amdgcn_s_setprio(0);
            }
        } else {
            if (blk + 1 < NBLK) RW_SPUT(blk + 1);
            if (blk + 2 < NBLK) RW_SLOAD(blk + 2);
            if (blk >= 1) {
                const int pb = blk - 1, tt = hid >> 1, rr = hid & 1, l15 = lane & 15, l4 = lane >> 4;
                const LAS float* s0 = S0 + (pb & 1) * (32 * 65); const LAS float* uu = UU + (pb & 1) * 1024; const LAS float* vv = VB + (pb % 3) * 1024;
                f32x4 acc = {0.f, 0.f, 0.f, 0.f}, acc1 = {0.f, 0.f, 0.f, 0.f};
                mm16x8(acc, acc1, RT + (16 * tt + l15) * 65 + l4, s0 + (16 * rr + l15) * 65 + l4, 4);
                mm16x8(acc, acc1, RT + (16 * tt + l15) * 65 + 32 + l4, s0 + (16 * rr + l15) * 65 + 32 + l4, 4);
                mm16x8(acc, acc1, NRB + (16 * tt + l15) * 33 + l4, uu + l4 * 32 + 16 * rr + l15, 128);
                mm16x8(acc, acc1, NRK + (16 * tt + l15) * 33 + l4, vv + l4 * 32 + 16 * rr + l15, 128);
                acc = acc + acc1;
                const unsigned yo = (unsigned)(b * SEQ + pb * TB + 16 * tt + 4 * l4) * 1024 + hd * 64 + 32 * half + 16 * rr + l15;
#pragma unroll
                for (int r = 0; r < 4; ++r) YC[yo + (unsigned)r * 1024] = f2bf(acc[r]);
            }
            helper_sync(hs, epoch, lane);
            if (blk < NBLK) {
                { const LAS float* cur = ob + (blk & 1) * BUF; const int k = 16 * hid + (lane & 15), sg = lane >> 4;
                  const LAS bf16* rb = RB + (blk & 1) * 2048 + k;
                  float wl[8], Wc = 1.0f;
#pragma unroll
                  for (int j = 0; j < 8; ++j) { Wc *= cur[(8 * sg + j) * OPS + 64 + k]; wl[j] = Wc; }
                  const float p1 = __shfl(Wc, (lane - 16) & 63), p2 = __shfl(Wc, (lane - 32) & 63), p3 = __shfl(Wc, (lane - 48) & 63);
                  const float pre = (sg >= 1 ? p1 : 1.0f) * (sg >= 2 ? p2 : 1.0f) * (sg >= 3 ? p3 : 1.0f);
#pragma unroll
                  for (int j = 0; j < 8; ++j) { const int t = 8 * sg + j; const float Wt = wl[j] * pre, inv = __builtin_amdgcn_rcpf(Wt);
                      RT[t * 65 + k] = Wt * bf2f(rb[t * 64]); BT[t * 65 + k] = cur[t * OPS + 128 + k] * inv; KT[t * 65 + k] = cur[t * OPS + 192 + k] * inv; } }
                helper_sync(hs, epoch, lane);
                { const int l15 = lane & 15, l4 = lane >> 4;
#pragma unroll 1
                  for (int q = hid; q < 6; q += 4) {
                      const int mk = q >= 3, qq = q - 3 * mk, tt = qq >= 1, ii = qq == 2;
                      const LAS float* src = mk ? KT : BT; LAS float* dst = mk ? NRK : NRB;
                      f32x4 acc = {0.f, 0.f, 0.f, 0.f}, acc1 = {0.f, 0.f, 0.f, 0.f};
                      mm16x8(acc, acc1, RT + (16 * tt + l15) * 65 + l4, src + (16 * ii + l15) * 65 + l4, 4);
                      mm16x8(acc, acc1, RT + (16 * tt + l15) * 65 + 32 + l4, src + (16 * ii + l15) * 65 + 32 + l4, 4);
                      acc = acc + acc1;
#pragma unroll
                      for (int r = 0; r < 4; ++r) { const int t = 16 * tt + 4 * l4 + r, i = 16 * ii + l15; dst[t * 33 + i] = (i <= t) ? acc[r] : 0.f; }
                      if (qq == 0) {
#pragma unroll
                          for (int r = 0; r < 4; ++r) dst[(4 * l4 + r) * 33 + 16 + l15] = 0.f; }
                  } }
            }
        }
        __syncthreads();
    }
#undef RW_SLOAD
#undef RW_SPUT
}
DI void rwkv_post_token(const Args& a, int l, int t, int lane) {
    const bf16* P = (const bf16*)(a.ws + WS_P);
    const bf16* RWr = (const bf16*)(a.ws + WS_RW); const bf16* RWk = RWr + (size_t)T * 1024; const bf16* RWv = RWk + (size_t)T * 1024; const bf16* RWa = RWr + (size_t)4 * T * 1024;
    bf16* YC = (bf16*)(a.ws + WS_YS) + (size_t)2 * T * 1024;
    const float* mu = a.in[8] + l * 4288 + 3264;
    const bool hp = (t & (SEQ - 1)) > 0;
    u32x2 wy[4], wr[4], wk[4], wv[4], wa[4], gc[4], gp[4];
#pragma unroll
    for (int c = 0; c < 4; ++c) { const int j = 256 * c + 4 * lane; const unsigned o = (unsigned)t * 1024 + j;
        wy[c] = *(const u32x2*)(YC + o); wr[c] = *(const u32x2*)(RWr + o); wk[c] = *(const u32x2*)(RWk + o); wv[c] = *(const u32x2*)(RWv + o); wa[c] = *(const u32x2*)(RWa + o);
        gc[c] = *(const u32x2*)(P + (unsigned)t * LDP + CG + j); u32x2 g0 = {0u, 0u}; if (hp) g0 = *(const u32x2*)(P + (unsigned)(t - 1) * LDP + CG + j); gp[c] = g0; }
#pragma unroll
    for (int c = 0; c < 4; ++c) {
        const int j = 256 * c + 4 * lane; const unsigned o = (unsigned)t * 1024 + j;
        const f32x4 ka4 = *(const f32x4*)(a.in[14] + l * 1024 + j); const f32x4 av = {bflo(wa[c].x), bfhi(wa[c].x), bflo(wa[c].y), bfhi(wa[c].y)};
        const f32x4 m4 = *(const f32x4*)(mu + j), rk4 = *(const f32x4*)(a.in[15] + l * 1024 + j), lg4 = *(const f32x4*)(a.in[16] + l * 1024 + j), lb4 = *(const f32x4*)(a.in[17] + l * 1024 + j);
        f32x4 y = {bflo(wy[c].x), bfhi(wy[c].x), bflo(wy[c].y), bfhi(wy[c].y)}, r = {bflo(wr[c].x), bfhi(wr[c].x), bflo(wr[c].y), bfhi(wr[c].y)}, kl = {bflo(wk[c].x), bfhi(wk[c].x), bflo(wk[c].y), bfhi(wk[c].y)}, v = {bflo(wv[c].x), bfhi(wv[c].x), bflo(wv[c].y), bfhi(wv[c].y)};
        const f32x4 k = kl * (1.0f + (av - 1.0f) * ka4);
        f32x4 g = {bflo(gc[c].x), bfhi(gc[c].x), bflo(gc[c].y), bfhi(gc[c].y)}; const f32x4 gq = {bflo(gp[c].x), bfhi(gp[c].x), bflo(gp[c].y), bfhi(gp[c].y)};
        g = g + (gq - g) * m4;
        const float mean = row16_sum((y.x + y.y) + (y.z + y.w)) * (1.0f / 64.0f); const f32x4 d = y - mean;
        const float var = row16_sum((d.x * d.x + d.y * d.y) + (d.z * d.z + d.w * d.w)) * (1.0f / 64.0f); const float rstd = 1.0f / sqrtf(var + 64e-5f);
        const float bs = row16_sum((r.x * k.x * rk4.x + r.y * k.y * rk4.y) + (r.z * k.z * rk4.z + r.w * k.w * rk4.w));
        const f32x4 ov = d * rstd * lg4 + lb4 + bs * v;
        u32x2 w; w.x = pk2(ov.x * siluf_(g.x), ov.y * siluf_(g.y)); w.y = pk2(ov.z * siluf_(g.z), ov.w * siluf_(g.w));
        *(u32x2*)(YC + o) = w;
    }
}

DI void sgu_unit(const Args& a, int l, int unit, LAS unsigned char* lds, int tid, int lane, int wave) {
    const bf16* P = (const bf16*)(a.ws + WS_P); bf16* YD = (bf16*)(a.ws + WS_YS) + (size_t)3 * T * 1024;
    const bf16* wsb = (const bf16*)(a.ws + WS_WSB) + (size_t)l * 8 * 128 * 128;
    const int g = unit & 7, ch = (unit >> 3) & 31, b = unit >> 8;
    const int t0 = b * SEQ + ch * 128, r32 = lane & 31, hh = lane >> 5;
    LAS bf16* vt = (LAS bf16*)lds;
#pragma unroll
    for (int r = 0; r < 4; ++r) { const int cidx = tid + 512 * r, j = cidx >> 4, c = cidx & 15;
        *(LAS u32x4*)(vt + j * 136 + 8 * c) = *(const u32x4*)(P + (unsigned)(t0 + j) * LDP + DV + g * 128 + 8 * c); }
    __syncthreads();
    const int it = wave >> 1, dt0 = (wave & 1) * 2;
    f32x16 acc[2];
#pragma unroll
    for (int x = 0; x < 2; ++x)
#pragma unroll
        for (int r = 0; r < 16; ++r) acc[x][r] = 0.f;
#pragma unroll
    for (int st = 0; st < 8; ++st) {
        const bf16x8 A = *(const bf16x8*)(wsb + ((unsigned)g * 128 + 32 * it + r32) * 128 + 16 * st + 8 * hh);
#pragma unroll
        for (int x = 0; x < 2; ++x) { const int d = 32 * (dt0 + x) + r32; u32x4 w;
#pragma unroll
            for (int e = 0; e < 4; ++e) { const int j = 16 * st + 8 * hh + 2 * e; w[e] = (unsigned)vt[j * 136 + d] | ((unsigned)vt[(j + 1) * 136 + d] << 16); }
            acc[x] = MFMA32(A, __builtin_bit_cast(bf16x8, w), acc[x]); }
    }
    const float* bs = a.in[21] + (size_t)l * 8 * 128 + g * 128;
    unsigned short uu[2][16], gg[2][16]; f32x4 bsv[4];
#pragma unroll
    for (int g4 = 0; g4 < 4; ++g4) bsv[g4] = *(const f32x4*)(bs + 32 * it + 8 * g4 + 4 * hh);
#pragma unroll
    for (int x = 0; x < 2; ++x)
#pragma unroll
        for (int r = 0; r < 16; ++r) { const int t = t0 + 32 * it + crow(r, hh), col = g * 128 + 32 * (dt0 + x) + r32;
            uu[x][r] = P[(unsigned)t * LDP + DU + col]; gg[x][r] = P[(unsigned)t * LDP + DG + col]; }
#pragma unroll
    for (int x = 0; x < 2; ++x)
#pragma unroll
        for (int r = 0; r < 16; ++r) { const int t = t0 + 32 * it + crow(r, hh), col = g * 128 + 32 * (dt0 + x) + r32;
            const float sv = acc[x][r] + bsv[r >> 2][r & 3];
            YD[(unsigned)t * 1024 + col] = f2bf(bf2f(uu[x][r]) * sv * siluf_(bf2f(gg[x][r]))); }
    __syncthreads();
}

DI unsigned f2key(float f) { const unsigned u = __float_as_uint(f); return (u & 0x80000000u) ? ~u : (u | 0x80000000u); }
DI unsigned wave_sum_u32(unsigned x) {
    x += (unsigned)__builtin_amdgcn_update_dpp(0, (int)x, 0x128, 0xf, 0xf, false); x += (unsigned)__builtin_amdgcn_update_dpp(0, (int)x, 0x124, 0xf, 0xf, false);
    x += (unsigned)__builtin_amdgcn_update_dpp(0, (int)x, 0x122, 0xf, 0xf, false); x += (unsigned)__builtin_amdgcn_update_dpp(0, (int)x, 0x121, 0xf, 0xf, false);
    return (unsigned)__builtin_amdgcn_readlane((int)x, 0) + (unsigned)__builtin_amdgcn_readlane((int)x, 16) + (unsigned)__builtin_amdgcn_readlane((int)x, 32) + (unsigned)__builtin_amdgcn_readlane((int)x, 48);
}
DI void dsa_index_unit(const Args& a, int unit, unsigned* fl, LAS unsigned char* lds, int tid, int lane, int wave) {
    const bf16* P = (const bf16*)(a.ws + WS_P); const float* SM = (const float*)(a.ws + WS_SM);
    const int b = unit >> 6, jq = 63 - (unit & 63);
    const int nch = jq + 1, nk = 64 * nch, ntile = 2 * nch, tq0 = b * SEQ + jq * 64;
    float* SCu = (float*)(a.ws + WS_SC) + (size_t)b * (4096 * 2080) + (unsigned)(jq * (jq + 1) / 2) * 4096;
    unsigned long long* BM = (unsigned long long*)(a.ws + WS_BM);
    const int r32 = lane & 31, hh = lane >> 5;
    LAS bf16* iql = (LAS bf16*)lds;
#pragma unroll
    for (int r = 0; r < 8; ++r) { const int cidx = tid + 512 * r, q = cidx >> 6, c = cidx & 63;
        *(LAS u32x4*)(iql + q * 520 + 8 * c) = *(const u32x4*)(P + (unsigned)(tq0 + q) * LDP + BIQ + 8 * c); }
    __syncthreads();
#pragma unroll 1
    for (int kt = wave; kt < ntile; kt += 8) {
        const int ts = b * SEQ + 32 * kt + r32;
        bf16x8 Ak[4];
#pragma unroll
        for (int st = 0; st < 4; ++st) { const float* p = SM + (unsigned)ts * 512 + IK + 16 * st + 8 * hh; Ak[st] = pack8f(*(const f32x4*)p, *(const f32x4*)(p + 4)); }
#pragma unroll 1
        for (int qh = 0; qh < 2; ++qh) {
            const int tq = tq0 + 32 * qh + r32;
            const f32x4 w0 = *(const f32x4*)(SM + (unsigned)tq * 512 + IW), w1 = *(const f32x4*)(SM + (unsigned)tq * 512 + IW + 4);
            f32x16 sc;
#pragma unroll
            for (int r = 0; r < 16; ++r) sc[r] = 0.f;
#pragma unroll
            for (int h8 = 0; h8 < 8; ++h8) { f32x16 acc;
#pragma unroll
                for (int r = 0; r < 16; ++r) acc[r] = 0.f;
#pragma unroll
                for (int st = 0; st < 4; ++st) { const bf16x8 Bq = *(const LAS bf16x8*)(iql + (32 * qh + r32) * 520 + h8 * 64 + 16 * st + 8 * hh); acc = MFMA32(Ak[st], Bq, acc); }
                const float wq = (h8 < 4 ? w0[h8 & 3] : w1[h8 & 3]) * 0.044194173824159216f;
#pragma unroll
                for (int r = 0; r < 16; ++r) sc[r] += wq * fmaxf(acc[r], 0.f); }
#pragma unroll
            for (int g4 = 0; g4 < 4; ++g4) { f32x4 o; o.x = sc[4 * g4]; o.y = sc[4 * g4 + 1]; o.z = sc[4 * g4 + 2]; o.w = sc[4 * g4 + 3];
                *(f32x4*)(SCu + (unsigned)(32 * qh + r32) * nk + 32 * kt + 8 * g4 + 4 * hh) = o; }
        }
    }
    __syncthreads();
    LAS unsigned* keys = (LAS unsigned*)(lds + wave * 16384);
#pragma unroll 1
    for (int qi = wave; qi < 64; qi += 8) {
        const float* row = SCu + (unsigned)qi * nk;
        unsigned long long myword = 0ull;
        if (nch <= 4) { myword = ~0ull; }
        else {
            unsigned key[64];
#pragma unroll
            for (int i = 0; i < 64; ++i) key[i] = __float_as_uint(row[(i < nch ? 64 * i : 0) + lane]);
            asm volatile("" ::: "memory");
#pragma unroll
            for (int i = 0; i < 64; ++i) key[i] = i < nch ? f2key(__uint_as_float(key[i])) : 0u;
            unsigned tau = 0u; int cnt_ge = 0;
#pragma unroll 1
            for (int bit = 31; bit >= 0; --bit) {
                const unsigned cand = tau | (1u << bit); unsigned cl = 0u;
#define CNT8(i0) asm volatile("v_cmp_ge_u32_e64 s[80:81], %1, %9\n\tv_cmp_ge_u32_e64 s[82:83], %2, %9\n\tv_cmp_ge_u32_e64 s[84:85], %3, %9\n\tv_cmp_ge_u32_e64 s[86:87], %4, %9\n\t" \
                     "v_cmp_ge_u32_e64 s[88:89], %5, %9\n\tv_cmp_ge_u32_e64 s[90:91], %6, %9\n\tv_cmp_ge_u32_e64 s[92:93], %7, %9\n\tv_cmp_ge_u32_e64 s[94:95], %8, %9\n\t" \
                     "v_addc_co_u32_e64 %0, s[96:97], 0, %0, s[80:81]\n\tv_addc_co_u32_e64 %0, s[96:97], 0, %0, s[82:83]\n\tv_addc_co_u32_e64 %0, s[96:97], 0, %0, s[84:85]\n\tv_addc_co_u32_e64 %0, s[96:97], 0, %0, s[86:87]\n\t" \
                     "v_addc_co_u32_e64 %0, s[96:97], 0, %0, s[88:89]\n\tv_addc_co_u32_e64 %0, s[96:97], 0, %0, s[90:91]\n\tv_addc_co_u32_e64 %0, s[96:97], 0, %0, s[92:93]\n\tv_addc_co_u32_e64 %0, s[96:97], 0, %0, s[94:95]" \
                     : "+v"(cl) : "v"(key[i0]), "v"(key[i0 + 1]), "v"(key[i0 + 2]), "v"(key[i0 + 3]), "v"(key[i0 + 4]), "v"(key[i0 + 5]), "v"(key[i0 + 6]), "v"(key[i0 + 7]), "v"(cand) \
                     : "s80", "s81", "s82", "s83", "s84", "s85", "s86", "s87", "s88", "s89", "s90", "s91", "s92", "s93", "s94", "s95", "s96", "s97")
                CNT8(0);
                if (nch > 8) { CNT8(8); }
                if (nch > 16) { CNT8(16); CNT8(24); }
                if (nch > 32) { CNT8(32); CNT8(40); }
                if (nch > 48) { CNT8(48); CNT8(56); }
#undef CNT8
                const int c = (int)wave_sum_u32(cl);
                if (c >= 256) { tau = cand; cnt_ge = c; if (c == 256) break; }
            }
            if (cnt_ge == 256) {
#pragma unroll
                for (int i = 0; i < 64; ++i) { const unsigned long long m = __ballot(key[i] >= tau); myword = (lane == i) ? m : myword; }
            } else {
#pragma unroll
                for (int i = 0; i < 64; ++i) keys[i * 64 + lane] = key[i];
                int n_gt = 0;
#pragma unroll 1
                for (int i = 0; i < nch; ++i) n_gt += __builtin_popcountll(__ballot(keys[i * 64 + lane] > tau));
                int quota = 256 - n_gt;
#pragma unroll 1
                for (int i = 0; i < nch; ++i) { const unsigned kv = keys[i * 64 + lane]; const unsigned long long m_gt = __ballot(kv > tau); unsigned long long m_eq = __ballot(kv == tau), take = 0ull;
                    const int ne = __builtin_popcountll(m_eq);
                    if (ne <= quota) { take = m_eq; quota -= ne; } else { while (quota > 0) { const unsigned long long low = m_eq & (0ull - m_eq); take |= low; m_eq ^= low; --quota; } }
                    myword = (lane == i) ? (m_gt | take) : myword; }
            }
        }
        if (lane < nch) BM[(unsigned)(tq0 + qi) * 64 + lane] = myword;
    }
    asm volatile("s_waitcnt vmcnt(0)" ::: "memory");
    __syncthreads();
    if (tid == 0) { __builtin_amdgcn_fence(__ATOMIC_RELEASE, "agent"); asm volatile("s_waitcnt vmcnt(0)" ::: "memory"); (void)xb_add(fl + 16 * (b * 16 + (jq >> 2)), 1u); }
}

DI void dsa_attn_unit(const Args& a, int unit, unsigned* fl, LAS unsigned char* lds, int tid, int lane, int wave) {
    const bf16* P = (const bf16*)(a.ws + WS_P); const bf16* VT = (const bf16*)(a.ws + WS_VT); const unsigned* BM32 = (const unsigned*)(a.ws + WS_BM);
    bf16* YB = (bf16*)(a.ws + WS_YS) + (size_t)T * 1024;
    const int qg = 15 - (unit >> 5), bh = unit & 31, b = bh >> 3, hd = bh & 7;
    if (tid == 0) { unsigned* f = fl + 16 * (b * 16 + qg); unsigned sp = 0; while (xb_ld(f) < 4u) { __builtin_amdgcn_s_sleep(2); if (++sp > (1u << 22)) break; } __builtin_amdgcn_fence(__ATOMIC_ACQUIRE, "agent"); }
    __syncthreads();
    const int q0 = 256 * qg + 32 * wave, cw = 4 * qg + (wave >> 1), nkt = 4 * qg + 4;
    const int r32 = lane & 31, hh = lane >> 5;
    const int tq = b * SEQ + q0 + r32;
    LAS bf16* kbuf = (LAS bf16*)lds;
    LAS bf16* vbuf = kbuf + 2 * 64 * 136;
    const int krow = tid >> 3, kseg = (tid & 7) * 16, vrow = tid >> 2, vseg = (tid & 3) * 16;
    const bf16* ksrc = P + (unsigned)(b * SEQ + krow) * LDP + BK_ + hd * 128 + kseg;
    const bf16* vsrc = VT + (unsigned)((b * 8 + hd) * 128 + vrow) * SEQ + vseg;
    u32x4 kn[2], vn[2];
    kn[0] = *(const u32x4*)ksrc; kn[1] = *(const u32x4*)(ksrc + 8); vn[0] = *(const u32x4*)vsrc; vn[1] = *(const u32x4*)(vsrc + 8);
    bf16x8 Bq[8];
#pragma unroll
    for (int st = 0; st < 8; ++st) Bq[st] = *(const bf16x8*)(P + (unsigned)tq * LDP + BQ + hd * 128 + 16 * st + 8 * hh);
    f32x16 O[4];
#pragma unroll
    for (int dt = 0; dt < 4; ++dt)
#pragma unroll
        for (int r = 0; r < 16; ++r) O[dt][r] = 0.f;
    float m = -1e30f, lsum = 0.f;
    const float sc2 = 0.08838834764831845f * 1.4426950408889634f;
#define ATT_PUT(buf_) do { LAS bf16* kd_ = kbuf + (buf_) * (64 * 136) + krow * 136 + kseg; *(LAS u32x4*)kd_ = kn[0]; *(LAS u32x4*)(kd_ + 8) = kn[1]; \
        LAS u32x2* vd_ = (LAS u32x2*)(vbuf + (buf_) * (128 * 68) + vrow * 68 + vseg); u32x2 t_; t_.x = vn[0].x; t_.y = vn[0].y; vd_[0] = t_; t_.x = vn[0].z; t_.y = vn[0].w; vd_[1] = t_; \
        t_.x = vn[1].x; t_.y = vn[1].y; vd_[2] = t_; t_.x = vn[1].z; t_.y = vn[1].w; vd_[3] = t_; } while (0)
    ATT_PUT(0);
    __syncthreads();
#pragma unroll 1
    for (int kt = 0; kt < nkt; ++kt) {
        { const int kn_i = kt + 1 < nkt ? kt + 1 : kt;
          const bf16* kp = ksrc + (unsigned)(kn_i * 64) * LDP; kn[0] = *(const u32x4*)kp; kn[1] = *(const u32x4*)(kp + 8);
          const bf16* vp = vsrc + kn_i * 64; vn[0] = *(const u32x4*)vp; vn[1] = *(const u32x4*)(vp + 8); }
        if (kt <= cw) {
            const LAS bf16* kb = kbuf + (kt & 1) * (64 * 136); const LAS bf16* vb = vbuf + (kt & 1) * (128 * 68);
            f32x16 s[2];
#pragma unroll
            for (int th = 0; th < 2; ++th) {
#pragma unroll
                for (int r = 0; r < 16; ++r) s[th][r] = 0.f;
#pragma unroll
                for (int st = 0; st < 8; ++st) { const bf16x8 A = *(const LAS bf16x8*)(kb + (32 * th + r32) * 136 + 16 * st + 8 * hh); s[th] = MFMA32(A, Bq[st], s[th]); }
            }
            const u32x2 mw = *(const u32x2*)(BM32 + (unsigned)tq * 128 + 2 * kt);
            const unsigned mlo = mw.x >> (4 * hh), mhi = mw.y >> (4 * hh);
            float tmax = -1e30f;
#pragma unroll
            for (int th = 0; th < 2; ++th)
#pragma unroll
                for (int r = 0; r < 16; ++r) tmax = fmaxf(tmax, s[th][r]);
            tmax = fmaxf(tmax, __shfl_xor(tmax, 32)) * sc2;
            const float mn = fmaxf(m, tmax);
            if (__any(mn != m)) {
                const float alpha = __builtin_amdgcn_exp2f(m - mn); lsum *= alpha;
#pragma unroll
                for (int dt = 0; dt < 4; ++dt)
#pragma unroll
                    for (int r = 0; r < 16; ++r) O[dt][r] *= alpha;
            }
            m = mn;
            float ps = 0.f;
#pragma unroll
            for (int th = 0; th < 2; ++th)
#pragma unroll
                for (int r = 0; r < 16; ++r) { const float p = __builtin_amdgcn_exp2f(s[th][r] * sc2 - mn);
                    const int sel = __builtin_amdgcn_sbfe((int)(th ? mhi : mlo), (r & 3) + 8 * (r >> 2), 1);
                    const float pm = __uint_as_float(__float_as_uint(p) & (unsigned)sel); s[th][r] = pm; ps += pm; }
            lsum += ps;
#pragma unroll
            for (int th = 0; th < 2; ++th)
#pragma unroll
                for (int ss = 0; ss < 2; ++ss) { const bf16x8 Bp = pack_step(s[th], ss);
#pragma unroll
                    for (int dt = 0; dt < 4; ++dt) { const LAS bf16* vp = vb + (32 * dt + r32) * 68 + 32 * th + 16 * ss + 4 * hh;
                        const bf16x8 A = join8(*(const LAS u32x2*)vp, *(const LAS u32x2*)(vp + 8)); O[dt] = MFMA32(A, Bp, O[dt]); } }
        }
        ATT_PUT((kt + 1) & 1);
        __syncthreads();
    }
#undef ATT_PUT
    lsum += __shfl_xor(lsum, 32);
    const float inv = 1.0f / lsum;
    u32x2 gwv[4][4];
#pragma unroll
    for (int dt = 0; dt < 4; ++dt)
#pragma unroll
        for (int g4 = 0; g4 < 4; ++g4) gwv[dt][g4] = *(const u32x2*)(P + (unsigned)tq * LDP + BG + hd * 128 + 32 * dt + 8 * g4 + 4 * hh);
#pragma unroll
    for (int dt = 0; dt < 4; ++dt)
#pragma unroll
        for (int g4 = 0; g4 < 4; ++g4) { const int col = hd * 128 + 32 * dt + 8 * g4 + 4 * hh; const u32x2 gw = gwv[dt][g4];
            u32x2 w; w.x = pk2(O[dt][4 * g4] * inv * siluf_(bflo(gw.x)), O[dt][4 * g4 + 1] * inv * siluf_(bfhi(gw.x))); w.y = pk2(O[dt][4 * g4 + 2] * inv * siluf_(bflo(gw.y)), O[dt][4 * g4 + 3] * inv * siluf_(bfhi(gw.y)));
            *(u32x2*)(YB + (unsigned)tq * 1024 + col) = w; }
}

DI int queue_next(unsigned* head, volatile LAS unsigned* slot, int tid) {
    __syncthreads();
    if (tid == 0) *slot = __hip_atomic_fetch_add(head, 1u, __ATOMIC_RELAXED, __HIP_MEMORY_SCOPE_AGENT);
    __syncthreads();
    return (int)*slot;
}

template <unsigned PMASK> DI void fwd_body(const Args& a) {
    extern __shared__ __attribute__((aligned(16))) unsigned char lds_raw[];
    LAS unsigned char* lds = (LAS unsigned char*)lds_raw;
    volatile LAS unsigned* MISC = (volatile LAS unsigned*)(lds + MISC_OFF);
    const int tid = threadIdx.x, lane = tid & 63, wave = __builtin_amdgcn_readfirstlane(tid >> 6), bid = blockIdx.x, G = gridDim.x;
    unsigned* ctl = (unsigned*)(a.ws + WS_CTL);
    if (tid < 64) MISC[tid] = 0u;
    __syncthreads();
    const bool one_launch = (a.ph_hi - a.ph_lo) > 1;
    XcdBarrier bar; bar.bar = ctl + CW_BAR; bar.x = 0; bar.st = nullptr;
    if (one_launch) bar = xcd_barrier_post(ctl + CW_BAR, MISC + 8);
    const int lo = a.ph_lo, hi = a.ph_hi;
#define IN0 ((PMASK & 1u) && lo <= 0 && 0 < hi)
#define INL(j) (((PMASK >> ((j) + 1)) & 1u) && lo <= pb + (j) && pb + (j) < hi)
#ifndef REPB
#define REPB 1
#endif
#define SEAM(k) do { if (lo <= (k) && (k) + 1 < hi) for (int rb_ = 0; rb_ < REPB; ++rb_) xcd_barrier(bar); } while (0)
    const int NGW = G * 8;
#ifndef REPG
#define REPG 1
#endif
#ifndef REPG1
#define REPG1 REPG
#endif
#ifndef GP_ALIGN
#define GP_ALIGN true
#endif
#ifndef GP_SP2
#define GP_SP2 true
#endif
#ifndef REPT
#define REPT 1
#endif
#ifndef REPP
#define REPP 1
#endif
#define FRESH int tid_ = threadIdx.x; asm volatile("" : "+v"(tid_)); const int lane_ = tid_ & 63, wave_ = __builtin_amdgcn_readfirstlane(tid_ >> 6), gw_ = bid * 8 + wave_; (void)lane_; (void)gw_;

#ifndef REPP_SEL
#define REPP_SEL 15
#endif
    if (IN0) { for (int rp_ = 0; rp_ < REPP; ++rp_) { { FRESH phase_prologue(a, lds, tid_, lane_, wave_, bid, G, rp_ == 0 ? 15 : REPP_SEL); } if (rp_ + 1 < REPP) xcd_barrier(bar); }
               { FRESH phase_prenorm(a.in[0], a.in[2], (bf16*)(a.ws + WS_H), gw_, NGW, lane_); }
               SEAM(0); }

#pragma unroll 1
    for (int l = 0; l < 2; ++l) {
        const int pb = 1 + 10 * l;
        const float* xin = l == 0 ? a.in[0] : a.out;
        if (INL(1)) {
            pg8::Gemm g{(const pg8::bf16_t*)(a.ws + WS_H), (const pg8::bf16_t*)(a.ws + WS_WT1) + (size_t)l * N1 * DM, T, N1, DM, 0, 0};
            pg8::StaticOrder S; S.init(T, N1, G, bid);
            Epi<0> E{a.ws + WS_P, (float*)(a.ws + WS_SM)};
            for (int rg_ = 0; rg_ < REPG1; ++rg_) { pg8::gemm_phase2<Epi<0>, pg8::StaticOrder, GP_ALIGN, GP_SP2>(lds, g, S, E); if (rg_ + 1 < REPG1) xcd_barrier(bar); }
            SEAM(pb + 1);
        }
        if (INL(2)) {
            { FRESH bf16* Pp = (bf16*)(a.ws + WS_P); float* SMp = (float*)(a.ws + WS_SM);
              for (int t = gw_; t < T; t += NGW) { RopeL Lr; SguL Ls; RwkvL Lw;
                  rope_load(Lr, Pp, SMp, (const f32x2*)(a.ws + WS_ROPE), t, lane_); sgu_load(Ls, Pp, t, lane_); rwkvp_load(Lw, Pp, t, lane_);
                  rope_finish(Lr, Pp, SMp, t, lane_); rwkvp_finish(Lw, a, l, t, lane_); sgu_finish(Ls, Pp, a.in[18] + l * BW, a.in[19] + l * BW, t, lane_); } }
#ifdef REPW
            for (int rw_ = 0; rw_ < REPW; ++rw_) {
              FRESH bf16* Pp = (bf16*)(a.ws + WS_P); float* SMp = (float*)(a.ws + WS_SM); bf16* Pd = (bf16*)(a.ws + WS_YS); float* SMd = (float*)(a.ws + WS_BM); Args a2 = a; a2.ws = a.ws + (WS_SC - WS_RW);
              for (int t = gw_; t < T; t += NGW) { RopeL Lr; SguL Ls; RwkvL Lw; const int td = t & 4095;
                  rope_load(Lr, Pp, SMp, (const f32x2*)(a.ws + WS_ROPE), t, lane_); sgu_load(Ls, Pp, t, lane_); rwkvp_load(Lw, Pp, t, lane_);
                  rope_finish(Lr, Pd, SMd, td, lane_); rwkvp_finish(Lw, a2, l, td, lane_); sgu_finish(Ls, Pd, a.in[18] + l * BW, a.in[19] + l * BW, td, lane_); } }
#endif
            { FRESH for (int u = bid; u < T / 32; u += G) prep_lowrank_unit(a, l, u, lds, tid_, lane_, wave_); }
            for (int rt_ = 0; rt_ < REPT; ++rt_) {
#ifndef REPT_SEL
#define REPT_SEL 3
#endif
            if (rt_ == 0 || (REPT_SEL & 1)) { FRESH for (int u = bid; u < 2048; u += G) vt_unit(a, u, lds, tid_); }
            if (rt_ == 0 || (REPT_SEL & 2)) { FRESH for (int u = bid; u < 1024; u += G) gla_kv_unit(a, l, u, lds, tid_, lane_, wave_); }
            if (rt_ + 1 < REPT) xcd_barrier(bar); }
            SEAM(pb + 2);
        }
        if (INL(3)) {
#ifndef REP3
#define REP3 1
#endif
#pragma unroll 1
          for (int rep = 0; rep < REP3; ++rep) {
            if (PMASK & (1u << 11)) { FRESH unsigned* head = ctl + CW_Q + 64 * (8 * l + 0 + 16 * rep); for (;;) { const int u = queue_next(head, MISC + 4, tid_); if (u >= 128) break; rwkv_unit(a, l, u, lds, tid_, lane_, wave_); } }
            if (PMASK & (1u << 12)) { FRESH unsigned* head = ctl + CW_Q + 64 * (8 * l + 1 + 16 * rep); for (;;) { const int u = queue_next(head, MISC + 4, tid_); if (u >= 16) break; gla_scan_unit(a, l, u, lds, tid_, lane_, wave_); } }
            if (PMASK & (1u << 13)) { FRESH unsigned* head = ctl + CW_Q + 64 * (8 * l + 2 + 16 * rep); for (;;) { const int u = queue_next(head, MISC + 4, tid_); if (u >= 256) break; dsa_index_unit(a, u, ctl + CW_F + 1024 * l, lds, tid_, lane_, wave_); } }
            if (PMASK & (1u << 14)) { FRESH unsigned* head = ctl + CW_Q + 64 * (8 * l + 3 + 16 * rep); for (;;) { const int u = queue_next(head, MISC + 4, tid_); if (u >= 1024) break; sgu_unit(a, l, u, lds, tid_, lane_, wave_); } }
            if (PMASK & (1u << 5)) { FRESH unsigned* head = ctl + CW_Q + 64 * (8 * l + 4 + 16 * rep); for (;;) { const int u = queue_next(head, MISC + 4, tid_); if (u >= 512) break; dsa_attn_unit(a, u, ctl + CW_F + 1024 * l, lds, tid_, lane_, wave_); } }
            if (rep + 1 < REP3) xcd_barrier(bar);
          }
            SEAM(pb + 3);
#ifdef EXTRA
            {
                FRESH unsigned* head = ctl + CW_Q + 64 * (8 * l + 48 + EXTRA);
                if (EXTRA == 0) for (;;) { const int u = queue_next(head, MISC + 4, tid_); if (u >= 128) break; rwkv_unit(a, l, u, lds, tid_, lane_, wave_); }
                if (EXTRA == 1) for (;;) { const int u = queue_next(head, MISC + 4, tid_); if (u >= 16) break; gla_scan_unit(a, l, u, lds, tid_, lane_, wave_); }
                if (EXTRA == 2) for (;;) { const int u = queue_next(head, MISC + 4, tid_); if (u >= 256) break; dsa_index_unit(a, u, ctl + CW_F + 1024 * l, lds, tid_, lane_, wave_); }
                if (EXTRA == 3) for (;;) { const int u = queue_next(head, MISC + 4, tid_); if (u >= 1024) break; sgu_unit(a, l, u, lds, tid_, lane_, wave_); }
                xcd_barrier(bar);
            }
#endif
        }
        if (INL(4)) {
            { FRESH for (int t = gw_; t < T; t += NGW) { rwkv_post_token(a, l, t, lane_); } }
            SEAM(pb + 4);
        }
        if (INL(5)) {
            pg8::Gemm g{(const pg8::bf16_t*)(a.ws + WS_YS), (const pg8::bf16_t*)(a.ws + WS_WTP) + ((size_t)l << 23), T, 4 * DM, BW, 8, (size_t)T * BW * 2};
            pg8::StaticOrder S; S.init(T, 4 * DM, G, bid);
            Epi<1> E{a.ws + WS_P, nullptr};
            for (int rg_ = 0; rg_ < REPG; ++rg_) { pg8::gemm_phase2<Epi<1>, pg8::StaticOrder, GP_ALIGN, GP_SP2>(lds, g, S, E); if (rg_ + 1 < REPG) xcd_barrier(bar); }
            SEAM(pb + 5);
        }
        if (INL(6)) {
            pg8::Gemm g{(const pg8::bf16_t*)(a.ws + WS_H), (const pg8::bf16_t*)(a.ws + WS_WTM) + (size_t)l * NM * DM, T, NM, DM, 0, 0};
            pg8::StaticOrder S; S.init(T, NM, G, bid);
            Epi<2> E{a.ws + WS_RW, (float*)(a.ws + WS_P)};
            for (int rg_ = 0; rg_ < REPG; ++rg_) { pg8::gemm_phase2<Epi<2>, pg8::StaticOrder, GP_ALIGN, GP_SP2>(lds, g, S, E); if (rg_ + 1 < REPG) xcd_barrier(bar); }
            SEAM(pb + 6);
        }
        if (INL(8)) {
            pg8::Gemm g{(const pg8::bf16_t*)(a.ws + WS_RW), (const pg8::bf16_t*)(a.ws + WS_WTO) + ((size_t)l << 22), T, DM, DM, 0, 0};
            pg8::StaticOrder S; S.init(T, DM, G, bid);
            Epi<3> E{a.ws + WS_SC, nullptr};
            for (int rg_ = 0; rg_ < REPG; ++rg_) { pg8::gemm_phase2<Epi<3>, pg8::StaticOrder, GP_ALIGN, GP_SP2>(lds, g, S, E); if (rg_ + 1 < REPG) xcd_barrier(bar); }
            SEAM(pb + 8);
        }
        if (INL(9)) { FRESH phase_postnorm(xin, (const float*)(a.ws + WS_SC), a.in[3] + l * DM, a.out, a.in[2] + DM, l == 0 ? (bf16*)(a.ws + WS_H) : (bf16*)nullptr, gw_, NGW, lane_); SEAM(pb + 9); }
    }
#undef IN0
#undef INL
#undef SEAM
}

#if defined(ONE_LAUNCH) || defined(ANALYZE)
__global__ void __launch_bounds__(512, 2) fwd(Args a) { fwd_body<0x7fffu>(a); }
#endif
#if !defined(ONE_LAUNCH)
__global__ void __launch_bounds__(512, 2) fwd_p0(Args a) { fwd_body<1u << 0>(a); }
__global__ void __launch_bounds__(512, 2) fwd_p1(Args a) { fwd_body<1u << 1>(a); }
__global__ void __launch_bounds__(512, 2) fwd_p2(Args a) { fwd_body<1u << 2>(a); }
__global__ void __launch_bounds__(512, 2) fwd_p3(Args a) { fwd_body<1u << 3>(a); }
__global__ void __launch_bounds__(512, 2) fwd_p4a(Args a) { fwd_body<(1u << 4) | (1u << 11)>(a); }
__global__ void __launch_bounds__(512, 2) fwd_p4b(Args a) { fwd_body<(1u << 4) | (1u << 12)>(a); }
__global__ void __launch_bounds__(512, 2) fwd_p4c(Args a) { fwd_body<(1u << 4) | (1u << 13)>(a); }
__global__ void __launch_bounds__(512, 2) fwd_p4d(Args a) { fwd_body<(1u << 4) | (1u << 14)>(a); }
__global__ void __launch_bounds__(512, 2) fwd_p5(Args a) { fwd_body<1u << 5>(a); }
__global__ void __launch_bounds__(512, 2) fwd_p6(Args a) { fwd_body<1u << 6>(a); }
__global__ void __launch_bounds__(512, 2) fwd_p7(Args a) { fwd_body<1u << 7>(a); }
__global__ void __launch_bounds__(512, 2) fwd_p8(Args a) { fwd_body<1u << 8>(a); }
__global__ void __launch_bounds__(512, 2) fwd_p9(Args a) { fwd_body<1u << 9>(a); }
__global__ void __launch_bounds__(512, 2) fwd_p10(Args a) { fwd_body<1u << 10>(a); }
#endif
#ifdef COMBO
#include "combo.inc"
#endif
typedef void (*kern_t)(Args);
extern "C" void kernel_launch(void* const* d_in, const int* in_sizes, int n_in, void* d_out, int out_size, void* d_ws, size_t ws_size, hipStream_t stream) {
    static int grid = 0;
#if defined(ONE_LAUNCH)
    static const kern_t kerns[1] = {fwd};
    constexpr int NK = 1;
#else
    static const kern_t kerns[14] = {fwd_p0, fwd_p1, fwd_p2, fwd_p3, fwd_p4a, fwd_p4b, fwd_p4c, fwd_p4d, fwd_p5, fwd_p6, fwd_p7, fwd_p8, fwd_p9, fwd_p10};
    constexpr int NK = 14;
#endif
    if (grid == 0) {
        if (n_in != 24 || out_size != T * DM || ws_size < WS_END) { fprintf(stderr, "kernel_launch: unexpected shapes (n_in %d out %d ws %zu, need %zu)\n", n_in, out_size, ws_size, (size_t)WS_END); grid = -1; return; }
        int dev = 0, cus = 0, per_cu = 0;
        if (hipGetDevice(&dev) != hipSuccess || hipDeviceGetAttribute(&cus, hipDeviceAttributeMultiprocessorCount, dev) != hipSuccess) { grid = -1; return; }
        for (int k = 0; k < NK; ++k)
            if (hipFuncSetAttribute((const void*)kerns[k], hipFuncAttributeMaxDynamicSharedMemorySize, LDS_BYTES) != hipSuccess) { fprintf(stderr, "kernel_launch: hipFuncSetAttribute failed\n"); grid = -1; return; }
        if (hipOccupancyMaxActiveBlocksPerMultiprocessor(&per_cu, (const void*)kerns[0], 512, LDS_BYTES) != hipSuccess || per_cu < 1) { fprintf(stderr, "kernel_launch: occupancy query says %d\n", per_cu); }
        (void)hipGetLastError();
        grid = cus;
    }
    if (grid < 0) return;
    (void)hipMemsetAsync((char*)d_ws + WS_CTL, 0, CTL_BYTES, stream);
    Args a{};
    for (int i = 0; i < 24; ++i) a.in[i] = (const float*)d_in[i];
    a.pos = (const int*)d_in[1]; a.out = (float*)d_out; a.ws = (unsigned char*)d_ws;
#if defined(ONE_LAUNCH)
    a.ph_lo = 0; a.ph_hi = NPHASE; hipLaunchKernelGGL(fwd, dim3(grid), dim3(512), LDS_BYTES, stream, a);
#else
    a.ph_lo = 0; a.ph_hi = 1; hipLaunchKernelGGL(fwd_p0, dim3(grid), dim3(512), LDS_BYTES, stream, a);
    for (int l = 0; l < 2; ++l) {
        static const int phase_of[13] = {0, 1, 2, 3, 3, 3, 3, 4, 5, 6, 7, 8, 9};
        for (int k = 0; k < 13; ++k) { a.ph_lo = 1 + 10 * l + phase_of[k]; a.ph_hi = a.ph_lo + 1; hipLaunchKernelGGL(kerns[1 + k], dim3(grid), dim3(512), LDS_BYTES, stream, a); }
    }
#endif
}
```

```cpp
#include <hip/hip_runtime.h>
#include <cstdio>
#include <cstdint>
#define ONE_LAUNCH 1


#ifndef PG8_WGM
#define PG8_WGM 8
#endif
namespace pg8 {
#define PG8_LAS __attribute__((address_space(3)))
typedef unsigned short bf16_t;
typedef short bf16x8 __attribute__((ext_vector_type(8)));
typedef float f32x4 __attribute__((ext_vector_type(4)));
typedef unsigned u32x4 __attribute__((ext_vector_type(4)));
constexpr int BM = 256, BK = 64, HALF = 128, HTB = HALF * BK * 2  , STAGE_BYTES = 8 * HTB, NXCD = 8, WGM = PG8_WGM;

__host__ __device__ __forceinline__ int lds_byte(int r, int c) { const int st = (r >> 4) * 2 + (c >> 5), rr = r & 15, cc = c & 31, ob = rr * 64 + cc * 2; return st * 1024 + (ob ^ (((ob >> 9) & 1) << 5)); }
__host__ __device__ __forceinline__ void stage_rc(int b, int& R, int& C) { const int st = b / 1024, sb = b % 1024, swz = sb ^ (((sb >> 9) & 1) << 5); R = (st >> 1) * 16 + swz / 64; C = (st & 1) * 32 + (swz % 64) / 2; }
__host__ __device__ __forceinline__ int perm32(int rho) { const int n = rho >> 4, i = rho & 15; return 8 * (i >> 2) + 4 * n + (i & 3); }

struct Unit { int pm, pn; };
struct Gemm { const bf16_t* A; const bf16_t* Bt; int M, N, K; int npg; size_t a_gstride; };

struct StaticOrder {
    int nM, nN, nwg, G, c;
    __host__ __device__ void init(int M, int N, int G_, int c_) { nM = M / BM; nN = N / BM; nwg = nM * nN; G = G_; c = c_; }
    __host__ __device__ bool next(int i, Unit& u) const {
        const int L = i * G + c; if (L >= nwg) return false;
        int wgid = L; { const int q = nwg / NXCD, r = nwg % NXCD, xcd = wgid % NXCD, off = wgid / NXCD; wgid = (xcd < r ? xcd * (q + 1) : r * (q + 1) + (xcd - r) * q) + off; }
        const int nig = WGM * nN, gid = wgid / nig, fm = gid * WGM, gsz = (nM - fm) < WGM ? (nM - fm) : WGM;
        u.pm = fm + ((wgid % nig) % gsz); u.pn = (wgid % nig) / gsz; return true;
    }
    __device__ __forceinline__ void a_ready(const Unit&) const {}
    __device__ __forceinline__ void done(const Unit&) const {}
};
template <class Epi, class Sched, bool STAMP = false>
__device__ __forceinline__ void gemm_phase(PG8_LAS unsigned char* lds, const Gemm g, const Sched& S, const Epi& E, unsigned long long* stamps) {
    int tid_l = threadIdx.x; asm volatile("" : "+v"(tid_l));
    const int tid = tid_l, wid = __builtin_amdgcn_readfirstlane(tid >> 6), lane = tid & 63, wr = wid >> 2, wc = wid & 3, fr = lane & 15, fq = lane >> 4;
    const int K = g.K, nt = K / BK;
    int ts_lo = 0, ts_hi = 0, nts = 0; const unsigned long long rt_entry = STAMP ? (unsigned long long)wall_clock64() : 0ull;
#define PG8_STAMP() do { if (STAMP && wid == 0 && nts < 64) { const unsigned long long _c = (unsigned long long)clock64(); \
        ts_lo = (lane == nts) ? (int)(unsigned)_c : ts_lo; ts_hi = (lane == nts) ? (int)(unsigned)(_c >> 32) : ts_hi; ++nts; } } while (0)
    PG8_STAMP();
    unsigned voffA[2], voffB[2];
#pragma unroll
    for (int i = 0; i < 2; ++i) { int R, C; stage_rc(tid * 16 + i * 8192, R, C); const int Rb = Epi::PERM ? ((R & ~31) + perm32(R & 31)) : R;
        voffA[i] = (unsigned)(R * K + C) * 2u; voffB[i] = (unsigned)(Rb * K + C) * 2u; }
    const size_t kstep = (size_t)(BK * 2);
    const size_t hstep = (size_t)HALF * K * 2;
    const size_t tstep = 2 * hstep;
    const unsigned ldsw = (unsigned)wid * 1024u;
    const int aoff = lds_byte(wr * 64 + fr, fq * 8), boff = lds_byte(wc * 32 + fr, fq * 8);
#define PG8_SA(b, h) (((b) * 2 + (h)) * HTB)
#define PG8_SB(b, h) ((4 + (b) * 2 + (h)) * HTB)
#define PG8_STAGE(bufoff, gbase, voff) do { _Pragma("unroll") for (int _i = 0; _i < 2; ++_i) \
        __builtin_amdgcn_global_load_lds((const unsigned*)((const char*)(gbase) + (voff)[_i]), (PG8_LAS unsigned*)(lds + (bufoff) + ldsw + _i * 8192), 16, 0, 0); } while (0)
#define PG8_LDA(dst, b, h) do { _Pragma("unroll") for (int m = 0; m < 4; ++m) _Pragma("unroll") for (int k = 0; k < 2; ++k) dst[m][k] = *(const PG8_LAS bf16x8*)(lds + PG8_SA(b, h) + aoff + m * 2048 + k * 1024); } while (0)
#define PG8_LDB(dst, b, h) do { _Pragma("unroll") for (int n = 0; n < 2; ++n) _Pragma("unroll") for (int k = 0; k < 2; ++k) dst[n][k] = *(const PG8_LAS bf16x8*)(lds + PG8_SB(b, h) + boff + n * 2048 + k * 1024); } while (0)
#define PG8_MMA(ai, bj, At, Bt) do { __builtin_amdgcn_s_setprio(1); _Pragma("unroll") for (int m = 0; m < 4; ++m) _Pragma("unroll") for (int n = 0; n < 2; ++n) _Pragma("unroll") for (int k = 0; k < 2; ++k) \
        acc[ai][bj][m][n] = __builtin_amdgcn_mfma_f32_16x16x32_bf16(Bt[n][k], At[m][k], acc[ai][bj][m][n], 0, 0, 0); __builtin_amdgcn_s_setprio(0); } while (0)
#define PG8_WAIT_V(n) asm volatile("s_waitcnt vmcnt(" #n ")" ::: "memory")
#define PG8_WAIT_L(n) asm volatile("s_waitcnt lgkmcnt(" #n ")" ::: "memory")
#define PG8_BAR __builtin_amdgcn_s_barrier()
#define PG8_SCHED __builtin_amdgcn_sched_barrier(0)
    Unit cur, nxt; int ui = 0;
    if (!S.next(0, cur)) return;
    f32x4 acc[2][2][4][2];
#pragma unroll
    for (int a = 0; a < 2; ++a)
#pragma unroll
        for (int b = 0; b < 2; ++b)
#pragma unroll
            for (int m = 0; m < 4; ++m)
#pragma unroll
                for (int n = 0; n < 2; ++n) acc[a][b][m][n] = (f32x4){0.f, 0.f, 0.f, 0.f};
    bf16x8 At[4][2], B0[2][2], B1[2][2];
    const char* cA = (const char*)g.A + (size_t)cur.pm * tstep + (g.npg ? (size_t)(cur.pn / g.npg) * g.a_gstride : (size_t)0); const char* cB = (const char*)g.Bt + (size_t)cur.pn * tstep;
    S.a_ready(cur);
    PG8_STAGE(PG8_SB(0, 0), cB, voffB); PG8_STAGE(PG8_SA(0, 0), cA, voffA); PG8_STAGE(PG8_SB(0, 1), cB + hstep, voffB); PG8_STAGE(PG8_SA(0, 1), cA + hstep, voffA);
    if (wr == 1) PG8_BAR;
    PG8_WAIT_V(4); PG8_BAR;
    PG8_STAGE(PG8_SB(1, 0), cB + kstep, voffB); PG8_STAGE(PG8_SA(1, 0), cA + kstep, voffA); PG8_STAGE(PG8_SB(1, 1), cB + hstep + kstep, voffB);
    PG8_WAIT_V(6); PG8_BAR;
    PG8_STAMP();
    for (;;) {
        const bool has_next = S.next(ui + 1, nxt);
        const char* nA = has_next ? (const char*)g.A + (size_t)nxt.pm * tstep + (g.npg ? (size_t)(nxt.pn / g.npg) * g.a_gstride : (size_t)0) : cA; const char* nB = has_next ? (const char*)g.Bt + (size_t)nxt.pn * tstep : cB;
        for (int t = 0; t < nt; t += 2) {
            const bool last = (t == nt - 2);
            const char* a1 = cA + (size_t)(t + 1) * kstep;
            const char* a2 = last ? nA : cA + (size_t)(t + 2) * kstep; const char* b2 = last ? nB : cB + (size_t)(t + 2) * kstep;
            const char* a3 = a2 + kstep; const char* b3 = b2 + kstep;
            if (last && has_next) S.a_ready(nxt);
            PG8_LDB(B0, 0, 0); PG8_SCHED; PG8_LDA(At, 0, 0); PG8_STAGE(PG8_SA(1, 1), a1 + hstep, voffA);
            PG8_WAIT_L(8); PG8_BAR; PG8_WAIT_L(0); PG8_MMA(0, 0, At, B0); PG8_BAR; PG8_SCHED;
            PG8_LDB(B1, 0, 1); PG8_STAGE(PG8_SB(0, 0), b2, voffB);
            PG8_BAR; PG8_WAIT_L(0); PG8_MMA(0, 1, At, B1); PG8_BAR;
            PG8_LDA(At, 0, 1); PG8_STAGE(PG8_SA(0, 0), a2, voffA);
            PG8_BAR; PG8_WAIT_L(0); PG8_MMA(1, 0, At, B0); PG8_BAR; PG8_SCHED;
            PG8_STAGE(PG8_SB(0, 1), b2 + hstep, voffB);
            PG8_WAIT_V(6); PG8_BAR; PG8_MMA(1, 1, At, B1); PG8_BAR;
            PG8_LDB(B0, 1, 0); PG8_SCHED; PG8_LDA(At, 1, 0); PG8_STAGE(PG8_SA(0, 1), a2 + hstep, voffA);
            PG8_WAIT_L(8); PG8_BAR; PG8_WAIT_L(0); PG8_MMA(0, 0, At, B0); PG8_BAR; PG8_SCHED;
            PG8_LDB(B1, 1, 1); PG8_STAGE(PG8_SB(1, 0), b3, voffB);
            PG8_BAR; PG8_WAIT_L(0); PG8_MMA(0, 1, At, B1); PG8_BAR;
            PG8_LDA(At, 1, 1); PG8_STAGE(PG8_SA(1, 0), a3, voffA);
            PG8_BAR; PG8_WAIT_L(0); PG8_MMA(1, 0, At, B0); PG8_BAR; PG8_SCHED;
            PG8_STAGE(PG8_SB(1, 1), b3 + hstep, voffB);
            PG8_WAIT_V(6); PG8_BAR; PG8_MMA(1, 1, At, B1); PG8_BAR;
        }
        PG8_STAMP();
        if constexpr (!Epi::AFTER_DRAIN) { E(acc, cur, wr, wc, fr, fq); S.done(cur); }
        PG8_STAMP();
        if (!has_next) break;
#pragma unroll
        for (int a = 0; a < 2; ++a)
#pragma unroll
            for (int b = 0; b < 2; ++b)
#pragma unroll
                for (int m = 0; m < 4; ++m)
#pragma unroll
                    for (int n = 0; n < 2; ++n) acc[a][b][m][n] = (f32x4){0.f, 0.f, 0.f, 0.f};
        cur = nxt; cA = nA; cB = nB; ++ui;
    }
    PG8_WAIT_V(0);
    if (wr == 0) PG8_BAR;
    PG8_BAR;
    if constexpr (Epi::AFTER_DRAIN) { E.fused(acc, cur, wr, wc, fr, fq, lds, wid, lane); S.done(cur); }
    PG8_STAMP();
    if (STAMP && wid == 0) { stamps[lane] = lane < nts ? (((unsigned long long)(unsigned)ts_hi << 32) | (unsigned)ts_lo) : 0ull;
        if (lane == 62) stamps[62] = rt_entry; if (lane == 63) stamps[63] = (unsigned long long)wall_clock64(); }
#undef PG8_STAMP
#undef PG8_SA
#undef PG8_SB
#undef PG8_STAGE
#undef PG8_LDA
#undef PG8_LDB
#undef PG8_MMA
#undef PG8_WAIT_V
#undef PG8_WAIT_L
#undef PG8_BAR
#undef PG8_SCHED
}
template <class Epi, class Sched, bool ALIGN_EPI = false, bool SP2 = false>
__device__ __forceinline__ void gemm_phase2(PG8_LAS unsigned char* lds, const Gemm g, const Sched& S, const Epi& E) {
    int tid_l = threadIdx.x; asm volatile("" : "+v"(tid_l));
    const int tid = tid_l, wid = __builtin_amdgcn_readfirstlane(tid >> 6), lane = tid & 63, wr = wid >> 2, wc = wid & 3, fr = lane & 15, fq = lane >> 4;
    const int K = g.K, nt = K / BK;
    unsigned voffA[2], voffB[2];
#pragma unroll
    for (int i = 0; i < 2; ++i) { int R, C; stage_rc(tid * 16 + i * 8192, R, C); const int Rb = Epi::PERM ? ((R & ~31) + perm32(R & 31)) : R;
        voffA[i] = (unsigned)(R * K + C) * 2u; voffB[i] = (unsigned)(Rb * K + C) * 2u; }
    const size_t kstep = (size_t)(BK * 2);
    const size_t hstep = (size_t)HALF * K * 2;
    const size_t tstep = 2 * hstep;
    const unsigned ldsw = (unsigned)wid * 1024u;
    const int aoff = lds_byte(wr * 64 + fr, fq * 8), boff = lds_byte(wc * 32 + fr, fq * 8);
#define PG8_SA(b, h) (((b) * 2 + (h)) * HTB)
#define PG8_SB(b, h) ((4 + (b) * 2 + (h)) * HTB)
#define PG8_STAGE(bufoff, gbase, voff) do { _Pragma("unroll") for (int _i = 0; _i < 2; ++_i) \
        __builtin_amdgcn_global_load_lds((const unsigned*)((const char*)(gbase) + (voff)[_i]), (PG8_LAS unsigned*)(lds + (bufoff) + ldsw + _i * 8192), 16, 0, 0); } while (0)
#define PG8_LDA(dst, b, h) do { _Pragma("unroll") for (int m = 0; m < 4; ++m) _Pragma("unroll") for (int k = 0; k < 2; ++k) dst[m][k] = *(const PG8_LAS bf16x8*)(lds + PG8_SA(b, h) + aoff + m * 2048 + k * 1024); } while (0)
#define PG8_LDB(dst, b, h) do { _Pragma("unroll") for (int n = 0; n < 2; ++n) _Pragma("unroll") for (int k = 0; k < 2; ++k) dst[n][k] = *(const PG8_LAS bf16x8*)(lds + PG8_SB(b, h) + boff + n * 2048 + k * 1024); } while (0)
#define PG8_MMA(ai, bj, At, Bt) do { __builtin_amdgcn_s_setprio(1); _Pragma("unroll") for (int m = 0; m < 4; ++m) _Pragma("unroll") for (int n = 0; n < 2; ++n) _Pragma("unroll") for (int k = 0; k < 2; ++k) \
        acc[ai][bj][m][n] = __builtin_amdgcn_mfma_f32_16x16x32_bf16(Bt[n][k], At[m][k], acc[ai][bj][m][n], 0, 0, 0); __builtin_amdgcn_s_setprio(0); } while (0)
#define PG8_WAIT_V(n) asm volatile("s_waitcnt vmcnt(" #n ")" ::: "memory")
#define PG8_WAIT_L(n) asm volatile("s_waitcnt lgkmcnt(" #n ")" ::: "memory")
#define PG8_BAR __builtin_amdgcn_s_barrier()
#define PG8_SCHED __builtin_amdgcn_sched_barrier(0)
    Unit cur, nxt; int ui = 0;
    if (!S.next(0, cur)) return;
    f32x4 acc[2][2][4][2];
#pragma unroll
    for (int a = 0; a < 2; ++a)
#pragma unroll
        for (int b = 0; b < 2; ++b)
#pragma unroll
            for (int m = 0; m < 4; ++m)
#pragma unroll
                for (int n = 0; n < 2; ++n) acc[a][b][m][n] = (f32x4){0.f, 0.f, 0.f, 0.f};
    bf16x8 At[4][2], B0[2][2], B1[2][2];
    const char* cA = (const char*)g.A + (size_t)cur.pm * tstep + (g.npg ? (size_t)(cur.pn / g.npg) * g.a_gstride : (size_t)0); const char* cB = (const char*)g.Bt + (size_t)cur.pn * tstep;
    S.a_ready(cur);
    if constexpr (SP2) {
        PG8_STAGE(PG8_SB(0, 0), cB, voffB); PG8_STAGE(PG8_SB(0, 1), cB + hstep, voffB); PG8_STAGE(PG8_SA(0, 0), cA, voffA); PG8_STAGE(PG8_SA(0, 1), cA + hstep, voffA);
        if (wr == 1) PG8_BAR;
        PG8_WAIT_V(2); PG8_BAR;
        PG8_STAGE(PG8_SB(1, 0), cB + kstep, voffB); PG8_STAGE(PG8_SA(1, 0), cA + kstep, voffA); PG8_STAGE(PG8_SB(1, 1), cB + hstep + kstep, voffB);
        PG8_WAIT_V(6); PG8_BAR;
    } else {
        PG8_STAGE(PG8_SB(0, 0), cB, voffB); PG8_STAGE(PG8_SA(0, 0), cA, voffA); PG8_STAGE(PG8_SB(0, 1), cB + hstep, voffB); PG8_STAGE(PG8_SA(0, 1), cA + hstep, voffA);
        if (wr == 1) PG8_BAR;
        PG8_WAIT_V(4); PG8_BAR;
        PG8_STAGE(PG8_SB(1, 0), cB + kstep, voffB); PG8_STAGE(PG8_SA(1, 0), cA + kstep, voffA); PG8_STAGE(PG8_SB(1, 1), cB + hstep + kstep, voffB);
        PG8_WAIT_V(6); PG8_BAR;
    }
    for (;;) {
        const bool has_next = S.next(ui + 1, nxt);
        const char* nA = has_next ? (const char*)g.A + (size_t)nxt.pm * tstep + (g.npg ? (size_t)(nxt.pn / g.npg) * g.a_gstride : (size_t)0) : cA; const char* nB = has_next ? (const char*)g.Bt + (size_t)nxt.pn * tstep : cB;
        for (int t = 0; t < nt; t += 2) {
            const bool last = (t == nt - 2);
            const char* a1 = cA + (size_t)(t + 1) * kstep;
            const char* a2 = last ? nA : cA + (size_t)(t + 2) * kstep; const char* b2 = last ? nB : cB + (size_t)(t + 2) * kstep;
            const char* a3 = a2 + kstep; const char* b3 = b2 + kstep;
            if (last && has_next) S.a_ready(nxt);
            if constexpr (SP2) {
            PG8_LDB(B0, 0, 0); PG8_LDB(B1, 0, 1); PG8_SCHED; PG8_LDA(At, 0, 0); PG8_STAGE(PG8_SA(1, 1), a1 + hstep, voffA);
            PG8_WAIT_V(8); PG8_WAIT_L(0); PG8_BAR; PG8_MMA(0, 0, At, B0); PG8_MMA(0, 1, At, B1); PG8_BAR; PG8_SCHED;
            PG8_LDA(At, 0, 1); PG8_STAGE(PG8_SB(0, 0), b2, voffB); PG8_STAGE(PG8_SB(0, 1), b2 + hstep, voffB); PG8_STAGE(PG8_SA(0, 0), a2, voffA);
            PG8_WAIT_V(8); PG8_WAIT_L(0); PG8_BAR; PG8_MMA(1, 0, At, B0); PG8_MMA(1, 1, At, B1); PG8_BAR; PG8_SCHED;
            PG8_LDB(B0, 1, 0); PG8_LDB(B1, 1, 1); PG8_SCHED; PG8_LDA(At, 1, 0); PG8_STAGE(PG8_SA(0, 1), a2 + hstep, voffA);
            PG8_WAIT_V(8); PG8_WAIT_L(0); PG8_BAR; PG8_MMA(0, 0, At, B0); PG8_MMA(0, 1, At, B1); PG8_BAR; PG8_SCHED;
            PG8_LDA(At, 1, 1); PG8_STAGE(PG8_SB(1, 0), b3, voffB); PG8_STAGE(PG8_SB(1, 1), b3 + hstep, voffB); PG8_STAGE(PG8_SA(1, 0), a3, voffA);
            PG8_WAIT_V(8); PG8_WAIT_L(0); PG8_BAR; PG8_MMA(1, 0, At, B0); PG8_MMA(1, 1, At, B1); PG8_BAR; PG8_SCHED;
            } else {
            PG8_LDB(B0, 0, 0); PG8_SCHED; PG8_LDA(At, 0, 0); PG8_STAGE(PG8_SA(1, 1), a1 + hstep, voffA);
            PG8_WAIT_L(8); PG8_BAR; PG8_WAIT_L(0); PG8_MMA(0, 0, At, B0); PG8_BAR; PG8_SCHED;
            PG8_LDB(B1, 0, 1); PG8_STAGE(PG8_SB(0, 0), b2, voffB);
            PG8_BAR; PG8_WAIT_L(0); PG8_MMA(0, 1, At, B1); PG8_BAR;
            PG8_LDA(At, 0, 1); PG8_STAGE(PG8_SA(0, 0), a2, voffA);
            PG8_BAR; PG8_WAIT_L(0); PG8_MMA(1, 0, At, B0); PG8_BAR; PG8_SCHED;
            PG8_STAGE(PG8_SB(0, 1), b2 + hstep, voffB);
            PG8_WAIT_V(6); PG8_BAR; PG8_MMA(1, 1, At, B1); PG8_BAR;
            PG8_LDB(B0, 1, 0); PG8_SCHED; PG8_LDA(At, 1, 0); PG8_STAGE(PG8_SA(0, 1), a2 + hstep, voffA);
            PG8_WAIT_L(8); PG8_BAR; PG8_WAIT_L(0); PG8_MMA(0, 0, At, B0); PG8_BAR; PG8_SCHED;
            PG8_LDB(B1, 1, 1); PG8_STAGE(PG8_SB(1, 0), b3, voffB);
            PG8_BAR; PG8_WAIT_L(0); PG8_MMA(0, 1, At, B1); PG8_BAR;
            PG8_LDA(At, 1, 1); PG8_STAGE(PG8_SA(1, 0), a3, voffA);
            PG8_BAR; PG8_WAIT_L(0); PG8_MMA(1, 0, At, B0); PG8_BAR; PG8_SCHED;
            PG8_STAGE(PG8_SB(1, 1), b3 + hstep, voffB);
            PG8_WAIT_V(6); PG8_BAR; PG8_MMA(1, 1, At, B1); PG8_BAR;
            }
        }
        if constexpr (ALIGN_EPI) { if (wr == 0) PG8_BAR; }
        if constexpr (!Epi::AFTER_DRAIN) { E(acc, cur, wr, wc, fr, fq); S.done(cur); }
        if (!has_next) break;
#pragma unroll
        for (int a = 0; a < 2; ++a)
#pragma unroll
            for (int b = 0; b < 2; ++b)
#pragma unroll
                for (int m = 0; m < 4; ++m)
#pragma unroll
                    for (int n = 0; n < 2; ++n) acc[a][b][m][n] = (f32x4){0.f, 0.f, 0.f, 0.f};
        cur = nxt; cA = nA; cB = nB; ++ui;
        if constexpr (ALIGN_EPI) { if (wr == 1) PG8_BAR; }
    }
    PG8_WAIT_V(0);
    if constexpr (!ALIGN_EPI) { if (wr == 0) PG8_BAR; }
    PG8_BAR;
    if constexpr (Epi::AFTER_DRAIN) { E.fused(acc, cur, wr, wc, fr, fq, lds, wid, lane); S.done(cur); }
#undef PG8_SA
#undef PG8_SB
#undef PG8_STAGE
#undef PG8_LDA
#undef PG8_LDB
#undef PG8_MMA
#undef PG8_WAIT_V
#undef PG8_WAIT_L
#undef PG8_BAR
#undef PG8_SCHED
}

}

#define LAS __attribute__((address_space(3)))
typedef unsigned short bf16;
typedef short bf16x8 __attribute__((ext_vector_type(8)));
typedef float f32x4 __attribute__((ext_vector_type(4)));
typedef float f32x2 __attribute__((ext_vector_type(2)));
typedef float f32x16 __attribute__((ext_vector_type(16)));
typedef unsigned u32x4 __attribute__((ext_vector_type(4)));
typedef unsigned u32x2 __attribute__((ext_vector_type(2)));
typedef __bf16 bf16x2_t __attribute__((ext_vector_type(2)));
#define DI __device__ __forceinline__
#define MFMA32(a, b, c) __builtin_amdgcn_mfma_f32_32x32x16_bf16((a), (b), (c), 0, 0, 0)

DI float bf2f(unsigned short b) { return __uint_as_float(((unsigned)b) << 16); }
DI float bflo(unsigned w) { return __uint_as_float(w << 16); }
DI float bfhi(unsigned w) { return __uint_as_float(w & 0xffff0000u); }
DI unsigned pk2(float lo, float hi) { f32x2 v; v.x = lo; v.y = hi; return __builtin_bit_cast(unsigned, __builtin_convertvector(v, bf16x2_t)); }
DI unsigned short f2bf(float f) { return (unsigned short)(pk2(f, 0.f) & 0xffffu); }
DI int crow(int reg, int h) { return (reg & 3) + 8 * (reg >> 2) + 4 * h; }
DI bf16x8 pack_step(const f32x16& x, int s) {
    u32x4 p; p.x = pk2(x[8 * s], x[8 * s + 1]); p.y = pk2(x[8 * s + 2], x[8 * s + 3]); p.z = pk2(x[8 * s + 4], x[8 * s + 5]); p.w = pk2(x[8 * s + 6], x[8 * s + 7]);
    return __builtin_bit_cast(bf16x8, p);
}
DI bf16x8 pack8f(f32x4 a, f32x4 b) { u32x4 p; p.x = pk2(a.x, a.y); p.y = pk2(a.z, a.w); p.z = pk2(b.x, b.y); p.w = pk2(b.z, b.w); return __builtin_bit_cast(bf16x8, p); }
DI bf16x8 join8(u32x2 lo, u32x2 hi) { u32x4 p; p.x = lo.x; p.y = lo.y; p.z = hi.x; p.w = hi.y; return __builtin_bit_cast(bf16x8, p); }
DI float wave_sum(float v) {
#pragma unroll
    for (int o = 1; o < 64; o <<= 1) v += __shfl_xor(v, o);
    return v;
}
DI float half_sum(float v) {
#pragma unroll
    for (int o = 1; o < 32; o <<= 1) v += __shfl_xor(v, o);
    return v;
}
#define DPP_ROR(x, n) __builtin_bit_cast(float, __builtin_amdgcn_update_dpp(0, __builtin_bit_cast(int, (x)), 0x120 + (n), 0xf, 0xf, false))
DI float row16_sum(float x) { x += DPP_ROR(x, 8); x += DPP_ROR(x, 4); x += DPP_ROR(x, 2); x += DPP_ROR(x, 1); return x; }
DI float sigmoidf_(float x) { return __builtin_amdgcn_rcpf(1.0f + __expf(-x)); }
DI float siluf_(float x) { return x * __builtin_amdgcn_rcpf(1.0f + __expf(-x)); }
DI float gelu_erf(float v) {
    const float t = __builtin_amdgcn_rcpf(fabsf(v) * 0.2316418882f + 1.0f);
    float q = t * 0.5307027145f + (-0.7265760135f); q = q * t + 0.7107068705f; q = q * t + (-0.142248368f); q = q * t + 0.127414796f; q = q * t;
    const float e = __builtin_amdgcn_exp2f((v * v) * (-0.72134752044f));
    const float m = v * (q * e);
    return v < 0.f ? m : v - m;
}
DI float logsigmoidf_(float x) { return fminf(x, 0.f) - __logf(1.0f + __expf(-fabsf(x))); }

#define XB_TMO      128
#define XB_XCNT(j)  (256  + 64 * (j))
#define XB_XSUB(j)  (1280 + 64 * (j))
#define XB_XGEN(j)  (2304 + 64 * (j))
#define XB_TOP      3328
#define XB_TOPGEN   3392
#define XCD_BAR_WORDS 3456
#define XB_SPIN_CAP (1u << 18)
__device__ __forceinline__ unsigned xb_ld(unsigned* p)              { return __hip_atomic_load(p, __ATOMIC_RELAXED, __HIP_MEMORY_SCOPE_AGENT); }
__device__ __forceinline__ unsigned xb_add(unsigned* p, unsigned v) { return __hip_atomic_fetch_add(p, v, __ATOMIC_RELAXED, __HIP_MEMORY_SCOPE_AGENT); }
__device__ __forceinline__ unsigned xb_xcc_id() { return (unsigned)__builtin_amdgcn_s_getreg((3 << 11) | 20) & 0xFu; }
#define XB_SPIN(cond, bar) do { unsigned _sp = 0; while (cond) { __builtin_amdgcn_s_sleep(1); \
    if ((++_sp & 255u) == 0u) { if (xb_ld(&(bar)[XB_TMO])) break; if (_sp > XB_SPIN_CAP) { atomicAdd(&(bar)[XB_TMO], 1u); break; } } } } while (0)
struct XcdBarrier { unsigned* bar; unsigned x; volatile LAS unsigned* st; };
__device__ __forceinline__ XcdBarrier xcd_barrier_post(unsigned* bar, volatile LAS unsigned* st) {
    XcdBarrier b; b.bar = bar; b.x = xb_xcc_id(); b.st = st;
    if (threadIdx.x == 0) (void)xb_add(&bar[XB_XCNT(b.x)], 1u);
    return b;
}
__device__ __forceinline__ void xcd_barrier_complete(unsigned* bar, unsigned x, unsigned& nloc, unsigned& nx) {
    const unsigned G = gridDim.x * gridDim.y * gridDim.z;
    unsigned sum, cnt, mine, sp = 0u;
    for (;;) {
        sum = 0u; cnt = 0u; mine = 0u;
#pragma unroll
        for (unsigned j = 0; j < 16; ++j) { const unsigned c = xb_ld(&bar[XB_XCNT(j)]); sum += c; cnt += (c > 0u) ? 1u : 0u; mine = (j == x) ? c : mine; }
        if (sum == G) break;
        __builtin_amdgcn_s_sleep(1);
        if ((++sp & 255u) == 0u) { if (xb_ld(&bar[XB_TMO])) break; if (sp > XB_SPIN_CAP) { atomicAdd(&bar[XB_TMO], 1u); break; } }
    }
    nloc = mine > 0u ? mine : 1u; nx = cnt > 0u ? cnt : 1u;
}
__device__ __forceinline__ void xcd_barrier(const XcdBarrier& b) {
    asm volatile("s_waitcnt vmcnt(0)" ::: "memory");
    __syncthreads();
    if (threadIdx.x == 0) {
        unsigned* bar = b.bar;
        __builtin_amdgcn_s_waitcnt(0);
        unsigned nloc = b.st[0], nx = b.st[1];
        if (nloc == 0u) { xcd_barrier_complete(bar, b.x, nloc, nx); b.st[0] = nloc; b.st[1] = nx; }
        const unsigned old = xb_add(&bar[XB_XSUB(b.x)], 1u);
        const unsigned gen = old / nloc;
        if (old + 1u == (gen + 1u) * nloc) {
            __builtin_amdgcn_fence(__ATOMIC_RELEASE, "agent");
            asm volatile("s_waitcnt vmcnt(0)" ::: "memory");
            const unsigned og = xb_add(&bar[XB_TOP], 1u);
            const unsigned tg = og / nx;
            if (og + 1u == (tg + 1u) * nx) xb_add(&bar[XB_TOPGEN], 1u);
            else XB_SPIN(xb_ld(&bar[XB_TOPGEN]) == tg, bar);
            __builtin_amdgcn_fence(__ATOMIC_ACQUIRE, "agent");
            xb_add(&bar[XB_XGEN(b.x)], 1u);
            asm volatile("s_waitcnt vmcnt(0)" ::: "memory");
        } else {
            XB_SPIN(xb_ld(&bar[XB_XGEN(b.x)]) == gen, bar);
            __builtin_amdgcn_fence(__ATOMIC_ACQUIRE, "agent");
            asm volatile("s_waitcnt vmcnt(0)" ::: "memory");
        }
    }
    __syncthreads();
}

constexpr int NB = 4, SEQ = 4096, T = NB * SEQ, DM = 2048, BW = 1024, NIN = 23320;
constexpr int N1 = 15360, LDP = 14848, N1BF_TILES = 58, NM = 8192;
constexpr int AQ = 0, AK = 512, AV = 1024, AG = 2048, BQ = 3072, BK_ = 4096, BV = 5120, BIQ = 6144, BG = 6656, CR = 7680, CK = 8704, CV = 9728, CG = 10752, DU = 11776, DV = 12800, DG = 13824;
constexpr int GLR = 0, IK = 16, IW = 80, WLR = 96, ALR = 192;
constexpr size_t MiB = 1u << 20;
constexpr size_t WS_CTL = 0, CTL_BYTES = 64 * 1024;
constexpr size_t WS_WT1 = 1 * MiB;
constexpr size_t WS_WTM = 121 * MiB;
constexpr size_t WS_WTP = 185 * MiB;
constexpr size_t WS_WTO = 217 * MiB;
constexpr size_t WS_WSB = 233 * MiB;
constexpr size_t WS_H   = 234 * MiB;
constexpr size_t WS_P   = 298 * MiB;
constexpr size_t WS_SM  = 762 * MiB;
constexpr size_t WS_RW  = 794 * MiB;
constexpr size_t WS_KD  = 1050 * MiB;
constexpr size_t WS_VT  = 1050 * MiB;
constexpr size_t WS_SC  = 1082 * MiB;
constexpr size_t WS_BM  = 1212 * MiB;
constexpr size_t WS_YS  = 1220 * MiB;
constexpr size_t WS_ROPE = 1348 * MiB;
constexpr size_t WS_X1 = 1351 * MiB;
constexpr size_t WS_ET = 1415 * MiB;
constexpr size_t WS_WLR = 1416 * MiB;
constexpr size_t WS_END = 1418 * MiB;
constexpr size_t RW_ARR = (size_t)T * 1024 * 2;
constexpr int CW_BAR = 64, CW_Q = 4096, CW_F = 8192;
constexpr int CW_RD = 11000;
constexpr int CW_UNUSED_ = 0;
constexpr int LDS_BYTES = 147456, MISC_OFF = LDS_BYTES - 256;
constexpr int NPHASE = 21;

struct Args { const float* in[24]; const int* pos; float* out; unsigned char* ws; int ph_lo, ph_hi; };

template <int MODE> struct Epi {
    static constexpr bool PERM = true, AFTER_DRAIN = false;
    unsigned char* O; float* O2;
    __device__ __forceinline__ void operator()(const pg8::f32x4 (&acc)[2][2][4][2], const pg8::Unit& u, int wr, int wc, int fr, int fq) const {
        const int row0 = u.pm * 256 + wr * 64 + fr, cl = wc * 32 + 8 * fq;
        if (MODE == 2) {
            const bf16* proj = (const bf16*)O2; bf16* merged = (bf16*)O;
            const unsigned d0 = u.pn * 64 + wc * 16 + 4 * fq;
            u32x2 pv[2][4][4];
#pragma unroll
            for (int ai = 0; ai < 2; ++ai)
#pragma unroll
                for (int m = 0; m < 4; ++m)
#pragma unroll
                    for (int g = 0; g < 4; ++g) pv[ai][m][g] = *(const u32x2*)(proj + ((unsigned)(g * T + row0 + ai * 128 + m * 16) * (unsigned)DM + d0));
#pragma unroll
            for (int ai = 0; ai < 2; ++ai)
#pragma unroll
                for (int m = 0; m < 4; ++m) { float o0 = 0.f, o1 = 0.f, o2 = 0.f, o3 = 0.f;
#pragma unroll
                    for (int g = 0; g < 4; ++g) { const pg8::f32x4 v = acc[ai][g >> 1][m][g & 1]; const u32x2 p = pv[ai][m][g];
                        o0 += sigmoidf_(v[0]) * bflo(p.x); o1 += sigmoidf_(v[1]) * bfhi(p.x); o2 += sigmoidf_(v[2]) * bflo(p.y); o3 += sigmoidf_(v[3]) * bfhi(p.y); }
                    u32x2 w; w.x = pk2(o0, o1); w.y = pk2(o2, o3);
                    *(u32x2*)(merged + ((unsigned)(row0 + ai * 128 + m * 16) * (unsigned)DM + d0)) = w; }
        } else if (MODE == 0 && u.pn >= N1BF_TILES) {
            float* base; int ldc;
            base = O2 + (u.pn - N1BF_TILES) * 256 + cl; ldc = 512;
#pragma unroll
            for (int ai = 0; ai < 2; ++ai)
#pragma unroll
                for (int m = 0; m < 4; ++m) { float* rowp = base + (size_t)(row0 + ai * 128 + m * 16) * ldc;
#pragma unroll
                    for (int bj = 0; bj < 2; ++bj) { *(pg8::f32x4*)(rowp + bj * 128) = acc[ai][bj][m][0]; *(pg8::f32x4*)(rowp + bj * 128 + 4) = acc[ai][bj][m][1]; } }
        } else {
            bf16* base; int ldc;
            if (MODE == 0) { base = (bf16*)O + u.pn * 256 + cl; ldc = LDP; }
            else if (MODE == 1) { const int g = u.pn >> 3; base = (bf16*)O + (size_t)g * T * DM + (u.pn & 7) * 256 + cl; ldc = DM; }
            else { base = (bf16*)O + u.pn * 256 + cl; ldc = DM; }
#pragma unroll
            for (int ai = 0; ai < 2; ++ai)
#pragma unroll
                for (int m = 0; m < 4; ++m) { bf16* rowp = base + (size_t)(row0 + ai * 128 + m * 16) * ldc;
#pragma unroll
                    for (int bj = 0; bj < 2; ++bj) { pg8::f32x4 v0 = acc[ai][bj][m][0], v1 = acc[ai][bj][m][1];
                        u32x4 w; w.x = pk2(v0[0], v0[1]); w.y = pk2(v0[2], v0[3]); w.z = pk2(v1[0], v1[1]); w.w = pk2(v1[2], v1[3]);
                        *(u32x4*)(rowp + bj * 128) = w; } }
        }
    }
};

DI int map1(int n) {
    if (n < 2048) return n;
    if (n < 6656) return n + 16;
    if (n < 10752) return n + 88;
    if (n < LDP) return n + 280;
    const int m = n - LDP;
    if (m < 16) return 2048 + m;
    if (m < 80) return 6672 + (m - 16);
    if (m < 88) return 6736 + (m - 80);
    if (m < 96) return -1;
    if (m < 192) return 10840 + (m - 96);
    if (m < 288) return 10936 + (m - 192);
    return -1;
}
DI void tr_item(const float* W, size_t ldw, int K, bf16* WT, int k0, int sc, int nd, LAS float* scr, int lane) {
#pragma unroll 8
    for (int i = 0; i < 32; ++i) { const int kk = 2 * i + (lane >> 5); const float v = sc >= 0 ? W[(size_t)(k0 + kk) * ldw + sc] : 0.f; scr[kk * 33 + (lane & 31)] = v; }
    asm volatile("s_waitcnt lgkmcnt(0)" ::: "memory");
    const int c = lane & 7;
#pragma unroll
    for (int jj = 0; jj < 4; ++jj) { const int n = (lane >> 3) + 8 * jj; const LAS float* s = scr + (8 * c) * 33 + n;
        u32x4 o; o.x = pk2(s[0 * 33], s[1 * 33]); o.y = pk2(s[2 * 33], s[3 * 33]); o.z = pk2(s[4 * 33], s[5 * 33]); o.w = pk2(s[6 * 33], s[7 * 33]);
        *(u32x4*)(WT + (size_t)(nd + n) * K + k0 + 8 * c) = o; }
    asm volatile("s_waitcnt lgkmcnt(0)" ::: "memory");
}
DI void tr_load64(f32x4 (&v)[16], const float* W, size_t ldw, int k0, int sc0, int lane) {
    const int kr = lane >> 4, c4 = 4 * (lane & 15);
#pragma unroll
    for (int i = 0; i < 16; ++i) v[i] = *(const f32x4*)(W + (size_t)(k0 + 4 * i + kr) * ldw + sc0 + c4);
}
DI void tr_finish64(const f32x4 (&v)[16], int K, bf16* WT, int k0, int nd, LAS float* scr, int lane, int gsel) {
    const int kr = lane >> 4, c4 = 4 * (lane & 15);
#pragma unroll
    for (int i = 0; i < 16; ++i) { LAS float* d = scr + (4 * i + kr) * 65 + c4; d[0] = v[i].x; d[1] = v[i].y; d[2] = v[i].z; d[3] = v[i].w; }
    asm volatile("s_waitcnt lgkmcnt(0)" ::: "memory");
    const int c = lane & 7;
#pragma unroll
    for (int jj = 0; jj < 8; ++jj) { const int n = (lane >> 3) + 8 * jj; const LAS float* s = scr + (8 * c) * 65 + n;
        u32x4 o; o.x = pk2(s[0 * 65], s[1 * 65]); o.y = pk2(s[2 * 65], s[3 * 65]); o.z = pk2(s[4 * 65], s[5 * 65]); o.w = pk2(s[6 * 65], s[7 * 65]);
        const int nr = gsel < 0 ? n : 128 * (gsel >> 1) + 32 * (n >> 4) + 8 * ((n >> 2) & 3) + 4 * (gsel & 1) + (n & 3);
        *(u32x4*)(WT + (size_t)(nd + nr) * K + k0 + 8 * c) = o; }
    asm volatile("s_waitcnt lgkmcnt(0)" ::: "memory");
}
DI int map1_base(int n0) { return n0 < 2048 ? n0 : (n0 < 6656 ? n0 + 16 : (n0 < 10752 ? n0 + 88 : n0 + 280)); }
DI void phase_prologue(const Args& a, LAS unsigned char* lds, int tid, int lane, int wave, int bid, int G, int sel = 15) {
    LAS float* scr = (LAS float*)(lds + wave * 16640);
    const int gw = bid * 8 + wave, NGW = G * 8;
    constexpr int I1 = 32 * 232, IS = 32 * 16, IM = 32 * 128, IP = 4 * 16 * 32, IO = 32 * 32, IL = I1 + IS + IM + IP + IO;
    struct TrIt { const float* W; bf16* WT; unsigned ldw; int K, k0, sc0, nd, gsel; };
    auto decode = [&](int it, TrIt& d) -> bool {
        const int l = it / IL; int r = it - l * IL;
        const float* win = a.in[4] + (size_t)l * DM * NIN;
        if (r < I1) { const int kb = r % 32, nb = r / 32; d = TrIt{win, (bf16*)(a.ws + WS_WT1) + (size_t)l * N1 * DM, (unsigned)NIN, DM, 64 * kb, map1_base(64 * nb), 64 * nb, -1}; return true; } r -= I1;
        if (r < IS) return false; r -= IS;
        if (r < IM) { const int kb = r % 32, nb = r / 32; d = TrIt{win, (bf16*)(a.ws + WS_WTM) + (size_t)l * NM * DM, (unsigned)NIN, DM, 64 * kb, 15128 + 64 * nb, 256 * (nb & 31), nb >> 5}; return true; } r -= IM;
        if (r < IP) { const int g = r / 512, q = r % 512, kb = q % 16, nb = q / 16;
            d = TrIt{a.in[22] + ((size_t)(l * 4 + g) << 21), (bf16*)(a.ws + WS_WTP) + ((size_t)(l * 4 + g) << 21), (unsigned)DM, BW, 64 * kb, 64 * nb, 64 * nb, -1}; return true; } r -= IP;
        { const int kb = r % 32, nb = r / 32; d = TrIt{a.in[23] + ((size_t)l << 22), (bf16*)(a.ws + WS_WTO) + ((size_t)l << 22), (unsigned)DM, DM, 64 * kb, 64 * nb, 64 * nb, -1}; return true; }
    };
    if (sel & 1) {
        f32x4 vn[16]; TrIt dn{}; bool hn = false; int it = gw;
        while (it < 2 * IL && !(hn = decode(it, dn))) it += NGW;
        if (hn) tr_load64(vn, dn.W, dn.ldw, dn.k0, dn.sc0, lane);
        while (hn) {
            f32x4 vc[16]; const TrIt dc = dn;
#pragma unroll
            for (int i = 0; i < 16; ++i) vc[i] = vn[i];
            __builtin_amdgcn_sched_barrier(0);
            it += NGW; hn = false;
            while (it < 2 * IL && !(hn = decode(it, dn))) it += NGW;
            if (hn) tr_load64(vn, dn.W, dn.ldw, dn.k0, dn.sc0, lane);
            __builtin_amdgcn_sched_barrier(0);
            tr_finish64(vc, dc.K, dc.WT, dc.k0, dc.nd, scr, lane, dc.gsel);
        }
        for (int it2 = gw; it2 < 2 * IL; it2 += NGW) {
            const int l = it2 / IL; int r = it2 - l * IL - I1;
            if (r < 0 || r >= IS) continue;
            const float* win = a.in[4] + (size_t)l * DM * NIN;
            const int kb = r % 32, nb = 464 + r / 32; tr_item(win, NIN, DM, (bf16*)(a.ws + WS_WT1) + (size_t)l * N1 * DM, 64 * kb, map1(32 * nb + (lane & 31)), 32 * nb, scr, lane);
        }
    }
    if (sel & 2) { f32x2* rope = (f32x2*)(a.ws + WS_ROPE);
      for (int e = bid * 512 + tid; e < T * 24; e += G * 512) { const int t = e / 24, i = e - t * 24;
          const float inv = i < 16 ? (float)pow(500000.0, -(double)(2 * i) / 32.0) : (float)pow(500000.0, -(double)(2 * (i - 16)) / 16.0);
          const float ang = (float)a.pos[t] * inv; double sd, cd; sincos((double)ang, &sd, &cd); f32x2 o; o.x = (float)cd; o.y = (float)sd; rope[e] = o; } }
    if (sel & 4) { bf16* wl = (bf16*)(a.ws + WS_WLR);
      for (int e = bid * 512 + tid; e < 2 * 2 * 96 * 1024; e += G * 512) { const int n = e & 1023, k = (e >> 10) % 96, lm = (e >> 10) / 96, l = lm >> 1, m = lm & 1;
          const float x = a.in[m ? 12 : 10][(size_t)l * 96 * BW + k * BW + n]; const bf16 hi = f2bf(x); const bf16 lo = f2bf(x - bf2f(hi));
          wl[((size_t)(lm * 2 + 0) * 1024 + n) * 96 + k] = hi; wl[((size_t)(lm * 2 + 1) * 1024 + n) * 96 + k] = lo; } }
    bf16* wsb = (bf16*)(a.ws + WS_WSB);
    if (sel & 8) for (int e = bid * 512 + tid; e < 2 * 8 * 128 * 128; e += G * 512) { const int j = e & 127, i = (e >> 7) & 127; wsb[e] = (i < 64 && j >= 64) ? (bf16)0 : f2bf(a.in[20][e]); }
}

DI void phase_prenorm(const float* x, const float* g, bf16* h, int gw, int NGW, int lane, LAS unsigned char* lds, int tid) {
    LAS f32x4* gl = (LAS f32x4*)lds;
    __syncthreads();
    gl[tid] = ((const f32x4*)g)[tid];
    __syncthreads();
    f32x4 xq[8];
#define PR_LOAD(m_) do { const f32x4* xr_ = (const f32x4*)(x + (size_t)(m_) * DM) + lane; _Pragma("unroll") for (int j = 0; j < 8; ++j) xq[j] = xr_[64 * j]; } while (0)
    PR_LOAD(gw);
    for (int m = gw; m < T; m += NGW) {
        f32x4 v[8]; float s = 0.f;
#pragma unroll
        for (int j = 0; j < 8; ++j) { v[j] = xq[j]; s += (v[j].x * v[j].x + v[j].y * v[j].y) + (v[j].z * v[j].z + v[j].w * v[j].w); }
        __builtin_amdgcn_sched_barrier(0);
        if (m + NGW < T) PR_LOAD(m + NGW);
        __builtin_amdgcn_sched_barrier(0);
        const float rs = 1.0f / sqrtf(wave_sum(s) * (1.0f / DM) + 1e-6f);
        u32x2* o = (u32x2*)(h + (size_t)m * DM) + lane;
#pragma unroll
        for (int j = 0; j < 8; ++j) { const f32x4 gv = gl[lane + 64 * j]; u32x2 w; w.x = pk2(v[j].x * rs * gv.x, v[j].y * rs * gv.y); w.y = pk2(v[j].z * rs * gv.z, v[j].w * rs * gv.w); o[64 * j] = w; }
    }
#undef PR_LOAD
    __syncthreads();
}
template <int LAYER> DI void phase_postnorm(const float* x, bf16* x1, const bf16* y, const float* g, float* out, const float* gnext, bf16* hnext, int gw, int NGW, int lane, LAS unsigned char* lds, int tid) {
    LAS f32x4* gl = (LAS f32x4*)lds;
    gl[tid] = ((const f32x4*)g)[tid]; if (LAYER == 0) gl[512 + tid] = ((const f32x4*)gnext)[tid];
    __syncthreads();
    u32x2 yw[8], xw[8]; f32x4 xq[8];
#define PN_LOAD(m_) do { const u32x2* yr_ = (const u32x2*)(y + (size_t)(m_) * DM) + lane; \
        if (LAYER == 0) { const f32x4* xr_ = (const f32x4*)(x + (size_t)(m_) * DM) + lane; _Pragma("unroll") for (int j = 0; j < 8; ++j) { yw[j] = yr_[64 * j]; xq[j] = xr_[64 * j]; } } \
        else { const u32x2* xr_ = (const u32x2*)(x1 + (size_t)(m_) * DM) + lane; _Pragma("unroll") for (int j = 0; j < 8; ++j) { yw[j] = yr_[64 * j]; xw[j] = xr_[64 * j]; } } } while (0)
    PN_LOAD(gw);
    for (int m = gw; m < T; m += NGW) {
        f32x4 v[8], xv[8]; float s = 0.f;
#pragma unroll
        for (int j = 0; j < 8; ++j) {
            if (LAYER == 0) xv[j] = xq[j];
            else { xv[j].x = bflo(xw[j].x); xv[j].y = bfhi(xw[j].x); xv[j].z = bflo(xw[j].y); xv[j].w = bfhi(xw[j].y); }
            v[j].x = bflo(yw[j].x); v[j].y = bfhi(yw[j].x); v[j].z = bflo(yw[j].y); v[j].w = bfhi(yw[j].y); s += (v[j].x * v[j].x + v[j].y * v[j].y) + (v[j].z * v[j].z + v[j].w * v[j].w); }
        __builtin_amdgcn_sched_barrier(0);
        if (m + NGW < T) PN_LOAD(m + NGW);
        __builtin_amdgcn_sched_barrier(0);
        const float rs = 1.0f / sqrtf(wave_sum(s) * (1.0f / DM) + 1e-6f);
        float s2 = 0.f;
#pragma unroll
        for (int j = 0; j < 8; ++j) { const f32x4 gv = gl[lane + 64 * j]; const f32x4 r = xv[j] + v[j] * rs * gv; v[j] = r; s2 += (r.x * r.x + r.y * r.y) + (r.z * r.z + r.w * r.w);
            if (LAYER == 0) { u32x2 w; w.x = pk2(r.x, r.y); w.y = pk2(r.z, r.w); ((u32x2*)(x1 + (size_t)m * DM) + lane)[64 * j] = w; }
            else ((f32x4*)(out + (size_t)m * DM) + lane)[64 * j] = r; }
        if (LAYER == 0) {
            const float rs2 = 1.0f / sqrtf(wave_sum(s2) * (1.0f / DM) + 1e-6f);
            u32x2* ho = (u32x2*)(hnext + (size_t)m * DM) + lane;
#pragma unroll
            for (int j = 0; j < 8; ++j) { const f32x4 gv = gl[512 + lane + 64 * j]; u32x2 w; w.x = pk2(v[j].x * rs2 * gv.x, v[j].y * rs2 * gv.y); w.y = pk2(v[j].z * rs2 * gv.z, v[j].w * rs2 * gv.w); ho[64 * j] = w; }
        }
    }
#undef PN_LOAD
    __syncthreads();
}
DI void phase_merge(const bf16* gates, const bf16* proj, bf16* merged, int gtid, int NT) {
    for (int it = gtid; it < T * (DM / 8); it += NT) {
        const int t = it >> 8, d = (it & 255) * 8;
        float acc[8];
#pragma unroll
        for (int e = 0; e < 8; ++e) acc[e] = 0.f;
#pragma unroll
        for (int g = 0; g < 4; ++g) { const u32x4 gv = *(const u32x4*)(gates + (size_t)t * NM + g * DM + d); const u32x4 pv = *(const u32x4*)(proj + ((size_t)g * T + t) * DM + d);
#pragma unroll
            for (int e = 0; e < 4; ++e) { acc[2 * e] += bflo(gv[e]) * bflo(pv[e]); acc[2 * e + 1] += bfhi(gv[e]) * bfhi(pv[e]); } }
        u32x4 o; o.x = pk2(acc[0], acc[1]); o.y = pk2(acc[2], acc[3]); o.z = pk2(acc[4], acc[5]); o.w = pk2(acc[6], acc[7]);
        *(u32x4*)(merged + (size_t)t * DM + d) = o;
    }
}

struct RopeL { unsigned short q[2][2][2]; unsigned short iq[2]; float ik[2]; f32x2 csa, csi; };
DI void rope_load(RopeL& L, const bf16* P, const float* SM, const f32x2* rope, int t, int lane) {
    const int i = lane & 15, i8 = lane & 7;
    L.csa = rope[(unsigned)t * 24 + i]; L.csi = rope[(unsigned)t * 24 + 16 + i8];
#pragma unroll
    for (int r = 0; r < 2; ++r)
#pragma unroll
        for (int w = 0; w < 2; ++w) { const bf16* q = P + (unsigned)t * LDP + (w ? BK_ : BQ) + ((lane + 64 * r) >> 4) * 128 + i; L.q[r][w][0] = q[0]; L.q[r][w][1] = q[16]; }
    { const bf16* q = P + (unsigned)t * LDP + BIQ + (lane >> 3) * 64 + i8; L.iq[0] = q[0]; L.iq[1] = q[8]; }
    { const float* q = SM + (unsigned)t * 512 + IK + i8; L.ik[0] = q[0]; L.ik[1] = q[8]; }
}
DI void rope_finish(const RopeL& L, bf16* P, float* SM, int t, int lane) {
    const int i = lane & 15, i8 = lane & 7;
#pragma unroll
    for (int r = 0; r < 2; ++r)
#pragma unroll
        for (int w = 0; w < 2; ++w) { bf16* q = P + (unsigned)t * LDP + (w ? BK_ : BQ) + ((lane + 64 * r) >> 4) * 128 + i; const float x1 = bf2f(L.q[r][w][0]), x2 = bf2f(L.q[r][w][1]);
            q[0] = f2bf(x1 * L.csa.x - x2 * L.csa.y); q[16] = f2bf(x2 * L.csa.x + x1 * L.csa.y); }
    { bf16* q = P + (unsigned)t * LDP + BIQ + (lane >> 3) * 64 + i8; const float x1 = bf2f(L.iq[0]), x2 = bf2f(L.iq[1]); q[0] = f2bf(x1 * L.csi.x - x2 * L.csi.y); q[8] = f2bf(x2 * L.csi.x + x1 * L.csi.y); }
    if (lane < 8) { float* q = SM + (unsigned)t * 512 + IK + i8; q[0] = L.ik[0] * L.csi.x - L.ik[1] * L.csi.y; q[8] = L.ik[1] * L.csi.x + L.ik[0] * L.csi.y; }
}
struct SguL { u32x4 v[2]; };
DI void sgu_load(SguL& L, const bf16* P, int t, int lane) {
#pragma unroll
    for (int r = 0; r < 2; ++r) L.v[r] = *(const u32x4*)(P + (unsigned)t * LDP + DV + 8 * lane + 512 * r);
}
DI void sgu_finish(const SguL& L, bf16* P, const LAS f32x4* pl, int t, int lane) {
    bf16* vrow = P + (unsigned)t * LDP + DV;
    float x[16]; float s = 0.f;
#pragma unroll
    for (int r = 0; r < 2; ++r)
#pragma unroll
        for (int e = 0; e < 4; ++e) { x[8 * r + 2 * e] = gelu_erf(bflo(L.v[r][e])); x[8 * r + 2 * e + 1] = gelu_erf(bfhi(L.v[r][e])); }
#pragma unroll
    for (int e = 0; e < 16; ++e) s += x[e];
    const float mean = wave_sum(s) * (1.0f / 1024.0f); float s2 = 0.f;
#pragma unroll
    for (int e = 0; e < 16; ++e) { x[e] -= mean; s2 += x[e] * x[e]; }
    const float rstd = 1.0f / sqrtf(wave_sum(s2) * (1.0f / 1024.0f) + 1e-5f);
#pragma unroll
    for (int r = 0; r < 2; ++r) { const int c0 = 8 * lane + 512 * r; const f32x4 g0 = pl[1024 + 2 * lane + 128 * r], g1 = pl[1025 + 2 * lane + 128 * r], b0 = pl[1280 + 2 * lane + 128 * r], b1 = pl[1281 + 2 * lane + 128 * r];
        u32x4 o; o.x = pk2(x[8 * r + 0] * rstd * g0.x + b0.x, x[8 * r + 1] * rstd * g0.y + b0.y); o.y = pk2(x[8 * r + 2] * rstd * g0.z + b0.z, x[8 * r + 3] * rstd * g0.w + b0.w);
        o.z = pk2(x[8 * r + 4] * rstd * g1.x + b1.x, x[8 * r + 5] * rstd * g1.y + b1.y); o.w = pk2(x[8 * r + 6] * rstd * g1.z + b1.z, x[8 * r + 7] * rstd * g1.w + b1.w);
        *(u32x4*)(vrow + c0) = o; }
}
DI float quad_sum(float x) {
    x += __builtin_bit_cast(float, __builtin_amdgcn_update_dpp(0, __builtin_bit_cast(int, x), 0xB1, 0xf, 0xf, false));
    x += __builtin_bit_cast(float, __builtin_amdgcn_update_dpp(0, __builtin_bit_cast(int, x), 0x4E, 0xf, 0xf, false));
    return x;
}
struct RwkvL { u32x4 c[3][2], p[3][2]; };
DI void rwkvp_load(RwkvL& L, const bf16* P, int t, int lane) {
    const bool hp = (t & (SEQ - 1)) > 0; const int j = 16 * lane;
    const bf16* pc = P + (unsigned)t * LDP + j; const bf16* pp = hp ? pc - LDP : pc;
#pragma unroll
    for (int w = 0; w < 3; ++w) { const int off = w == 0 ? CR : (w == 1 ? CK : CV);
#pragma unroll
        for (int q = 0; q < 2; ++q) { L.c[w][q] = *(const u32x4*)(pc + off + 8 * q); L.p[w][q] = *(const u32x4*)(pp + off + 8 * q); } }
}
DI void rwkvp_finish(const RwkvL& L, const Args& a, const LAS f32x4* pl, int t, int lane) {
    bf16* RWr = (bf16*)(a.ws + WS_RW); bf16* RWk = RWr + (size_t)T * 1024; bf16* RWv = RWk + (size_t)T * 1024; bf16* RWkk = RWv + (size_t)T * 1024;
    const int j = 16 * lane;
    const unsigned hpm = (t & (SEQ - 1)) > 0 ? 0xffffffffu : 0u;
    float kl[16]; float ss = 0.f;
#pragma unroll
    for (int w = 0; w < 3; ++w) {
        bf16* dst = (w == 0 ? RWr : (w == 1 ? RWk : RWv)) + (unsigned)t * 1024 + j;
#pragma unroll
        for (int q = 0; q < 2; ++q) { const u32x4 c = L.c[w][q]; u32x4 p = L.p[w][q]; p.x &= hpm; p.y &= hpm; p.z &= hpm; p.w &= hpm;
            const f32x4 m0 = pl[256 * w + 4 * lane + 2 * q], m1 = pl[256 * w + 4 * lane + 2 * q + 1];
            float x[8];
#pragma unroll
            for (int e = 0; e < 4; ++e) { const float c0 = bflo(c[e]), c1 = bfhi(c[e]), p0 = bflo(p[e]), p1 = bfhi(p[e]); const float ma = e < 2 ? m0[2 * e] : m1[2 * e - 4], mb = e < 2 ? m0[2 * e + 1] : m1[2 * e - 3];
                x[2 * e] = c0 + (p0 - c0) * ma; x[2 * e + 1] = c1 + (p1 - c1) * mb; }
            u32x4 o; o.x = pk2(x[0], x[1]); o.y = pk2(x[2], x[3]); o.z = pk2(x[4], x[5]); o.w = pk2(x[6], x[7]);
            *(u32x4*)(dst + 8 * q) = o;
            if (w == 1) { const f32x4 k0 = pl[768 + 4 * lane + 2 * q], k1 = pl[769 + 4 * lane + 2 * q];
#pragma unroll
                for (int e = 0; e < 8; ++e) { const float kk = x[e] * (e < 4 ? k0[e & 3] : k1[e & 3]); kl[8 * q + e] = kk; ss += kk * kk; } }
        }
    }
    const float rn = 1.0f / sqrtf(quad_sum(ss) + 1e-12f);
    u32x4 o0, o1; o0.x = pk2(kl[0] * rn, kl[1] * rn); o0.y = pk2(kl[2] * rn, kl[3] * rn); o0.z = pk2(kl[4] * rn, kl[5] * rn); o0.w = pk2(kl[6] * rn, kl[7] * rn);
    o1.x = pk2(kl[8] * rn, kl[9] * rn); o1.y = pk2(kl[10] * rn, kl[11] * rn); o1.z = pk2(kl[12] * rn, kl[13] * rn); o1.w = pk2(kl[14] * rn, kl[15] * rn);
    *(u32x4*)(RWkk + (unsigned)t * 1024 + j) = o0; *(u32x4*)(RWkk + (unsigned)t * 1024 + j + 8) = o1;
}
DI void prep_lowrank_unit(const Args& a, int l, int unit, LAS unsigned char* lds, int tid, int lane, int wave) {
    const float* SM = (const float*)(a.ws + WS_SM);
    bf16* RWa = (bf16*)(a.ws + WS_RW) + (size_t)4 * T * 1024; float* RWw = (float*)(a.ws + WS_RW + 6 * RW_ARR);
    const float* mu = a.in[8] + l * 4288;
    const int t0 = unit * 32, s0 = t0 & (SEQ - 1);
    LAS bf16* AH = (LAS bf16*)lds;
    { float cw[6], pw[6], ca[6], pa[6], mw[6], ma[6];
#pragma unroll
      for (int q = 0; q < 6; ++q) { const int e = tid + 512 * q, tok = e / 96, i = e - tok * 96; const int t = t0 + tok; const int tp = (s0 + tok) > 0 ? t - 1 : t;
          cw[q] = SM[(unsigned)t * 512 + WLR + i]; pw[q] = SM[(unsigned)tp * 512 + WLR + i]; ca[q] = SM[(unsigned)t * 512 + ALR + i]; pa[q] = SM[(unsigned)tp * 512 + ALR + i];
          mw[q] = mu[3072 + i]; ma[q] = mu[3168 + i]; }
#pragma unroll
      for (int q = 0; q < 6; ++q) { const int e = tid + 512 * q, tok = e / 96, i = e - tok * 96; const bool hp = (s0 + tok) > 0;
          const float pwv = hp ? pw[q] : 0.f, pav = hp ? pa[q] : 0.f;
          const float tw_ = cw[q] + (pwv - cw[q]) * mw[q]; const float xw = 1.0f - 2.0f * __builtin_amdgcn_rcpf(1.0f + __expf(2.0f * tw_));     const float xa = ca[q] + (pav - ca[q]) * ma[q];
          const bf16 hw = f2bf(xw), ha = f2bf(xa);
          AH[(0 * 32 + tok) * 104 + i] = hw; AH[(1 * 32 + tok) * 104 + i] = f2bf(xw - bf2f(hw)); AH[(2 * 32 + tok) * 104 + i] = ha; AH[(3 * 32 + tok) * 104 + i] = f2bf(xa - bf2f(ha)); } }
    __syncthreads();
    const int r32 = lane & 31, hh = lane >> 5;
    const bf16* WL = (const bf16*)(a.ws + WS_WLR) + (size_t)l * (2 * 2 * 1024 * 96);
    bf16x8 Bf[3][4];
#define LR_LD(slot_, s_, n_) do { _Pragma("unroll") for (int mp_ = 0; mp_ < 4; ++mp_) Bf[slot_][mp_] = *(const bf16x8*)(WL + ((unsigned)(mp_ * 1024 + (n_))) * 96 + 16 * (s_) + 8 * hh); } while (0)
    { const int n0 = 128 * wave + r32; LR_LD(0, 0, n0); LR_LD(1, 1, n0); }
    float w0 = a.in[9][l * BW + 128 * wave + r32], a0 = a.in[11][l * BW + 128 * wave + r32];
#pragma unroll 1
    for (int c = 0; c < 4; ++c) {
        const int n = 128 * wave + 32 * c + r32;
        f32x16 aw, aa;
#pragma unroll
        for (int r = 0; r < 16; ++r) { aw[r] = 0.f; aa[r] = 0.f; }
#pragma unroll
        for (int st = 0; st < 6; ++st) {
            if (st + 2 < 6) LR_LD((st + 2) % 3, st + 2, n);
            __builtin_amdgcn_sched_barrier(0);
            const bf16x8 Ahw = *(const LAS bf16x8*)(AH + (0 * 32 + r32) * 104 + 16 * st + 8 * hh), Alw = *(const LAS bf16x8*)(AH + (1 * 32 + r32) * 104 + 16 * st + 8 * hh);
            const bf16x8 Aha = *(const LAS bf16x8*)(AH + (2 * 32 + r32) * 104 + 16 * st + 8 * hh), Ala = *(const LAS bf16x8*)(AH + (3 * 32 + r32) * 104 + 16 * st + 8 * hh);
            aw = MFMA32(Ahw, Bf[st % 3][0], aw); aw = MFMA32(Ahw, Bf[st % 3][1], aw); aw = MFMA32(Alw, Bf[st % 3][0], aw);
            aa = MFMA32(Aha, Bf[st % 3][2], aa); aa = MFMA32(Aha, Bf[st % 3][3], aa); aa = MFMA32(Ala, Bf[st % 3][2], aa);
        }
        const int nn = 128 * wave + 32 * (c + 1 < 4 ? c + 1 : c) + r32;
        LR_LD(0, 0, nn); LR_LD(1, 1, nn);
        const float w0n = a.in[9][l * BW + nn], a0n = a.in[11][l * BW + nn];
        __builtin_amdgcn_sched_barrier(0);
#pragma unroll
        for (int r = 0; r < 16; ++r) { const unsigned o = (unsigned)(t0 + crow(r, hh)) * 1024 + n;
            RWw[o] = __expf(-0.606531f * sigmoidf_(w0 + aw[r])); RWa[o] = f2bf(sigmoidf_(a0 + aa[r])); }
        w0 = w0n; a0 = a0n;
    }
#undef LR_LD
    __syncthreads();
}
DI void vt_unit(const Args& a, int unit, LAS unsigned char* lds, int tid) {
    const bf16* P = (const bf16*)(a.ws + WS_P); bf16* VT = (bf16*)(a.ws + WS_VT);
    const int hd = unit & 7, st = (unit >> 3) & 63, b = unit >> 9;
    LAS bf16* tile = (LAS bf16*)lds;
#pragma unroll
    for (int r = 0; r < 2; ++r) { const int ch = tid + 512 * r, s = ch >> 4, c = ch & 15;
        *(LAS u32x4*)(tile + s * 136 + 8 * c) = *(const u32x4*)(P + (unsigned)(b * SEQ + st * 64 + s) * LDP + BV + hd * 128 + 8 * c); }
    __syncthreads();
    { const int d = tid & 127, sq = tid >> 7; unsigned w[8];
#pragma unroll
      for (int i = 0; i < 8; ++i) w[i] = (unsigned)tile[(16 * sq + 2 * i) * 136 + d] | ((unsigned)tile[(16 * sq + 2 * i + 1) * 136 + d] << 16);
      bf16* o = VT + ((unsigned)((b * 8 + hd) * 128 + d)) * SEQ + st * 64 + 16 * sq;
      u32x4 o0, o1; o0.x = w[0]; o0.y = w[1]; o0.z = w[2]; o0.w = w[3]; o1.x = w[4]; o1.y = w[5]; o1.z = w[6]; o1.w = w[7];
      *(u32x4*)o = o0; *(u32x4*)(o + 8) = o1; }
    __syncthreads();
}

typedef short s16x4 __attribute__((ext_vector_type(4)));
DI bf16x8 tr_frag(const LAS unsigned char* p, int rs4) {
    const s16x4 lo = __builtin_bit_cast(s16x4, __builtin_amdgcn_ds_read_tr16_b64_v4i16((LAS s16x4*)p));
    const s16x4 hi = __builtin_bit_cast(s16x4, __builtin_amdgcn_ds_read_tr16_b64_v4i16((LAS s16x4*)(p + rs4)));
    return __builtin_shufflevector(lo, hi, 0, 1, 2, 3, 4, 5, 6, 7);
}
DI void gla_kv_unit(const Args& a, int l, int unit, LAS unsigned char* lds, int tid, int lane, int wave) {
    const bf16* P = (const bf16*)(a.ws + WS_P); const float* SM = (const float*)(a.ws + WS_SM);
    const int hd = unit & 3, c = (unit >> 2) & 63, b = unit >> 8;
    LAS float* la = (LAS float*)lds;
    LAS float* ptot = la + 64 * 128;
    LAS float* glr = ptot + 4 * 128;
    LAS float* wgl = glr + 64 * 16;
    const int k2 = tid & 127, cg = tid >> 7;
    const int t0 = b * SEQ + c * 64;
    u32x4 kr[2]; float wv[4];
#pragma unroll
    for (int r = 0; r < 2; ++r) { const int pc = tid + 512 * r; kr[r] = *(const u32x4*)(P + (unsigned)(t0 + (pc >> 4)) * LDP + AK + hd * 128 + (pc & 15) * 8); }
#pragma unroll
    for (int r = 0; r < 4; ++r) { const int e = tid + 512 * r; wv[r] = a.in[5][(unsigned)(l * 16 * 512 + (e >> 7) * 512 + hd * 128 + (e & 127))]; }
    const float bg = a.in[6][l * 512 + hd * 128 + k2];
    const f32x4 gl = *(const f32x4*)(SM + (unsigned)(t0 + ((tid & 255) >> 2)) * 512 + GLR + (tid & 3) * 4);
    __builtin_amdgcn_sched_barrier(0);
#pragma unroll
    for (int r = 0; r < 4; ++r) wgl[tid + 512 * r] = wv[r];
    if (tid < 256) *(LAS f32x4*)(glr + (tid >> 2) * 16 + (tid & 3) * 4) = gl;
    __syncthreads();
    float pre[16]; float run = 0.f;
    { float wr[16];
#pragma unroll
      for (int q = 0; q < 16; ++q) wr[q] = wgl[q * 128 + k2];
#pragma unroll
      for (int i = 0; i < 16; ++i) { const int tok = cg * 16 + i; float x = bg;
#pragma unroll
          for (int q = 0; q < 4; ++q) { const f32x4 gv = *(const LAS f32x4*)(glr + tok * 16 + 4 * q); x += gv.x * wr[4 * q] + gv.y * wr[4 * q + 1] + gv.z * wr[4 * q + 2] + gv.w * wr[4 * q + 3]; }
          run += logsigmoidf_(x) * (1.0f / 16.0f); pre[i] = run; } }
    ptot[cg * 128 + k2] = run;
    __syncthreads();
    { const float p0 = ptot[k2], p1 = ptot[128 + k2], p2 = ptot[256 + k2], p3 = ptot[384 + k2];
      const float tot = ((p0 + p1) + p2) + p3;
      const float off = cg == 0 ? 0.f : cg == 1 ? p0 : cg == 2 ? p0 + p1 : (p0 + p1) + p2;
      const float base = tot - off;
#pragma unroll
      for (int i = 0; i < 16; ++i) la[(cg * 16 + i) * 128 + k2] = __expf(base - pre[i]);
      if (cg == 0) ((float*)(a.ws + WS_ET))[(unsigned)unit * 128 + k2] = __expf(tot); }
    __syncthreads();
    bf16* KD = (bf16*)(a.ws + WS_KD) + (unsigned)unit * (64 * 128);
#pragma unroll
    for (int r = 0; r < 2; ++r) { const int pc = tid + 512 * r, tok = pc >> 4, kg = pc & 15;
        const f32x4 d0 = *(const LAS f32x4*)(la + tok * 128 + kg * 8), d1 = *(const LAS f32x4*)(la + tok * 128 + kg * 8 + 4);
        u32x4 o; o.x = pk2(bflo(kr[r].x) * d0.x, bfhi(kr[r].x) * d0.y); o.y = pk2(bflo(kr[r].y) * d0.z, bfhi(kr[r].y) * d0.w);
        o.z = pk2(bflo(kr[r].z) * d1.x, bfhi(kr[r].z) * d1.y); o.w = pk2(bflo(kr[r].w) * d1.z, bfhi(kr[r].w) * d1.w);
        *(u32x4*)(KD + pc * 8) = o; }
    __syncthreads();
}
DI void gla_scan_unit(const Args& a, int l, int unit, LAS unsigned char* lds, int tid, int lane, int wave) {
    const bf16* P = (const bf16*)(a.ws + WS_P); bf16* YA = (bf16*)(a.ws + WS_YS);
    const int b = unit >> 2, hd = unit & 3, r32 = lane & 31, hh = lane >> 5;
    LAS float* etl = (LAS float*)lds;
    LAS float* ssq = etl + 64 * 128;
    LAS float* hgl = ssq + 64 * 16;
    LAS bf16* qbuf = (LAS bf16*)(hgl + 256);
    LAS unsigned char* kimg = (LAS unsigned char*)(qbuf + 64 * 132);
    LAS unsigned char* vimg = kimg + 64 * 320;
    { const float* ET = (const float*)(a.ws + WS_ET);
      for (int e = tid; e < 64 * 128; e += 512) { const int c = e >> 7, k = e & 127; etl[e] = ET[(unsigned)(((b * 64 + c) * 4 + hd) * 128 + k)]; }
      if (tid < 256) hgl[tid] = a.in[7][l * 256 + tid]; }
    const int qrow = tid >> 3, qseg = tid & 7;
    const bf16* KDb = (const bf16*)(a.ws + WS_KD) + (unsigned)((b * 64) * 4 + hd) * (64 * 128);
    u32x4 Kn[2], Vn[4], Qn[2]; u32x2 Gt[2][4];
#define GS_LOAD(c_) do { const int cc_ = (c_) < 64 ? (c_) : 63; int tl_ = tid; asm volatile("" : "+v"(tl_)); \
        const bf16* Pc_ = P + (size_t)(b * SEQ + cc_ * 64) * LDP; const bf16* Kc_ = KDb + (size_t)cc_ * (4 * 8192); \
        _Pragma("unroll") for (int r = 0; r < 2; ++r) Kn[r] = *(const u32x4*)(Kc_ + (unsigned)(tl_ * 8 + 4096 * r)); \
        _Pragma("unroll") for (int r = 0; r < 4; ++r) Vn[r] = *(const u32x4*)(Pc_ + (unsigned)(((tl_ >> 5) + 16 * r) * LDP + AV + hd * 256 + (tl_ & 31) * 8)); \
        Qn[0] = *(const u32x4*)(Pc_ + (unsigned)((tl_ >> 3) * LDP + AQ + hd * 128 + 16 * (tl_ & 7))); Qn[1] = *(const u32x4*)(Pc_ + (unsigned)((tl_ >> 3) * LDP + AQ + hd * 128 + 16 * (tl_ & 7) + 8)); } while (0)
#define GS_PUT() do { \
        _Pragma("unroll") for (int r = 0; r < 2; ++r) { const int pc = tid + 512 * r; *(LAS u32x4*)(kimg + (pc >> 4) * 320 + (pc & 15) * 16) = Kn[r]; } \
        _Pragma("unroll") for (int r = 0; r < 4; ++r) { const int pc = tid + 512 * r; *(LAS u32x4*)(vimg + (pc >> 5) * 576 + (pc & 31) * 16) = Vn[r]; } \
        { LAS u32x2* d = (LAS u32x2*)(qbuf + qrow * 132 + 16 * qseg); u32x2 t; t.x = Qn[0].x; t.y = Qn[0].y; d[0] = t; t.x = Qn[0].z; t.y = Qn[0].w; d[1] = t; t.x = Qn[1].x; t.y = Qn[1].y; d[2] = t; t.x = Qn[1].z; t.y = Qn[1].w; d[3] = t; } } while (0)
#define GS_GATE(c_) do { const int cc_ = (c_) < 64 ? (c_) : 63; int tl_ = tid; asm volatile("" : "+v"(tl_)); \
        const bf16* Pc_ = P + (size_t)(b * SEQ + cc_ * 64) * LDP; \
        _Pragma("unroll") for (int ct = 0; ct < 2; ++ct) _Pragma("unroll") for (int g = 0; g < 4; ++g) \
            Gt[ct][g] = *(const u32x2*)(Pc_ + (unsigned)((32 * ct + (tl_ & 31)) * LDP + AG + hd * 256 + 32 * wave + 4 * ((tl_ >> 5) & 1) + 8 * g)); } while (0)
    GS_LOAD(0); GS_GATE(0);
    __builtin_amdgcn_sched_barrier(0);
    GS_PUT();
    GS_LOAD(1);
    f32x16 S[4];
#pragma unroll
    for (int kt = 0; kt < 4; ++kt)
#pragma unroll
        for (int r = 0; r < 16; ++r) S[kt][r] = 0.f;
    const int rhalf = (lane >> 4) & 1, qi = (lane >> 2) & 3, pi = lane & 3;
    const LAS unsigned char* vb = vimg + (8 * hh + qi) * 576 + (32 * wave + 16 * rhalf + 4 * pi) * 2;
    const LAS unsigned char* kb = kimg + (8 * hh + qi) * 320 + (16 * rhalf + 4 * pi) * 2;
    __syncthreads();
#pragma unroll 1
    for (int c = 0; c < 64; ++c) {
        const int t0 = b * SEQ + c * 64;
#pragma unroll
        for (int kt = 0; kt < 4; ++kt) {
#pragma unroll
            for (int g4 = 0; g4 < 4; ++g4) { const f32x4 e = *(const LAS f32x4*)(etl + c * 128 + 32 * kt + 8 * g4 + 4 * hh);
                S[kt][4 * g4] *= e.x; S[kt][4 * g4 + 1] *= e.y; S[kt][4 * g4 + 2] *= e.z; S[kt][4 * g4 + 3] *= e.w; }
#pragma unroll
            for (int st = 0; st < 4; ++st) { const bf16x8 A = tr_frag(kb + 16 * st * 320 + 64 * kt, 4 * 320), Bv = tr_frag(vb + 16 * st * 576, 4 * 576); S[kt] = MFMA32(A, Bv, S[kt]); }
            __builtin_amdgcn_sched_barrier(0); }
        f32x16 O[2];
#pragma unroll
        for (int ct = 0; ct < 2; ++ct) {
#pragma unroll
            for (int r = 0; r < 16; ++r) O[ct][r] = 0.f;
#pragma unroll
            for (int kt = 0; kt < 4; ++kt)
#pragma unroll
                for (int s2 = 0; s2 < 2; ++s2) { const bf16x8 Sf = pack_step(S[kt], s2);
                    const LAS bf16* qp = qbuf + (32 * ct + r32) * 132 + 32 * kt + 16 * s2 + 4 * hh;
                    const bf16x8 Qf = join8(*(const LAS u32x2*)qp, *(const LAS u32x2*)(qp + 8)); O[ct] = MFMA32(Sf, Qf, O[ct]); }
            __builtin_amdgcn_sched_barrier(0);
            float ss = 0.f;
#pragma unroll
            for (int r = 0; r < 16; ++r) { O[ct][r] *= 0.08838834764831845f; ss += O[ct][r] * O[ct][r]; }
            ssq[(32 * ct + r32) * 16 + 2 * wave + hh] = ss;
        }
        __syncthreads();
        GS_PUT();
        GS_LOAD(c + 2);
        __builtin_amdgcn_sched_barrier(0);
#pragma unroll
        for (int ct = 0; ct < 2; ++ct) { const LAS f32x4* sp = (const LAS f32x4*)(ssq + (32 * ct + r32) * 16);
            const f32x4 s0 = sp[0], s1 = sp[1], s2 = sp[2], s3 = sp[3];
            const float tot = ((s0.x + s0.y) + (s0.z + s0.w)) + ((s1.x + s1.y) + (s1.z + s1.w)) + ((s2.x + s2.y) + (s2.z + s2.w)) + ((s3.x + s3.y) + (s3.z + s3.w));
            const float rs = 1.0f / sqrtf(tot * (1.0f / 256.0f) + 1e-6f);
            int tl_ = tid; asm volatile("" : "+v"(tl_));
            bf16* yp = YA + (size_t)t0 * 1024 + (unsigned)((32 * ct + (tl_ & 31)) * 1024 + hd * 256 + 32 * wave + 4 * ((tl_ >> 5) & 1));
#pragma unroll
            for (int g = 0; g < 4; ++g) { const f32x4 hg = *(const LAS f32x4*)(hgl + 32 * wave + 8 * g + 4 * hh); const u32x2 gt = Gt[ct][g];
                u32x2 w; w.x = pk2(O[ct][4 * g] * rs * hg.x * siluf_(bflo(gt.x)), O[ct][4 * g + 1] * rs * hg.y * siluf_(bfhi(gt.x)));
                w.y = pk2(O[ct][4 * g + 2] * rs * hg.z * siluf_(bflo(gt.y)), O[ct][4 * g + 3] * rs * hg.w * siluf_(bfhi(gt.y)));
                *(u32x2*)(yp + 8 * g) = w; } }
        GS_GATE(c + 1);
        __syncthreads();
    }
#undef GS_LOAD
#undef GS_PUT
#undef GS_GATE
}

DI void mm16x8(f32x4& acc0, f32x4& acc1, const LAS float* ap, const LAS float* bp, int bstep) {
    float av[8], bv[8];
#pragma unroll
    for (int j = 0; j < 8; ++j) { av[j] = ap[4 * j]; bv[j] = bp[j * bstep]; }
#pragma unroll
    for (int j = 0; j < 8; j += 2) { acc0 = __builtin_amdgcn_mfma_f32_16x16x4f32(av[j], bv[j], acc0, 0, 0, 0); acc1 = __builtin_amdgcn_mfma_f32_16x16x4f32(av[j + 1], bv[j + 1], acc1, 0, 0, 0); }
}
DI void helper_sync(volatile LAS unsigned* hs, unsigned& epoch, int lane) {
    asm volatile("s_waitcnt lgkmcnt(0)" ::: "memory");
    epoch += 4u;
    if (lane == 0) __hip_atomic_fetch_add((LAS unsigned*)hs, 1u, __ATOMIC_RELAXED, __HIP_MEMORY_SCOPE_WORKGROUP);
    while (*hs < epoch) __builtin_amdgcn_s_sleep(1);
    asm volatile("" ::: "memory");
}
DI void rwkv_unit(const Args& a, int l, int unit, LAS unsigned char* lds, int tid, int lane, int wave) {
    constexpr int TB = 32, NBLK = SEQ / TB, OPS = 256, BUF = TB * OPS;
    const bf16* RWr = (const bf16*)(a.ws + WS_RW); const bf16* RWk = RWr + (size_t)T * 1024; const bf16* RWv = RWk + (size_t)T * 1024; const bf16* RWkk = RWv + (size_t)T * 1024; const bf16* RWa = RWkk + (size_t)T * 1024;
    const float* RWw = (const float*)(a.ws + WS_RW + 6 * RW_ARR);
    bf16* YC = (bf16*)(a.ws + WS_YS) + (size_t)2 * T * 1024;
    const int half = unit & 1, hd = (unit >> 1) & 15, b = unit >> 5;
    LAS float* ob = (LAS float*)lds;
    LAS float* RT = ob + 2 * BUF;
    LAS float* BT = RT + 32 * 65;
    LAS float* KT = BT + 32 * 65;
    LAS float* NRB = KT + 32 * 65;
    LAS float* NRK = NRB + 32 * 33;
    LAS float* UU = NRK + 32 * 33;
    LAS float* S0 = UU + 2 * 1024;
    LAS float* VB = S0 + 2 * 32 * 65;
    LAS bf16* RB = (LAS bf16*)(VB + 3 * 1024);
    volatile LAS unsigned* hs = (volatile LAS unsigned*)(VB + 3 * 1024 + 2048);
    if (tid == 0) *hs = 0u;
    unsigned epoch = 0u;
    const int rg = lane >> 4, ks = lane & 15, row0 = 8 * (wave & 3) + 2 * rg;
    f32x2 S0a = {0.f, 0.f}, S0b = {0.f, 0.f}, S1a = {0.f, 0.f}, S1b = {0.f, 0.f};
    const int hid = wave - 4, htid = tid - 256;
    u32x2 gk[2], gkk[2], ga[2], gr[2], gv[2]; f32x4 gw[2];
    const f32x4 kav = *(const f32x4*)(a.in[14] + l * BW + hd * 64 + (htid & 15) * 4), rkv = *(const f32x4*)(a.in[15] + l * BW + hd * 64 + (htid & 15) * 4);
    float* BS = (float*)(a.ws + WS_RW + 5 * RW_ARR);
#define RW_SLOAD(blk_) do { const int tb_ = b * SEQ + (blk_) * TB; _Pragma("unroll") for (int j_ = 0; j_ < 2; ++j_) { const int pt_ = (htid >> 4) + 16 * j_, p4_ = (htid & 15) * 4; \
            const unsigned g_ = (unsigned)(tb_ + pt_) * 1024 + hd * 64 + p4_; \
            gk[j_] = *(const u32x2*)(RWk + g_); gkk[j_] = *(const u32x2*)(RWkk + g_); ga[j_] = *(const u32x2*)(RWa + g_); gr[j_] = *(const u32x2*)(RWr + g_); gw[j_] = *(const f32x4*)(RWw + g_); \
            gv[j_] = *(const u32x2*)(RWv + (unsigned)(tb_ + pt_) * 1024 + hd * 64 + 32 * half + (p4_ & 31)); } } while (0)
#define RW_SPUT(blk_) do { LAS float* d_ = ob + ((blk_) & 1) * BUF; LAS float* vd_ = VB + ((blk_) % 3) * 1024; _Pragma("unroll") for (int j_ = 0; j_ < 2; ++j_) { const int pt_ = (htid >> 4) + 16 * j_, p4_ = (htid & 15) * 4; \
            LAS float* q_ = d_ + pt_ * OPS + p4_; *(LAS u32x2*)(RB + ((blk_) & 1) * 2048 + pt_ * 64 + p4_) = gr[j_]; \
            f32x4 kk_, aa_, kl_; kk_.x = bflo(gkk[j_].x); kk_.y = bfhi(gkk[j_].x); kk_.z = bflo(gkk[j_].y); kk_.w = bfhi(gkk[j_].y); aa_.x = bflo(ga[j_].x); aa_.y = bfhi(ga[j_].x); aa_.z = bflo(ga[j_].y); aa_.w = bfhi(ga[j_].y); \
            kl_.x = bflo(gk[j_].x); kl_.y = bfhi(gk[j_].x); kl_.z = bflo(gk[j_].y); kl_.w = bfhi(gk[j_].y); \
            const f32x4 kp_ = kl_ * (1.0f + (aa_ - 1.0f) * kav); \
            *(LAS f32x4*)(q_) = -kk_; *(LAS f32x4*)(q_ + 64) = gw[j_]; *(LAS f32x4*)(q_ + 128) = kk_ * aa_; *(LAS f32x4*)(q_ + 192) = kp_; \
            { const float bs_ = row16_sum((bflo(gr[j_].x) * kp_.x * rkv.x + bfhi(gr[j_].x) * kp_.y * rkv.y) + (bflo(gr[j_].y) * kp_.z * rkv.z + bfhi(gr[j_].y) * kp_.w * rkv.w)); \
              if (half == 0 && (htid & 15) == 0) BS[(unsigned)(b * SEQ + (blk_) * TB + pt_) * 16 + hd] = bs_; } \
            if ((htid & 15) < 8) { f32x4 o_; o_.x = bflo(gv[j_].x); o_.y = bfhi(gv[j_].x); o_.z = bflo(gv[j_].y); o_.w = bfhi(gv[j_].y); *(LAS f32x4*)(vd_ + pt_ * 32 + p4_) = o_; } } } while (0)
    if (wave >= 4) { RW_SLOAD(0); RW_SPUT(0); RW_SLOAD(1); }
    __syncthreads();
#pragma unroll 1
    for (int blk = 0; blk <= NBLK; ++blk) {
        if (wave < 4) {
            if (blk < NBLK) {
                __builtin_amdgcn_s_setprio(2);
                const LAS float* cur = ob + (blk & 1) * BUF; const LAS float* vcur = VB + (blk % 3) * 1024;
                { LAS float* s0 = S0 + (blk & 1) * (32 * 65) + row0 * 65 + 4 * ks;
                  s0[0] = S0a.x; s0[1] = S0a.y; s0[2] = S0b.x; s0[3] = S0b.y; s0[65] = S1a.x; s0[66] = S1a.y; s0[67] = S1b.x; s0[68] = S1b.y; }
                LAS float* ub = UU + (blk & 1) * 1024 + row0;
                f32x4 onk[3], ow[3], oka[3], okk[3]; f32x2 ov[3];
#define RW_LD(slot_, t_) do { const LAS float* o_ = cur + (t_) * OPS + 4 * ks; onk[slot_] = *(const LAS f32x4*)(o_); ow[slot_] = *(const LAS f32x4*)(o_ + 64); oka[slot_] = *(const LAS f32x4*)(o_ + 128); \
        okk[slot_] = *(const LAS f32x4*)(o_ + 192); ov[slot_] = *(const LAS f32x2*)(vcur + (t_) * 32 + row0); } while (0)
                RW_LD(0, 0); RW_LD(1, 1);
#pragma unroll
                for (int t = 0; t < TB; ++t) {
                    if (t + 2 < TB) RW_LD((t + 2) % 3, t + 2);
                    __builtin_amdgcn_sched_barrier(0);
                    const f32x4 nk = onk[t % 3], w = ow[t % 3], ka = oka[t % 3], kk = okk[t % 3]; const f32x2 v2 = ov[t % 3];
                    const f32x2 nka = {nk.x, nk.y}, nkb = {nk.z, nk.w}, wa = {w.x, w.y}, wb = {w.z, w.w}, kaa = {ka.x, ka.y}, kab = {ka.z, ka.w}, kka = {kk.x, kk.y}, kkb = {kk.z, kk.w};
                    f32x2 p0 = S0a * nka + S0b * nkb, p1 = S1a * nka + S1b * nkb;
                    const float sa0 = row16_sum(p0.x + p0.y), sa1 = row16_sum(p1.x + p1.y);
                    const f32x2 sa0v = {sa0, sa0}, sa1v = {sa1, sa1}, v0v = {v2.x, v2.x}, v1v = {v2.y, v2.y};
                    S0a = S0a * wa + sa0v * kaa + v0v * kka; S0b = S0b * wb + sa0v * kab + v0v * kkb;
                    S1a = S1a * wa + sa1v * kaa + v1v * kka; S1b = S1b * wb + sa1v * kab + v1v * kkb;
                    { f32x2 uv = {sa0, sa1}; *(LAS f32x2*)(ub + t * 32) = uv; }
                }
#undef RW_LD
                __builtin_amdgcn_s_setprio(0);
            }
        } else {
            if (blk + 1 < NBLK) RW_SPUT(blk + 1);
            if (blk + 2 < NBLK) RW_SLOAD(blk + 2);
            if (blk >= 1) {
                const int pb = blk - 1, tt = hid >> 1, rr = hid & 1, l15 = lane & 15, l4 = lane >> 4;
                const LAS float* s0 = S0 + (pb & 1) * (32 * 65); const LAS float* uu = UU + (pb & 1) * 1024; const LAS float* vv = VB + (pb % 3) * 1024;
                f32x4 acc = {0.f, 0.f, 0.f, 0.f}, acc1 = {0.f, 0.f, 0.f, 0.f};
                mm16x8(acc, acc1, RT + (16 * tt + l15) * 65 + l4, s0 + (16 * rr + l15) * 65 + l4, 4);
                mm16x8(acc, acc1, RT + (16 * tt + l15) * 65 + 32 + l4, s0 + (16 * rr + l15) * 65 + 32 + l4, 4);
                mm16x8(acc, acc1, NRB + (16 * tt + l15) * 33 + l4, uu + l4 * 32 + 16 * rr + l15, 128);
                mm16x8(acc, acc1, NRK + (16 * tt + l15) * 33 + l4, vv + l4 * 32 + 16 * rr + l15, 128);
                acc = acc + acc1;
                const unsigned yo = (unsigned)(b * SEQ + pb * TB + 16 * tt + 4 * l4) * 1024 + hd * 64 + 32 * half + 16 * rr + l15;
#pragma unroll
                for (int r = 0; r < 4; ++r) YC[yo + (unsigned)r * 1024] = f2bf(acc[r]);
            }
            helper_sync(hs, epoch, lane);
            if (blk < NBLK) {
                { const LAS float* cur = ob + (blk & 1) * BUF; const int k = 16 * hid + (lane & 15), sg = lane >> 4;
                  const LAS bf16* rb = RB + (blk & 1) * 2048 + k;
                  float wl[8], Wc = 1.0f;
#pragma unroll
                  for (int j = 0; j < 8; ++j) { Wc *= cur[(8 * sg + j) * OPS + 64 + k]; wl[j] = Wc; }
                  const float p1 = __shfl(Wc, (lane - 16) & 63), p2 = __shfl(Wc, (lane - 32) & 63), p3 = __shfl(Wc, (lane - 48) & 63);
                  const float pre = (sg >= 1 ? p1 : 1.0f) * (sg >= 2 ? p2 : 1.0f) * (sg >= 3 ? p3 : 1.0f);
#pragma unroll
                  for (int j = 0; j < 8; ++j) { const int t = 8 * sg + j; const float Wt = wl[j] * pre, inv = __builtin_amdgcn_rcpf(Wt);
                      RT[t * 65 + k] = Wt * bf2f(rb[t * 64]); BT[t * 65 + k] = cur[t * OPS + 128 + k] * inv; KT[t * 65 + k] = cur[t * OPS + 192 + k] * inv; } }
                helper_sync(hs, epoch, lane);
                { const int l15 = lane & 15, l4 = lane >> 4;
#pragma unroll 1
                  for (int q = hid; q < 6; q += 4) {
                      const int mk = q >= 3, qq = q - 3 * mk, tt = qq >= 1, ii = qq == 2;
                      const LAS float* src = mk ? KT : BT; LAS float* dst = mk ? NRK : NRB;
                      f32x4 acc = {0.f, 0.f, 0.f, 0.f}, acc1 = {0.f, 0.f, 0.f, 0.f};
                      mm16x8(acc, acc1, RT + (16 * tt + l15) * 65 + l4, src + (16 * ii + l15) * 65 + l4, 4);
                      mm16x8(acc, acc1, RT + (16 * tt + l15) * 65 + 32 + l4, src + (16 * ii + l15) * 65 + 32 + l4, 4);
                      acc = acc + acc1;
#pragma unroll
                      for (int r = 0; r < 4; ++r) { const int t = 16 * tt + 4 * l4 + r, i = 16 * ii + l15; dst[t * 33 + i] = (i <= t) ? acc[r] : 0.f; }
                      if (qq == 0) {
#pragma unroll
                          for (int r = 0; r < 4; ++r) dst[(4 * l4 + r) * 33 + 16 + l15] = 0.f; }
                  } }
            }
        }
        __syncthreads();
    }
#undef RW_SLOAD
#undef RW_SPUT
    asm volatile("s_waitcnt vmcnt(0)" ::: "memory");
    __syncthreads();
    if (tid == 0) { __builtin_amdgcn_fence(__ATOMIC_RELEASE, "agent"); asm volatile("s_waitcnt vmcnt(0)" ::: "memory"); (void)xb_add((unsigned*)(a.ws + WS_CTL) + CW_RD + 64 * l + 16 * b, 1u); }
}
struct RpL { u32x2 wy[4], wv[4], gc[4], gp[4]; float bsv[4]; };
DI void rwkv_post_load(RpL& L, const Args& a, int t, int lane) {
    const bf16* P = (const bf16*)(a.ws + WS_P);
    const bf16* RWv = (const bf16*)(a.ws + WS_RW) + (size_t)2 * T * 1024; const float* BS = (const float*)(a.ws + WS_RW + 5 * RW_ARR);
    const bf16* YC = (const bf16*)(a.ws + WS_YS) + (size_t)2 * T * 1024;
    const bool hp = (t & (SEQ - 1)) > 0;
#pragma unroll
    for (int c = 0; c < 4; ++c) { const int j = 256 * c + 4 * lane; const unsigned o = (unsigned)t * 1024 + j;
        L.wy[c] = *(const u32x2*)(YC + o); L.wv[c] = *(const u32x2*)(RWv + o); L.bsv[c] = BS[(unsigned)t * 16 + 4 * c + (lane >> 4)];
        L.gc[c] = *(const u32x2*)(P + (unsigned)t * LDP + CG + j); L.gp[c] = *(const u32x2*)(P + (unsigned)(hp ? t - 1 : t) * LDP + CG + j); }
}
DI void rwkv_post_finish(const RpL& L, const Args& a, const LAS f32x4* pl, int t, int lane) {
    bf16* YC = (bf16*)(a.ws + WS_YS) + (size_t)2 * T * 1024;
    const unsigned hpm = (t & (SEQ - 1)) > 0 ? 0xffffffffu : 0u;
#pragma unroll
    for (int c = 0; c < 4; ++c) {
        const int j = 256 * c + 4 * lane; const unsigned o = (unsigned)t * 1024 + j;
        const f32x4 m4 = pl[64 * c + lane], lg4 = pl[256 + 64 * c + lane], lb4 = pl[512 + 64 * c + lane];
        const f32x4 y = {bflo(L.wy[c].x), bfhi(L.wy[c].x), bflo(L.wy[c].y), bfhi(L.wy[c].y)}, v = {bflo(L.wv[c].x), bfhi(L.wv[c].x), bflo(L.wv[c].y), bfhi(L.wv[c].y)};
        f32x4 g = {bflo(L.gc[c].x), bfhi(L.gc[c].x), bflo(L.gc[c].y), bfhi(L.gc[c].y)}; const unsigned gpx = L.gp[c].x & hpm, gpy = L.gp[c].y & hpm; const f32x4 gq = {bflo(gpx), bfhi(gpx), bflo(gpy), bfhi(gpy)};
        g = g + (gq - g) * m4;
        const float mean = row16_sum((y.x + y.y) + (y.z + y.w)) * (1.0f / 64.0f); const f32x4 d = y - mean;
        const float var = row16_sum((d.x * d.x + d.y * d.y) + (d.z * d.z + d.w * d.w)) * (1.0f / 64.0f); const float rstd = 1.0f / sqrtf(var + 64e-5f);
        const f32x4 ov = d * rstd * lg4 + lb4 + L.bsv[c] * v;
        u32x2 w; w.x = pk2(ov.x * siluf_(g.x), ov.y * siluf_(g.y)); w.y = pk2(ov.z * siluf_(g.z), ov.w * siluf_(g.w));
        *(u32x2*)(YC + o) = w;
    }
}


DI void sgu_unit(const Args& a, int l, int unit, LAS unsigned char* lds, int tid, int lane, int wave) {
    const bf16* P = (const bf16*)(a.ws + WS_P); bf16* YD = (bf16*)(a.ws + WS_YS) + (size_t)3 * T * 1024;
    const bf16* wsb = (const bf16*)(a.ws + WS_WSB) + (size_t)l * 8 * 128 * 128;
    const int g = unit & 7, ch = (unit >> 3) & 31, b = unit >> 8;
    const int t0 = b * SEQ + ch * 128, r32 = lane & 31, hh = lane >> 5;
    LAS bf16* vt = (LAS bf16*)lds;
#pragma unroll
    for (int r = 0; r < 4; ++r) { const int cidx = tid + 512 * r, j = cidx >> 4, c = cidx & 15;
        *(LAS u32x4*)(vt + j * 136 + 8 * c) = *(const u32x4*)(P + (unsigned)(t0 + j) * LDP + DV + g * 128 + 8 * c); }
    __syncthreads();
    const int it = wave >> 1, dt0 = (wave & 1) * 2;
    f32x16 acc[2];
#pragma unroll
    for (int x = 0; x < 2; ++x)
#pragma unroll
        for (int r = 0; r < 16; ++r) acc[x][r] = 0.f;
#pragma unroll
    for (int st = 0; st < 8; ++st) {
        const bf16x8 A = *(const bf16x8*)(wsb + ((unsigned)g * 128 + 32 * it + r32) * 128 + 16 * st + 8 * hh);
#pragma unroll
        for (int x = 0; x < 2; ++x) { const int d = 32 * (dt0 + x) + r32; u32x4 w;
#pragma unroll
            for (int e = 0; e < 4; ++e) { const int j = 16 * st + 8 * hh + 2 * e; w[e] = (unsigned)vt[j * 136 + d] | ((unsigned)vt[(j + 1) * 136 + d] << 16); }
            acc[x] = MFMA32(A, __builtin_bit_cast(bf16x8, w), acc[x]); }
    }
    const float* bs = a.in[21] + (size_t)l * 8 * 128 + g * 128;
    unsigned short uu[2][16], gg[2][16]; f32x4 bsv[4];
#pragma unroll
    for (int g4 = 0; g4 < 4; ++g4) bsv[g4] = *(const f32x4*)(bs + 32 * it + 8 * g4 + 4 * hh);
#pragma unroll
    for (int x = 0; x < 2; ++x)
#pragma unroll
        for (int r = 0; r < 16; ++r) { const int t = t0 + 32 * it + crow(r, hh), col = g * 128 + 32 * (dt0 + x) + r32;
            uu[x][r] = P[(unsigned)t * LDP + DU + col]; gg[x][r] = P[(unsigned)t * LDP + DG + col]; }
#pragma unroll
    for (int x = 0; x < 2; ++x)
#pragma unroll
        for (int r = 0; r < 16; ++r) { const int t = t0 + 32 * it + crow(r, hh), col = g * 128 + 32 * (dt0 + x) + r32;
            const float sv = acc[x][r] + bsv[r >> 2][r & 3];
            YD[(unsigned)t * 1024 + col] = f2bf(gelu_erf(bf2f(uu[x][r])) * sv * siluf_(bf2f(gg[x][r]))); }
    __syncthreads();
}

DI unsigned f2key(float f) { const unsigned u = __float_as_uint(f); return (u & 0x80000000u) ? ~u : (u | 0x80000000u); }
DI unsigned wave_sum_u32(unsigned x) {
    x += (unsigned)__builtin_amdgcn_update_dpp(0, (int)x, 0x128, 0xf, 0xf, false); x += (unsigned)__builtin_amdgcn_update_dpp(0, (int)x, 0x124, 0xf, 0xf, false);
    x += (unsigned)__builtin_amdgcn_update_dpp(0, (int)x, 0x122, 0xf, 0xf, false); x += (unsigned)__builtin_amdgcn_update_dpp(0, (int)x, 0x121, 0xf, 0xf, false);
    return (unsigned)__builtin_amdgcn_readlane((int)x, 0) + (unsigned)__builtin_amdgcn_readlane((int)x, 16) + (unsigned)__builtin_amdgcn_readlane((int)x, 32) + (unsigned)__builtin_amdgcn_readlane((int)x, 48);
}
DI void dsa_index_unit(const Args& a, int unit, unsigned* fl, LAS unsigned char* lds, int tid, int lane, int wave) {
    const bf16* P = (const bf16*)(a.ws + WS_P); const float* SM = (const float*)(a.ws + WS_SM);
    const int b = unit & 3, jq = 63 - (unit >> 2);
    const int nch = jq + 1, nk = 64 * nch, ntile = 2 * nch, tq0 = b * SEQ + jq * 64;
    float* SCu = (float*)(a.ws + WS_SC) + (size_t)b * (4096 * 2080) + (unsigned)(jq * (jq + 1) / 2) * 4096;
    unsigned long long* BM = (unsigned long long*)(a.ws + WS_BM);
    const int r32 = lane & 31, hh = lane >> 5;
    LAS bf16* iql = (LAS bf16*)lds;
#pragma unroll
    for (int r = 0; r < 8; ++r) { const int cidx = tid + 512 * r, q = cidx >> 6, c = cidx & 63;
        *(LAS u32x4*)(iql + q * 520 + 8 * c) = *(const u32x4*)(P + (unsigned)(tq0 + q) * LDP + BIQ + 8 * c); }
    __syncthreads();
#pragma unroll 1
    for (int kt = wave; kt < ntile; kt += 8) {
        const int ts = b * SEQ + 32 * kt + r32;
        bf16x8 Ak[4];
#pragma unroll
        for (int st = 0; st < 4; ++st) { const float* p = SM + (unsigned)ts * 512 + IK + 16 * st + 8 * hh; Ak[st] = pack8f(*(const f32x4*)p, *(const f32x4*)(p + 4)); }
#pragma unroll 1
        for (int qh = 0; qh < 2; ++qh) {
            const int tq = tq0 + 32 * qh + r32;
            const f32x4 w0 = *(const f32x4*)(SM + (unsigned)tq * 512 + IW), w1 = *(const f32x4*)(SM + (unsigned)tq * 512 + IW + 4);
            f32x16 sc;
#pragma unroll
            for (int r = 0; r < 16; ++r) sc[r] = 0.f;
#pragma unroll
            for (int h8 = 0; h8 < 8; ++h8) { f32x16 acc;
#pragma unroll
                for (int r = 0; r < 16; ++r) acc[r] = 0.f;
#pragma unroll
                for (int st = 0; st < 4; ++st) { const bf16x8 Bq = *(const LAS bf16x8*)(iql + (32 * qh + r32) * 520 + h8 * 64 + 16 * st + 8 * hh); acc = MFMA32(Ak[st], Bq, acc); }
                const float wq = (h8 < 4 ? w0[h8 & 3] : w1[h8 & 3]) * 0.044194173824159216f;
#pragma unroll
                for (int r = 0; r < 16; ++r) sc[r] += wq * fmaxf(acc[r], 0.f); }
#pragma unroll
            for (int g4 = 0; g4 < 4; ++g4) { f32x4 o; o.x = sc[4 * g4]; o.y = sc[4 * g4 + 1]; o.z = sc[4 * g4 + 2]; o.w = sc[4 * g4 + 3];
                *(f32x4*)(SCu + (unsigned)(32 * qh + r32) * nk + 32 * kt + 8 * g4 + 4 * hh) = o; }
        }
    }
    __syncthreads();
    LAS unsigned* keys = (LAS unsigned*)(lds + wave * 16384);
#pragma unroll 1
    for (int qi = wave; qi < 64; qi += 8) {
        const float* row = SCu + (unsigned)qi * nk;
        unsigned long long myword = 0ull;
        if (nch <= 4) { myword = ~0ull; }
        else {
            unsigned key[64];
#pragma unroll
            for (int i = 0; i < 64; ++i) key[i] = __float_as_uint(row[(i < nch ? 64 * i : 0) + lane]);
            asm volatile("" ::: "memory");
#pragma unroll
            for (int i = 0; i < 64; ++i) key[i] = i < nch ? f2key(__uint_as_float(key[i])) : 0u;
            unsigned tau = 0u; int cnt_ge = 0;
#pragma unroll 1
            for (int bit = 31; bit >= 0; --bit) {
                const unsigned cand = tau | (1u << bit); unsigned cl = 0u;
#define CNT8(i0) asm volatile("v_cmp_ge_u32_e64 s[80:81], %1, %9\n\tv_cmp_ge_u32_e64 s[82:83], %2, %9\n\tv_cmp_ge_u32_e64 s[84:85], %3, %9\n\tv_cmp_ge_u32_e64 s[86:87], %4, %9\n\t" \
                     "v_cmp_ge_u32_e64 s[88:89], %5, %9\n\tv_cmp_ge_u32_e64 s[90:91], %6, %9\n\tv_cmp_ge_u32_e64 s[92:93], %7, %9\n\tv_cmp_ge_u32_e64 s[94:95], %8, %9\n\t" \
                     "v_addc_co_u32_e64 %0, s[96:97], 0, %0, s[80:81]\n\tv_addc_co_u32_e64 %0, s[96:97], 0, %0, s[82:83]\n\tv_addc_co_u32_e64 %0, s[96:97], 0, %0, s[84:85]\n\tv_addc_co_u32_e64 %0, s[96:97], 0, %0, s[86:87]\n\t" \
                     "v_addc_co_u32_e64 %0, s[96:97], 0, %0, s[88:89]\n\tv_addc_co_u32_e64 %0, s[96:97], 0, %0, s[90:91]\n\tv_addc_co_u32_e64 %0, s[96:97], 0, %0, s[92:93]\n\tv_addc_co_u32_e64 %0, s[96:97], 0, %0, s[94:95]" \
                     : "+v"(cl) : "v"(key[i0]), "v"(key[i0 + 1]), "v"(key[i0 + 2]), "v"(key[i0 + 3]), "v"(key[i0 + 4]), "v"(key[i0 + 5]), "v"(key[i0 + 6]), "v"(key[i0 + 7]), "v"(cand) \
                     : "s80", "s81", "s82", "s83", "s84", "s85", "s86", "s87", "s88", "s89", "s90", "s91", "s92", "s93", "s94", "s95", "s96", "s97")
                CNT8(0);
                if (nch > 8) { CNT8(8); }
                if (nch > 16) { CNT8(16); CNT8(24); }
                if (nch > 32) { CNT8(32); CNT8(40); }
                if (nch > 48) { CNT8(48); CNT8(56); }
#undef CNT8
                const int c = (int)wave_sum_u32(cl);
                if (c >= 256) { tau = cand; cnt_ge = c; if (c == 256) break; }
            }
            if (cnt_ge == 256) {
#pragma unroll
                for (int i = 0; i < 64; ++i) { const unsigned long long m = __ballot(key[i] >= tau); myword = (lane == i) ? m : myword; }
            } else {
#pragma unroll
                for (int i = 0; i < 64; ++i) keys[i * 64 + lane] = key[i];
                int n_gt = 0;
#pragma unroll 1
                for (int i = 0; i < nch; ++i) n_gt += __builtin_popcountll(__ballot(keys[i * 64 + lane] > tau));
                int quota = 256 - n_gt;
#pragma unroll 1
                for (int i = 0; i < nch; ++i) { const unsigned kv = keys[i * 64 + lane]; const unsigned long long m_gt = __ballot(kv > tau); unsigned long long m_eq = __ballot(kv == tau), take = 0ull;
                    const int ne = __builtin_popcountll(m_eq);
                    if (ne <= quota) { take = m_eq; quota -= ne; } else { while (quota > 0) { const unsigned long long low = m_eq & (0ull - m_eq); take |= low; m_eq ^= low; --quota; } }
                    myword = (lane == i) ? (m_gt | take) : myword; }
            }
        }
        if (lane < nch) BM[(unsigned)(tq0 + qi) * 64 + lane] = myword;
    }
    asm volatile("s_waitcnt vmcnt(0)" ::: "memory");
    __syncthreads();
    if (tid == 0) { __builtin_amdgcn_fence(__ATOMIC_RELEASE, "agent"); asm volatile("s_waitcnt vmcnt(0)" ::: "memory"); (void)xb_add(fl + 16 * (b * 16 + (jq >> 2)), 1u); }
}

DI void dsa_attn_unit(const Args& a, int unit, unsigned* fl, LAS unsigned char* lds, int tid, int lane, int wave) {
    const bf16* P = (const bf16*)(a.ws + WS_P); const unsigned* BM32 = (const unsigned*)(a.ws + WS_BM);
    bf16* YB = (bf16*)(a.ws + WS_YS) + (size_t)T * 1024;
    const int qg = 15 - (unit >> 5), bh = unit & 31, b = bh >> 3, hd = bh & 7;
    if (tid == 0) { unsigned* f = fl + 16 * (b * 16 + qg); unsigned sp = 0; while (xb_ld(f) < 4u) { __builtin_amdgcn_s_sleep(2); if (++sp > (1u << 22)) break; } __builtin_amdgcn_fence(__ATOMIC_ACQUIRE, "agent"); }
    __syncthreads();
    const int q0 = 256 * qg + 32 * wave, cw = 4 * qg + (wave >> 1), nkt = 4 * qg + 4;
    const int r32 = lane & 31, hh = lane >> 5;
    const int tq = b * SEQ + q0 + r32;
    LAS bf16* kbuf = (LAS bf16*)lds;
    LAS bf16* vbuf = kbuf + 2 * 64 * 136;
    const int krow = tid >> 3, kseg = (tid & 7) * 16;
    const bf16* ksrc = P + (unsigned)(b * SEQ + krow) * LDP + BK_ + hd * 128 + kseg;
    const bf16* vsrc = P + (unsigned)(b * SEQ + krow) * LDP + BV + hd * 128 + kseg;
    u32x4 kn[2], vn[2];
    kn[0] = *(const u32x4*)ksrc; kn[1] = *(const u32x4*)(ksrc + 8); vn[0] = *(const u32x4*)vsrc; vn[1] = *(const u32x4*)(vsrc + 8);
    bf16x8 Bq[8];
#pragma unroll
    for (int st = 0; st < 8; ++st) Bq[st] = *(const bf16x8*)(P + (unsigned)tq * LDP + BQ + hd * 128 + 16 * st + 8 * hh);
    f32x16 O[4];
#pragma unroll
    for (int dt = 0; dt < 4; ++dt)
#pragma unroll
        for (int r = 0; r < 16; ++r) O[dt][r] = 0.f;
    float m = -1e30f, lsum = 0.f;
    const float sc2 = 0.08838834764831845f * 1.4426950408889634f;
#define ATT_PUT(buf_) do { LAS bf16* kd_ = kbuf + (buf_) * (64 * 136) + krow * 136 + kseg; *(LAS u32x4*)kd_ = kn[0]; *(LAS u32x4*)(kd_ + 8) = kn[1]; \
        LAS bf16* vd_ = vbuf + (buf_) * (64 * 160) + krow * 160 + kseg; *(LAS u32x4*)vd_ = vn[0]; *(LAS u32x4*)(vd_ + 8) = vn[1]; } while (0)
    ATT_PUT(0);
    { const int k1 = nkt > 1 ? 1 : 0;
      const bf16* kp = ksrc + (unsigned)(k1 * 64) * LDP; kn[0] = *(const u32x4*)kp; kn[1] = *(const u32x4*)(kp + 8);
      const bf16* vp = vsrc + (unsigned)(k1 * 64) * LDP; vn[0] = *(const u32x4*)vp; vn[1] = *(const u32x4*)(vp + 8); }
    u32x2 mwn = *(const u32x2*)(BM32 + (unsigned)tq * 128);
    __syncthreads();
#pragma unroll 1
    for (int kt = 0; kt < nkt; ++kt) {
        const u32x2 mw = mwn;
        u32x4 kn2[2], vn2[2];
        { const int kn_i = kt + 1 < nkt ? kt + 1 : kt, k2_i = kt + 2 < nkt ? kt + 2 : nkt - 1;
          mwn = *(const u32x2*)(BM32 + (unsigned)tq * 128 + 2 * (kn_i <= cw ? kn_i : cw));
          const bf16* kp = ksrc + (unsigned)(k2_i * 64) * LDP; kn2[0] = *(const u32x4*)kp; kn2[1] = *(const u32x4*)(kp + 8);
          const bf16* vp = vsrc + (unsigned)(k2_i * 64) * LDP; vn2[0] = *(const u32x4*)vp; vn2[1] = *(const u32x4*)(vp + 8); }
        if (kt <= cw) {
            const LAS bf16* kb = kbuf + (kt & 1) * (64 * 136);
            const LAS unsigned char* vtb = (const LAS unsigned char*)(vbuf + (kt & 1) * (64 * 160)) + (4 * hh + ((lane >> 2) & 3)) * 320 + (16 * ((lane >> 4) & 1) + 4 * (lane & 3)) * 2;
            f32x16 s[2];
            {
                bf16x8 Ak0[8], Ak1[8];
#pragma unroll
                for (int st = 0; st < 8; ++st) Ak0[st] = *(const LAS bf16x8*)(kb + r32 * 136 + 16 * st + 8 * hh);
                __builtin_amdgcn_sched_barrier(0);
#pragma unroll
                for (int st = 0; st < 8; ++st) Ak1[st] = *(const LAS bf16x8*)(kb + (32 + r32) * 136 + 16 * st + 8 * hh);
#pragma unroll
                for (int r = 0; r < 16; ++r) { s[0][r] = 0.f; s[1][r] = 0.f; }
#pragma unroll
                for (int st = 0; st < 8; ++st) s[0] = MFMA32(Ak0[st], Bq[st], s[0]);
                __builtin_amdgcn_sched_barrier(0);
#pragma unroll
                for (int st = 0; st < 8; ++st) s[1] = MFMA32(Ak1[st], Bq[st], s[1]);
                __builtin_amdgcn_sched_barrier(0);
            }
            const unsigned mlo = mw.x >> (4 * hh), mhi = mw.y >> (4 * hh);
            float tmax = -1e30f;
#pragma unroll
            for (int th = 0; th < 2; ++th)
#pragma unroll
                for (int r = 0; r < 16; ++r) tmax = fmaxf(tmax, s[th][r]);
            tmax = fmaxf(tmax, __shfl_xor(tmax, 32)) * sc2;
            float mn = fmaxf(m, tmax);
            if (__any(mn > m + 8.0f)) {
                const float alpha = __builtin_amdgcn_exp2f(m - mn); lsum *= alpha;
#pragma unroll
                for (int dt = 0; dt < 4; ++dt)
#pragma unroll
                    for (int r = 0; r < 16; ++r) O[dt][r] *= alpha;
            } else mn = m;
            m = mn;
            float ps = 0.f;
#pragma unroll
            for (int th = 0; th < 2; ++th)
#pragma unroll
                for (int r = 0; r < 16; ++r) { const float p = __builtin_amdgcn_exp2f(s[th][r] * sc2 - mn);
                    const int sel = __builtin_amdgcn_sbfe((int)(th ? mhi : mlo), (r & 3) + 8 * (r >> 2), 1);
                    const float pm = __uint_as_float(__float_as_uint(p) & (unsigned)sel); s[th][r] = pm; ps += pm; }
            lsum += ps;
            {
                bf16x8 Av[2][4];
#pragma unroll
                for (int dt = 0; dt < 4; ++dt) Av[0][dt] = tr_frag(vtb + 64 * dt, 8 * 320);
#pragma unroll
                for (int g = 0; g < 4; ++g) { const int th = g >> 1, ss = g & 1;
                    __builtin_amdgcn_sched_barrier(0);
                    if (g < 3) {
#pragma unroll
                        for (int dt = 0; dt < 4; ++dt) Av[(g + 1) & 1][dt] = tr_frag(vtb + (32 * ((g + 1) >> 1) + 16 * ((g + 1) & 1)) * 320 + 64 * dt, 8 * 320); }
                    const bf16x8 Bp = pack_step(s[th], ss);
#pragma unroll
                    for (int dt = 0; dt < 4; ++dt) O[dt] = MFMA32(Av[g & 1][dt], Bp, O[dt]);
                }
                __builtin_amdgcn_sched_barrier(0);
            }
        }
        ATT_PUT((kt + 1) & 1);
        kn[0] = kn2[0]; kn[1] = kn2[1]; vn[0] = vn2[0]; vn[1] = vn2[1];
        __syncthreads();
    }
#undef ATT_PUT
    lsum += __shfl_xor(lsum, 32);
    const float inv = 1.0f / lsum;
    u32x2 gwv[4][4];
#pragma unroll
    for (int dt = 0; dt < 4; ++dt)
#pragma unroll
        for (int g4 = 0; g4 < 4; ++g4) gwv[dt][g4] = *(const u32x2*)(P + (unsigned)tq * LDP + BG + hd * 128 + 32 * dt + 8 * g4 + 4 * hh);
#pragma unroll
    for (int dt = 0; dt < 4; ++dt)
#pragma unroll
        for (int g4 = 0; g4 < 4; ++g4) { const int col = hd * 128 + 32 * dt + 8 * g4 + 4 * hh; const u32x2 gw = gwv[dt][g4];
            u32x2 w; w.x = pk2(O[dt][4 * g4] * inv * siluf_(bflo(gw.x)), O[dt][4 * g4 + 1] * inv * siluf_(bfhi(gw.x))); w.y = pk2(O[dt][4 * g4 + 2] * inv * siluf_(bflo(gw.y)), O[dt][4 * g4 + 3] * inv * siluf_(bfhi(gw.y)));
            *(u32x2*)(YB + (unsigned)tq * 1024 + col) = w; }
}

DI int queue_next(unsigned* head, volatile LAS unsigned* slot, int tid) {
    __syncthreads();
    if (tid == 0) *slot = __hip_atomic_fetch_add(head, 1u, __ATOMIC_RELAXED, __HIP_MEMORY_SCOPE_AGENT);
    __syncthreads();
    return (int)*slot;
}

template <unsigned PMASK> DI void fwd_body(const Args& a) {
    extern __shared__ __attribute__((aligned(16))) unsigned char lds_raw[];
    LAS unsigned char* lds = (LAS unsigned char*)lds_raw;
    volatile LAS unsigned* MISC = (volatile LAS unsigned*)(lds + MISC_OFF);
    const int tid = threadIdx.x, lane = tid & 63, wave = __builtin_amdgcn_readfirstlane(tid >> 6), bid = blockIdx.x, G = gridDim.x;
    unsigned* ctl = (unsigned*)(a.ws + WS_CTL);
    if (tid < 64) MISC[tid] = 0u;
    __syncthreads();
    const bool one_launch = (a.ph_hi - a.ph_lo) > 1;
    XcdBarrier bar; bar.bar = ctl + CW_BAR; bar.x = 0; bar.st = nullptr;
    if (one_launch) bar = xcd_barrier_post(ctl + CW_BAR, MISC + 8);
    const int lo = a.ph_lo, hi = a.ph_hi;
#define IN0 ((PMASK & 1u) && lo <= 0 && 0 < hi)
#define INL(j) (((PMASK >> ((j) + 1)) & 1u) && lo <= pb + (j) && pb + (j) < hi)
#ifndef REPB
#define REPB 1
#endif
#ifdef PROBE_A
#define STAMP(i) do { if (tid == 0) MISC[24 + (i)] = (unsigned)wall_clock64(); } while (0)
#else
#define STAMP(i) do { } while (0)
#endif
#define SEAM(k) do { if (lo <= (k) && (k) + 1 < hi) for (int rb_ = 0; rb_ < REPB; ++rb_) xcd_barrier(bar); STAMP((k) + 1); } while (0)
    const int NGW = G * 8;
#ifndef REPG
#define REPG 1
#endif
#ifndef REPG1
#define REPG1 REPG
#endif
#ifndef GP_ALIGN
#define GP_ALIGN true
#endif
#ifndef GP_SP2
#define GP_SP2 true
#endif
#ifndef REPT
#define REPT 1
#endif
#ifndef REPP
#define REPP 1
#endif
#define FRESH int tid_ = threadIdx.x; asm volatile("" : "+v"(tid_)); const int lane_ = tid_ & 63, wave_ = __builtin_amdgcn_readfirstlane(tid_ >> 6), gw_ = bid * 8 + wave_; (void)lane_; (void)gw_;

#ifndef REPP_SEL
#define REPP_SEL 15
#endif
    STAMP(0);
    if (IN0) { for (int rp_ = 0; rp_ < REPP; ++rp_) { { FRESH phase_prologue(a, lds, tid_, lane_, wave_, bid, G, rp_ == 0 ? 15 : REPP_SEL); } if (rp_ + 1 < REPP) xcd_barrier(bar); }
               { FRESH phase_prenorm(a.in[0], a.in[2], (bf16*)(a.ws + WS_H), gw_, NGW, lane_, lds, tid_); }
               SEAM(0); }

#pragma unroll 1
    for (int l = 0; l < 2; ++l) {
        const int pb = 1 + 10 * l;
        const float* xin = l == 0 ? a.in[0] : a.out;
        if (INL(1)) {
            pg8::Gemm g{(const pg8::bf16_t*)(a.ws + WS_H), (const pg8::bf16_t*)(a.ws + WS_WT1) + (size_t)l * N1 * DM, T, N1, DM, 0, 0};
            pg8::StaticOrder S; S.init(T, N1, G, bid);
            Epi<0> E{a.ws + WS_P, (float*)(a.ws + WS_SM)};
            for (int rg_ = 0; rg_ < REPG1; ++rg_) { pg8::gemm_phase2<Epi<0>, pg8::StaticOrder, GP_ALIGN, GP_SP2>(lds, g, S, E); if (rg_ + 1 < REPG1) xcd_barrier(bar); }
            SEAM(pb + 1);
        }
        if (INL(2)) {
#pragma unroll 1
            for (int s3 = 0; s3 < 3; ++s3) {
                const int which = (bid & 1) ? 2 - s3 : s3;
                if (which == 0) { FRESH bf16* Pp = (bf16*)(a.ws + WS_P); float* SMp = (float*)(a.ws + WS_SM);
                  LAS f32x4* pl = (LAS f32x4*)lds;
                  __syncthreads();
                  { const f32x4* mu4 = (const f32x4*)(a.in[8] + l * 4288); pl[tid_] = mu4[tid_]; if (tid_ < 256) { pl[512 + tid_] = mu4[512 + tid_]; pl[768 + tid_] = ((const f32x4*)(a.in[13] + l * BW))[tid_]; }
                    else { pl[1024 + tid_ - 256] = ((const f32x4*)(a.in[18] + l * BW))[tid_ - 256]; pl[1280 + tid_ - 256] = ((const f32x4*)(a.in[19] + l * BW))[tid_ - 256]; } }
                  __syncthreads();
                  { RwkvL Lwn;
                    rwkvp_load(Lwn, Pp, gw_, lane_);
                    for (int t = gw_; t < T; t += NGW) { const RwkvL Lw = Lwn;
                      __builtin_amdgcn_sched_barrier(0);
                      if (t + NGW < T) rwkvp_load(Lwn, Pp, t + NGW, lane_);
                      __builtin_amdgcn_sched_barrier(0);
                      rwkvp_finish(Lw, a, pl, t, lane_); } }
                  { RopeL Lrn; SguL Lsn;
                    rope_load(Lrn, Pp, SMp, (const f32x2*)(a.ws + WS_ROPE), gw_, lane_); sgu_load(Lsn, Pp, gw_, lane_);
                    for (int t = gw_; t < T; t += NGW) { const RopeL Lr = Lrn; const SguL Ls = Lsn;
                      __builtin_amdgcn_sched_barrier(0);
                      if (t + NGW < T) { rope_load(Lrn, Pp, SMp, (const f32x2*)(a.ws + WS_ROPE), t + NGW, lane_); sgu_load(Lsn, Pp, t + NGW, lane_); }
                      __builtin_amdgcn_sched_barrier(0);
                      rope_finish(Lr, Pp, SMp, t, lane_); sgu_finish(Ls, Pp, pl, t, lane_); } }
                  __syncthreads(); }
                else if (which == 1) { FRESH for (int u = bid; u < T / 32; u += G) prep_lowrank_unit(a, l, u, lds, tid_, lane_, wave_); }
                else { FRESH for (int u = bid; u < 1024; u += G) gla_kv_unit(a, l, u, lds, tid_, lane_, wave_); }
                if (l == 0) STAMP(22 + s3);
            }
            SEAM(pb + 2);
        }
        if (INL(3)) {
#ifndef REP3
#define REP3 1
#endif
#if defined(ONE_LAUNCH) && !defined(PROBE_Q) && !defined(SEPARATE_QUEUES)
          {
              unsigned* head = ctl + CW_Q + 64 * (8 * l + 6); bool staged = false;
#pragma unroll 1
              for (;;) { int tq_ = threadIdx.x; asm volatile("" : "+v"(tq_));
                  const int u = queue_next(head, MISC + 4, tq_); if (u >= 2448) break;
                  if (u < 128) { FRESH rwkv_unit(a, l, u, lds, tid_, lane_, wave_); }
                  else if (u < 144) { FRESH gla_scan_unit(a, l, u - 128, lds, tid_, lane_, wave_); }
                  else if (u < 400) { FRESH dsa_index_unit(a, u - 144, ctl + CW_F + 1024 * l, lds, tid_, lane_, wave_); }
                  else if (u < 1424) { FRESH sgu_unit(a, l, u - 400, lds, tid_, lane_, wave_); }
                  else if (u < 1936) { FRESH dsa_attn_unit(a, u - 1424, ctl + CW_F + 1024 * l, lds, tid_, lane_, wave_); }
                  else { FRESH const int up = u - 1936; LAS f32x4* pl = (LAS f32x4*)lds;
                      if (!staged) { staged = true;
                          if (tid_ < 256) { pl[tid_] = ((const f32x4*)(a.in[8] + l * 4288 + 3264))[tid_]; pl[256 + tid_] = ((const f32x4*)(a.in[16] + l * 1024))[tid_]; pl[512 + tid_] = ((const f32x4*)(a.in[17] + l * 1024))[tid_]; } }
                      if (tid_ == 0) { unsigned* f = ctl + CW_RD + 64 * l + 16 * (up >> 7); unsigned sp = 0; while (xb_ld(f) < 32u) { __builtin_amdgcn_s_sleep(2); if (++sp > (1u << 22)) break; } __builtin_amdgcn_fence(__ATOMIC_ACQUIRE, "agent"); }
                      __syncthreads();
                      { const int tb = up * 32 + wave_; RpL Ln; rwkv_post_load(Ln, a, tb, lane_);
#pragma unroll 1
                        for (int i = 0; i < 4; ++i) { const int t = tb + 8 * i; const RpL Lc = Ln; __builtin_amdgcn_sched_barrier(0); if (i + 1 < 4) rwkv_post_load(Ln, a, t + 8, lane_); __builtin_amdgcn_sched_barrier(0); rwkv_post_finish(Lc, a, pl, t, lane_); } }
                  }
              }
              __syncthreads();
          }
#else
#pragma unroll 1
          for (int rep = 0; rep < REP3; ++rep) {
            if (PMASK & (1u << 11)) { FRESH unsigned* head = ctl + CW_Q + 64 * (8 * l + 0 + 16 * rep); int nq_ = 0; for (;;) { const int u = queue_next(head, MISC + 4, tid_); if (u >= 128) break; rwkv_unit(a, l, u, lds, tid_, lane_, wave_); ++nq_; }
#ifdef PROBE_Q
              if (nq_ > 0 && tid_ == 0 && l == PROBE_QL) atomicMax(ctl + 12000 + 0, (unsigned)wall_clock64());
#endif
            }
            if (PMASK & (1u << 12)) { FRESH unsigned* head = ctl + CW_Q + 64 * (8 * l + 1 + 16 * rep); int nq_ = 0; for (;;) { const int u = queue_next(head, MISC + 4, tid_); if (u >= 16) break; gla_scan_unit(a, l, u, lds, tid_, lane_, wave_); ++nq_; }
#ifdef PROBE_Q
              if (nq_ > 0 && tid_ == 0 && l == PROBE_QL) atomicMax(ctl + 12000 + 1, (unsigned)wall_clock64());
#endif
            }
            if (PMASK & (1u << 13)) { FRESH unsigned* head = ctl + CW_Q + 64 * (8 * l + 2 + 16 * rep); int nq_ = 0; for (;;) { const int u = queue_next(head, MISC + 4, tid_); if (u >= 256) break; dsa_index_unit(a, u, ctl + CW_F + 1024 * l, lds, tid_, lane_, wave_); ++nq_; }
#ifdef PROBE_Q
              if (nq_ > 0 && tid_ == 0 && l == PROBE_QL) atomicMax(ctl + 12000 + 2, (unsigned)wall_clock64());
#endif
            }
            if (PMASK & (1u << 14)) { FRESH unsigned* head = ctl + CW_Q + 64 * (8 * l + 3 + 16 * rep); int nq_ = 0; for (;;) { const int u = queue_next(head, MISC + 4, tid_); if (u >= 1024) break; sgu_unit(a, l, u, lds, tid_, lane_, wave_); ++nq_; }
#ifdef PROBE_Q
              if (nq_ > 0 && tid_ == 0 && l == PROBE_QL) atomicMax(ctl + 12000 + 3, (unsigned)wall_clock64());
#endif
            }
            if (PMASK & (1u << 5)) { FRESH unsigned* head = ctl + CW_Q + 64 * (8 * l + 4 + 16 * rep); int nq_ = 0; for (;;) { const int u = queue_next(head, MISC + 4, tid_); if (u >= 512) break; dsa_attn_unit(a, u, ctl + CW_F + 1024 * l, lds, tid_, lane_, wave_); ++nq_; }
#ifdef PROBE_Q
              if (nq_ > 0 && tid_ == 0 && l == PROBE_QL) atomicMax(ctl + 12000 + 4, (unsigned)wall_clock64());
#endif
            }
            if (one_launch) {
                FRESH unsigned* head = ctl + CW_Q + 64 * (8 * l + 5 + 16 * rep); LAS f32x4* pl = (LAS f32x4*)lds; bool staged = false;
                for (;;) { const int u = queue_next(head, MISC + 4, tid_); if (u >= 512) break;
                    if (!staged) { staged = true;
                        if (tid_ < 256) { pl[tid_] = ((const f32x4*)(a.in[8] + l * 4288 + 3264))[tid_]; pl[256 + tid_] = ((const f32x4*)(a.in[16] + l * 1024))[tid_]; pl[512 + tid_] = ((const f32x4*)(a.in[17] + l * 1024))[tid_]; } }
                    if (tid_ == 0) { unsigned* f = ctl + CW_RD + 64 * l + 16 * (u >> 7); unsigned sp = 0; while (xb_ld(f) < 32u) { __builtin_amdgcn_s_sleep(2); if (++sp > (1u << 22)) break; } __builtin_amdgcn_fence(__ATOMIC_ACQUIRE, "agent"); }
                    __syncthreads();
                    { const int tb = u * 32 + wave_; RpL Ln; rwkv_post_load(Ln, a, tb, lane_);
#pragma unroll 1
                      for (int i = 0; i < 4; ++i) { const int t = tb + 8 * i; const RpL Lc = Ln; __builtin_amdgcn_sched_barrier(0); if (i + 1 < 4) rwkv_post_load(Ln, a, t + 8, lane_); __builtin_amdgcn_sched_barrier(0); rwkv_post_finish(Lc, a, pl, t, lane_); } }
                }
                __syncthreads();
            }
            if (rep + 1 < REP3) xcd_barrier(bar);
          }
#endif
            SEAM(pb + 3);
#ifdef EXTRA
            {
                FRESH unsigned* head = ctl + CW_Q + 64 * (8 * l + 48 + EXTRA);
                if (EXTRA == 0) for (;;) { const int u = queue_next(head, MISC + 4, tid_); if (u >= 128) break; rwkv_unit(a, l, u, lds, tid_, lane_, wave_); }
                if (EXTRA == 1) for (;;) { const int u = queue_next(head, MISC + 4, tid_); if (u >= 16) break; gla_scan_unit(a, l, u, lds, tid_, lane_, wave_); }
                if (EXTRA == 2) for (;;) { const int u = queue_next(head, MISC + 4, tid_); if (u >= 256) break; dsa_index_unit(a, u, ctl + CW_F + 1024 * l, lds, tid_, lane_, wave_); }
                if (EXTRA == 3) for (;;) { const int u = queue_next(head, MISC + 4, tid_); if (u >= 1024) break; sgu_unit(a, l, u, lds, tid_, lane_, wave_); }
                if (EXTRA == 4) for (;;) { const int u = queue_next(head, MISC + 4, tid_); if (u >= 512) break; dsa_attn_unit(a, u, ctl + CW_F + 1024 * l, lds, tid_, lane_, wave_); }
                xcd_barrier(bar);
            }
#endif
        }
        if (INL(4) && !one_launch) {
            { FRESH LAS f32x4* pl = (LAS f32x4*)lds;
              if (tid_ < 256) { pl[tid_] = ((const f32x4*)(a.in[8] + l * 4288 + 3264))[tid_]; pl[256 + tid_] = ((const f32x4*)(a.in[16] + l * 1024))[tid_]; pl[512 + tid_] = ((const f32x4*)(a.in[17] + l * 1024))[tid_]; }
              __syncthreads();
              { RpL Ln; rwkv_post_load(Ln, a, gw_, lane_);
                for (int t = gw_; t < T; t += NGW) { const RpL Lc = Ln; __builtin_amdgcn_sched_barrier(0); if (t + NGW < T) rwkv_post_load(Ln, a, t + NGW, lane_); __builtin_amdgcn_sched_barrier(0); rwkv_post_finish(Lc, a, pl, t, lane_); } }
              __syncthreads(); }
            SEAM(pb + 4);
        }
        if (INL(5)) {
            pg8::Gemm g{(const pg8::bf16_t*)(a.ws + WS_YS), (const pg8::bf16_t*)(a.ws + WS_WTP) + ((size_t)l << 23), T, 4 * DM, BW, 8, (size_t)T * BW * 2};
            pg8::StaticOrder S; S.init(T, 4 * DM, G, bid);
            Epi<1> E{a.ws + WS_P, nullptr};
            for (int rg_ = 0; rg_ < REPG; ++rg_) { pg8::gemm_phase2<Epi<1>, pg8::StaticOrder, GP_ALIGN, GP_SP2>(lds, g, S, E); if (rg_ + 1 < REPG) xcd_barrier(bar); }
            SEAM(pb + 5);
        }
        if (INL(6)) {
            pg8::Gemm g{(const pg8::bf16_t*)(a.ws + WS_H), (const pg8::bf16_t*)(a.ws + WS_WTM) + (size_t)l * NM * DM, T, NM, DM, 0, 0};
            pg8::StaticOrder S; S.init(T, NM, G, bid);
            Epi<2> E{a.ws + WS_RW, (float*)(a.ws + WS_P)};
            for (int rg_ = 0; rg_ < REPG; ++rg_) { pg8::gemm_phase2<Epi<2>, pg8::StaticOrder, GP_ALIGN, GP_SP2>(lds, g, S, E); if (rg_ + 1 < REPG) xcd_barrier(bar); }
            SEAM(pb + 6);
        }
        if (INL(8)) {
            pg8::Gemm g{(const pg8::bf16_t*)(a.ws + WS_RW), (const pg8::bf16_t*)(a.ws + WS_WTO) + ((size_t)l << 22), T, DM, DM, 0, 0};
            pg8::StaticOrder S; S.init(T, DM, G, bid);
            Epi<3> E{a.ws + WS_SC, nullptr};
            for (int rg_ = 0; rg_ < REPG; ++rg_) { pg8::gemm_phase2<Epi<3>, pg8::StaticOrder, GP_ALIGN, GP_SP2>(lds, g, S, E); if (rg_ + 1 < REPG) xcd_barrier(bar); }
            SEAM(pb + 8);
        }
        if (INL(9)) { FRESH
            if (l == 0) phase_postnorm<0>(a.in[0], (bf16*)(a.ws + WS_X1), (const bf16*)(a.ws + WS_SC), a.in[3], a.out, a.in[2] + DM, (bf16*)(a.ws + WS_H), gw_, NGW, lane_, lds, tid_);
            else phase_postnorm<1>(a.in[0], (bf16*)(a.ws + WS_X1), (const bf16*)(a.ws + WS_SC), a.in[3] + DM, a.out, a.in[2] + DM, (bf16*)nullptr, gw_, NGW, lane_, lds, tid_);
            SEAM(pb + 9); }
    }
#ifdef PROBE_A
    if (bid == 0 && tid == 0) { unsigned dt = MISC[24 + PROBE_B] - MISC[24 + PROBE_A];
#ifdef PROBE_Q
        dt = __hip_atomic_load(ctl + 12000 + PROBE_Q, __ATOMIC_RELAXED, __HIP_MEMORY_SCOPE_AGENT) - MISC[24 + 4 + 10 * PROBE_QL];
#endif
#ifdef PROBE_L2
        dt += MISC[24 + PROBE_B + 10] - MISC[24 + PROBE_A + 10];
#endif
        const unsigned t0 = (unsigned)wall_clock64(); while ((unsigned)wall_clock64() - t0 < PROBE_MUL * dt) __builtin_amdgcn_s_sleep(8); }
#endif
#undef IN0
#undef INL
#undef SEAM
}

#if defined(ONE_LAUNCH) || defined(ANALYZE)
__global__ void __launch_bounds__(512, 2) fwd(Args a) { fwd_body<0x7fffu>(a); }
#endif
#if !defined(ONE_LAUNCH)
__global__ void __launch_bounds__(512, 2) fwd_p0(Args a) { fwd_body<1u << 0>(a); }
__global__ void __launch_bounds__(512, 2) fwd_p1(Args a) { fwd_body<1u << 1>(a); }
__global__ void __launch_bounds__(512, 2) fwd_p2(Args a) { fwd_body<1u << 2>(a); }
__global__ void __launch_bounds__(512, 2) fwd_p3(Args a) { fwd_body<1u << 3>(a); }
__global__ void __launch_bounds__(512, 2) fwd_p4a(Args a) { fwd_body<(1u << 4) | (1u << 11)>(a); }
__global__ void __launch_bounds__(512, 2) fwd_p4b(Args a) { fwd_body<(1u << 4) | (1u << 12)>(a); }
__global__ void __launch_bounds__(512, 2) fwd_p4c(Args a) { fwd_body<(1u << 4) | (1u << 13)>(a); }
__global__ void __launch_bounds__(512, 2) fwd_p4d(Args a) { fwd_body<(1u << 4) | (1u << 14)>(a); }
__global__ void __launch_bounds__(512, 2) fwd_p5(Args a) { fwd_body<1u << 5>(a); }
__global__ void __launch_bounds__(512, 2) fwd_p6(Args a) { fwd_body<1u << 6>(a); }
__global__ void __launch_bounds__(512, 2) fwd_p7(Args a) { fwd_body<1u << 7>(a); }
__global__ void __launch_bounds__(512, 2) fwd_p8(Args a) { fwd_body<1u << 8>(a); }
__global__ void __launch_bounds__(512, 2) fwd_p9(Args a) { fwd_body<1u << 9>(a); }
__global__ void __launch_bounds__(512, 2) fwd_p10(Args a) { fwd_body<1u << 10>(a); }
#endif
#ifdef COMBO
#include "combo.inc"
#endif
typedef void (*kern_t)(Args);
extern "C" void kernel_launch(void* const* d_in, const int* in_sizes, int n_in, void* d_out, int out_size, void* d_ws, size_t ws_size, hipStream_t stream) {
    static int grid = 0;
#if defined(ONE_LAUNCH)
    static const kern_t kerns[1] = {fwd};
    constexpr int NK = 1;
#else
    static const kern_t kerns[14] = {fwd_p0, fwd_p1, fwd_p2, fwd_p3, fwd_p4a, fwd_p4b, fwd_p4c, fwd_p4d, fwd_p5, fwd_p6, fwd_p7, fwd_p8, fwd_p9, fwd_p10};
    constexpr int NK = 14;
#endif
    if (grid == 0) {
        if (n_in != 24 || out_size != T * DM || ws_size < WS_END) { fprintf(stderr, "kernel_launch: unexpected shapes (n_in %d out %d ws %zu, need %zu)\n", n_in, out_size, ws_size, (size_t)WS_END); grid = -1; return; }
        int dev = 0, cus = 0, per_cu = 0;
        if (hipGetDevice(&dev) != hipSuccess || hipDeviceGetAttribute(&cus, hipDeviceAttributeMultiprocessorCount, dev) != hipSuccess) { grid = -1; return; }
        for (int k = 0; k < NK; ++k)
            if (hipFuncSetAttribute((const void*)kerns[k], hipFuncAttributeMaxDynamicSharedMemorySize, LDS_BYTES) != hipSuccess) { fprintf(stderr, "kernel_launch: hipFuncSetAttribute failed\n"); grid = -1; return; }
        if (hipOccupancyMaxActiveBlocksPerMultiprocessor(&per_cu, (const void*)kerns[0], 512, LDS_BYTES) != hipSuccess || per_cu < 1) { fprintf(stderr, "kernel_launch: occupancy query says %d\n", per_cu); }
        (void)hipGetLastError();
        grid = cus;
    }
    if (grid < 0) return;
    (void)hipMemsetAsync((char*)d_ws + WS_CTL, 0, CTL_BYTES, stream);
    Args a{};
    for (int i = 0; i < 24; ++i) a.in[i] = (const float*)d_in[i];
    a.pos = (const int*)d_in[1]; a.out = (float*)d_out; a.ws = (unsigned char*)d_ws;
#if defined(ONE_LAUNCH)
    a.ph_lo = 0; a.ph_hi = NPHASE; hipLaunchKernelGGL(fwd, dim3(grid), dim3(512), LDS_BYTES, stream, a);
#else
    a.ph_lo = 0; a.ph_hi = 1; hipLaunchKernelGGL(fwd_p0, dim3(grid), dim3(512), LDS_BYTES, stream, a);
    for (int l = 0; l < 2; ++l) {
        static const int phase_of[13] = {0, 1, 2, 3, 3, 3, 3, 4, 5, 6, 7, 8, 9};
        for (int k = 0; k < 13; ++k) { a.ph_lo = 1 + 10 * l + phase_of[k]; a.ph_hi = a.ph_lo + 1; hipLaunchKernelGGL(kerns[1 + k], dim3(grid), dim3(512), LDS_BYTES, stream, a); }
    }
#endif
}
```
